# Optimizing an MI355X kernel written in HIP

```python
import math
import jax
import jax.numpy as jnp
from jax import lax
import numpy as np


D_MODEL = 2048
BATCH = 2
SEQ = 4096
DEPTH = 4

N_EVEN = (DEPTH + 1) // 2
N_ODD = DEPTH // 2
EPS = 1e-6

S5_WIDTH = D_MODEL // 2
S5_GROUP_SIZE = 16
S5_GROUPS = S5_WIDTH // S5_GROUP_SIZE
S5_STATE = 64
S5_MIN_DECAY = 1e-4

HGRN_WIDTH = D_MODEL - S5_WIDTH
HGRN_HEAD_DIM = 128
HGRN_HEADS = HGRN_WIDTH // HGRN_HEAD_DIM
HGRN_CHUNK = 64

IN_EVEN = S5_WIDTH + 4 * HGRN_WIDTH

ATT_HEAD_DIM = 64
ATT_HEADS = D_MODEL // ATT_HEAD_DIM
ATT_GROUP = 8
ATT_KV_HEADS = ATT_HEADS // ATT_GROUP
WINDOW = 128
ATT_BLOCK = 128
QKV_WIDTH = (ATT_HEADS + 2 * ATT_KV_HEADS) * ATT_HEAD_DIM

D_FF = 4 * D_MODEL

kernel_name = 'hybrid_s5_hgrn2_swa_block'

F32 = jnp.float32


def rms_norm(x, gain):
    xf = x.astype(F32)
    y = xf * lax.rsqrt(jnp.mean(xf * xf, axis=-1, keepdims=True) + EPS)
    return (y * gain.astype(F32)).astype(x.dtype)


def alibi_slopes(n_heads):
    return jnp.exp2(-8.0 * jnp.arange(1, n_heads + 1, dtype=F32) / n_heads)


def hgrn_lower_bounds(lb_param):
    p = jax.nn.softmax(lb_param.astype(F32), axis=0)
    return jnp.cumsum(p, axis=0) - p[0:1]


def s5_mixer(u, lam_re, lam_im, log_dt, b_re, b_im, c_re, c_im, d_skip, w_glu, b_glu):
    bsz, seqlen, _ = u.shape
    uf = u.astype(F32).reshape(bsz, seqlen, S5_GROUPS, S5_GROUP_SIZE)
    lr = jnp.minimum(lam_re.astype(F32), -S5_MIN_DECAY)
    li = lam_im.astype(F32)
    dt = jnp.exp(log_dt.astype(F32))[:, None]
    mag = jnp.exp(lr * dt)
    ar = mag * jnp.cos(li * dt)
    ai = mag * jnp.sin(li * dt)
    den = lr * lr + li * li
    zr = ((ar - 1.0) * lr + ai * li) / den
    zi = (ai * lr - (ar - 1.0) * li) / den
    br, bi = b_re.astype(F32), b_im.astype(F32)
    bbr = zr[..., None] * br - zi[..., None] * bi
    bbi = zr[..., None] * bi + zi[..., None] * br
    bu_re = jnp.einsum('blgc,gpc->blgp', uf, bbr)
    bu_im = jnp.einsum('blgc,gpc->blgp', uf, bbi)
    a_re = jnp.broadcast_to(ar, bu_re.shape)
    a_im = jnp.broadcast_to(ai, bu_im.shape)

    def combine(e1, e2):
        a1r, a1i, b1r, b1i = e1
        a2r, a2i, b2r, b2i = e2
        return (a2r * a1r - a2i * a1i,
                a2r * a1i + a2i * a1r,
                a2r * b1r - a2i * b1i + b2r,
                a2r * b1i + a2i * b1r + b2i)

    _, _, x_re, x_im = lax.associative_scan(combine, (a_re, a_im, bu_re, bu_im), axis=1)
    y = (jnp.einsum('blgp,gcp->blgc', x_re, c_re.astype(F32))
         - jnp.einsum('blgp,gcp->blgc', x_im, c_im.astype(F32))
         + d_skip.astype(F32) * uf)
    y = jax.nn.gelu(y.reshape(bsz, seqlen, S5_WIDTH))
    return y * jax.nn.sigmoid(y @ w_glu.astype(F32) + b_glu.astype(F32))


def chunkwise_gated_recurrence(q, log_f, k, v):
    bsz, seqlen, heads, dk = q.shape
    dv = v.shape[-1]
    n_chunks = seqlen // HGRN_CHUNK

    def to_chunks(t):
        return t.reshape(bsz, n_chunks, HGRN_CHUNK, heads, t.shape[-1]).transpose(1, 0, 3, 2, 4)

    qc, gc, kc, vc = to_chunks(q), to_chunks(log_f), to_chunks(k), to_chunks(v)
    causal = jnp.tril(jnp.ones((HGRN_CHUNK, HGRN_CHUNK), dtype=bool))[:, :, None]

    def step(state, inputs):
        q_, g_, k_, v_ = inputs
        b = jnp.cumsum(g_, axis=2)
        diff = b[:, :, :, None, :] - b[:, :, None, :, :]
        decay = jnp.exp(jnp.where(causal, diff, -jnp.inf))
        scores = jnp.einsum('bhtk,bhsk,bhtsk->bhts', q_, k_, decay)
        out = (jnp.einsum('bhts,bhsv->bhtv', scores, v_)
               + jnp.einsum('bhtk,bhkv->bhtv', q_ * jnp.exp(b), state))
        b_last = b[:, :, -1:, :]
        state = (jnp.exp(b_last[:, :, 0, :])[..., None] * state
                 + jnp.einsum('bhsk,bhsv->bhkv', k_ * jnp.exp(b_last - b), v_))
        return state, out

    state0 = jnp.zeros((bsz, heads, dk, dv), F32)
    _, outs = lax.scan(step, state0, (qc, gc, kc, vc))
    return outs.transpose(1, 0, 3, 2, 4).reshape(bsz, seqlen, heads, dv)


def hgrn2_mixer(q, f, i, g, lower_bound, o_gain):
    bsz, seqlen, _ = q.shape

    def heads(t):
        return t.astype(F32).reshape(bsz, seqlen, HGRN_HEADS, HGRN_HEAD_DIM)

    lb = lower_bound.reshape(HGRN_HEADS, HGRN_HEAD_DIM)
    forget = lb + (1.0 - lb) * jax.nn.sigmoid(heads(f))
    o = chunkwise_gated_recurrence(jax.nn.silu(heads(q)), jnp.log(forget), 1.0 - forget, heads(i))
    o = rms_norm(o, o_gain) * jax.nn.silu(heads(g))
    return o.reshape(bsz, seqlen, HGRN_WIDTH)


def s5_hgrn2_layer(xn, w_in, lam_re, lam_im, log_dt, b_re, b_im, c_re, c_im, d_skip,
                   w_glu, b_glu, lower_bound, o_gain, w_out):
    proj = xn @ w_in
    u, q, f, i, g = jnp.split(proj, [S5_WIDTH, S5_WIDTH + HGRN_WIDTH,
                                     S5_WIDTH + 2 * HGRN_WIDTH, S5_WIDTH + 3 * HGRN_WIDTH], axis=-1)
    y_a = s5_mixer(u, lam_re, lam_im, log_dt, b_re, b_im, c_re, c_im, d_skip, w_glu, b_glu)
    y_b = hgrn2_mixer(q, f, i, g, lower_bound, o_gain)
    return jnp.concatenate([y_a, y_b], axis=-1).astype(xn.dtype) @ w_out


def sliding_window_attention(q, k, v, sinks):
    bsz, seqlen = q.shape[:2]
    nb = seqlen // ATT_BLOCK
    qb = q.reshape(bsz, nb, ATT_BLOCK, ATT_KV_HEADS, ATT_GROUP, ATT_HEAD_DIM)

    def band(t):
        tb = t.reshape(bsz, nb, ATT_BLOCK, ATT_KV_HEADS, ATT_HEAD_DIM)
        prev = jnp.pad(tb, ((0, 0), (1, 0), (0, 0), (0, 0), (0, 0)))[:, :-1]
        return jnp.concatenate([prev, tb], axis=2)

    kw, vw = band(k), band(v)
    scores = jnp.einsum('bnqkgd,bnskd->bnkgqs', qb, kw) * (ATT_HEAD_DIM ** -0.5)
    dist = jnp.arange(ATT_BLOCK)[:, None] + ATT_BLOCK - jnp.arange(2 * ATT_BLOCK)[None, :]
    in_window = (dist >= 0) & (dist < WINDOW)
    key_pos = (jnp.arange(nb)[:, None] * ATT_BLOCK - ATT_BLOCK
               + jnp.arange(2 * ATT_BLOCK)[None, :])
    mask = in_window[None] & (key_pos >= 0)[:, None, :]
    slopes = alibi_slopes(ATT_HEADS).reshape(ATT_KV_HEADS, ATT_GROUP)
    bias = -slopes[:, :, None, None] * dist.astype(F32)
    scores = jnp.where(mask[None, :, None, None], scores + bias, -jnp.inf)
    sink = jnp.broadcast_to(sinks.astype(F32).reshape(ATT_KV_HEADS, ATT_GROUP)[None, None, :, :, None, None],
                            scores.shape[:-1] + (1,))
    probs = jax.nn.softmax(jnp.concatenate([scores, sink], axis=-1), axis=-1)[..., :-1]
    out = jnp.einsum('bnkgqs,bnskd->bnqkgd', probs, vw)
    return out.reshape(bsz, seqlen, ATT_HEADS * ATT_HEAD_DIM)


def attention_layer(xn, w_qkv, q_gain, k_gain, sinks, w_out):
    bsz, seqlen, _ = xn.shape
    proj = xn @ w_qkv
    q, k, v = jnp.split(proj, [ATT_HEADS * ATT_HEAD_DIM, (ATT_HEADS + ATT_KV_HEADS) * ATT_HEAD_DIM], axis=-1)
    q = rms_norm(q.astype(F32).reshape(bsz, seqlen, ATT_HEADS, ATT_HEAD_DIM), q_gain)
    k = rms_norm(k.astype(F32).reshape(bsz, seqlen, ATT_KV_HEADS, ATT_HEAD_DIM), k_gain)
    v = v.astype(F32).reshape(bsz, seqlen, ATT_KV_HEADS, ATT_HEAD_DIM)
    o = sliding_window_attention(q, k, v, sinks)
    return o.astype(xn.dtype) @ w_out


def squared_relu_mlp(xn, w_up, w_down):
    return jnp.square(jax.nn.relu(xn @ w_up)) @ w_down


def setup_inputs(seed: int = 0) -> dict:
    key = jax.random.key(seed)
    ks = iter(jax.random.split(key, 32))

    def nrm(shape, scale):
        return scale * jax.random.normal(next(ks), shape, F32)

    x = nrm((BATCH, SEQ, D_MODEL), 1.0)
    even_norm = 1.0 + nrm((N_EVEN, D_MODEL), 0.02)
    even_w_in = nrm((N_EVEN, D_MODEL, IN_EVEN), D_MODEL ** -0.5)
    s5_lambda_re = -0.5 + nrm((N_EVEN, S5_GROUPS, S5_STATE), 0.01)
    s5_lambda_im = math.pi * jnp.arange(S5_STATE, dtype=F32) + nrm((N_EVEN, S5_GROUPS, S5_STATE), 0.01)
    s5_log_dt = jax.random.uniform(next(ks), (N_EVEN, S5_GROUPS), F32, math.log(1e-3), math.log(1e-1))
    s5_b_re = nrm((N_EVEN, S5_GROUPS, S5_STATE, S5_GROUP_SIZE), (2 * S5_GROUP_SIZE) ** -0.5)
    s5_b_im = nrm((N_EVEN, S5_GROUPS, S5_STATE, S5_GROUP_SIZE), (2 * S5_GROUP_SIZE) ** -0.5)
    s5_c_re = nrm((N_EVEN, S5_GROUPS, S5_GROUP_SIZE, S5_STATE), S5_STATE ** -0.5)
    s5_c_im = nrm((N_EVEN, S5_GROUPS, S5_GROUP_SIZE, S5_STATE), S5_STATE ** -0.5)
    s5_d = nrm((N_EVEN, S5_GROUPS, S5_GROUP_SIZE), 1.0)
    s5_w_glu = nrm((N_EVEN, S5_WIDTH, S5_WIDTH), S5_WIDTH ** -0.5)
    s5_b_glu = nrm((N_EVEN, S5_WIDTH), 0.01)
    hgrn_lower_bound = nrm((N_EVEN, HGRN_WIDTH), 0.1)
    hgrn_o_norm = 1.0 + nrm((N_EVEN, HGRN_HEAD_DIM), 0.02)
    even_w_out = nrm((N_EVEN, D_MODEL, D_MODEL), D_MODEL ** -0.5)
    odd_norm = 1.0 + nrm((N_ODD, D_MODEL), 0.02)
    odd_w_qkv = nrm((N_ODD, D_MODEL, QKV_WIDTH), D_MODEL ** -0.5)
    q_norm = 1.0 + nrm((N_ODD, ATT_HEAD_DIM), 0.02)
    k_norm = 1.0 + nrm((N_ODD, ATT_HEAD_DIM), 0.02)
    att_sinks = nrm((N_ODD, ATT_HEADS), 0.5)
    odd_w_out = nrm((N_ODD, D_MODEL, D_MODEL), D_MODEL ** -0.5)
    mlp_norm = 1.0 + nrm((DEPTH, D_MODEL), 0.02)
    mlp_w_up = nrm((DEPTH, D_MODEL, D_FF), D_MODEL ** -0.5)
    mlp_w_down = nrm((DEPTH, D_FF, D_MODEL), D_FF ** -0.5)
    return {'x': x, 'even_norm': even_norm, 'even_w_in': even_w_in,
            's5_lambda_re': s5_lambda_re, 's5_lambda_im': s5_lambda_im, 's5_log_dt': s5_log_dt,
            's5_b_re': s5_b_re, 's5_b_im': s5_b_im, 's5_c_re': s5_c_re, 's5_c_im': s5_c_im,
            's5_d': s5_d, 's5_w_glu': s5_w_glu, 's5_b_glu': s5_b_glu,
            'hgrn_lower_bound': hgrn_lower_bound, 'hgrn_o_norm': hgrn_o_norm, 'even_w_out': even_w_out,
            'odd_norm': odd_norm, 'odd_w_qkv': odd_w_qkv, 'q_norm': q_norm, 'k_norm': k_norm,
            'att_sinks': att_sinks, 'odd_w_out': odd_w_out,
            'mlp_norm': mlp_norm, 'mlp_w_up': mlp_w_up, 'mlp_w_down': mlp_w_down}


def reference(x, even_norm, even_w_in, s5_lambda_re, s5_lambda_im, s5_log_dt, s5_b_re, s5_b_im,
              s5_c_re, s5_c_im, s5_d, s5_w_glu, s5_b_glu, hgrn_lower_bound, hgrn_o_norm, even_w_out,
              odd_norm, odd_w_qkv, q_norm, k_norm, att_sinks, odd_w_out, mlp_norm, mlp_w_up, mlp_w_down):
    h = x
    lower_bounds = hgrn_lower_bounds(hgrn_lower_bound)
    for layer in range(DEPTH):
        j = layer // 2
        if layer % 2 == 0:
            y = s5_hgrn2_layer(rms_norm(h, even_norm[j]), even_w_in[j], s5_lambda_re[j], s5_lambda_im[j],
                               s5_log_dt[j], s5_b_re[j], s5_b_im[j], s5_c_re[j], s5_c_im[j], s5_d[j],
                               s5_w_glu[j], s5_b_glu[j], lower_bounds[j], hgrn_o_norm[j], even_w_out[j])
        else:
            y = attention_layer(rms_norm(h, odd_norm[j]), odd_w_qkv[j], q_norm[j], k_norm[j],
                                att_sinks[j], odd_w_out[j])
        h = h + y.astype(h.dtype)
        h = h + squared_relu_mlp(rms_norm(h, mlp_norm[layer]), mlp_w_up[layer], mlp_w_down[layer]).astype(h.dtype)
    return h
```

```cpp
#include <hip/hip_runtime.h>
#include <hip/hip_cooperative_groups.h>
#include <cstdio>
namespace cg = cooperative_groups;

#ifndef MK_ONE_LAUNCH
#define MK_ONE_LAUNCH 0
#endif

#define LAS __attribute__((address_space(3)))
typedef unsigned short bf16_t;
typedef short bf16x8 __attribute__((ext_vector_type(8)));
typedef float f32x4 __attribute__((ext_vector_type(4)));
typedef float f32x2 __attribute__((ext_vector_type(2)));
typedef unsigned u32x4 __attribute__((ext_vector_type(4)));
typedef unsigned u32x2 __attribute__((ext_vector_type(2)));

constexpr int T = 8192, SEQ = 4096;
constexpr int NPH = 35;
constexpr int LDS_BYTES = 131072;
constexpr float LOG2E = 1.4426950408889634f;

constexpr size_t SZ_WIN = (size_t)5120 * 2048 * 2, SZ_WGLU = (size_t)1024 * 1024 * 2, SZ_WSQ = (size_t)2048 * 2048 * 2, SZ_WQKV = (size_t)2560 * 2048 * 2, SZ_WUP = (size_t)8192 * 2048 * 2;
constexpr size_t WS_WIN = 0;
constexpr size_t WS_WGLU = WS_WIN + 2 * SZ_WIN;
constexpr size_t WS_WOE = WS_WGLU + 2 * SZ_WGLU;
constexpr size_t WS_WQKV = WS_WOE + 2 * SZ_WSQ;
constexpr size_t WS_WOO = WS_WQKV + 2 * SZ_WQKV;
constexpr size_t WS_WUP = WS_WOO + 2 * SZ_WSQ;
constexpr size_t WS_WDN = WS_WUP + 4 * SZ_WUP;
constexpr size_t WS_XN = WS_WDN + 4 * SZ_WUP;
constexpr size_t WS_PROJ = WS_XN + (size_t)T * 2048 * 2;
constexpr size_t WS_YCAT = WS_PROJ + (size_t)T * 5120 * 2;
constexpr size_t WS_YS5 = WS_YCAT + (size_t)T * 2048 * 2;
constexpr size_t WS_HID = WS_YS5 + (size_t)T * 1024 * 2;
constexpr size_t WS_HST = WS_HID + (size_t)T * 8192 * 2;
constexpr size_t WS_HDEC = WS_HST + (size_t)16 * 64 * 16384 * 4;
constexpr size_t WS_S5F = WS_HDEC + (size_t)16 * 64 * 128 * 4;
constexpr size_t WS_S5A = WS_S5F + (size_t)128 * 64 * 64 * 2 * 4;
constexpr size_t WS_S5B = WS_S5A + (size_t)2 * 64 * 64 * 2 * 4;
constexpr size_t WS_END = WS_S5B + (size_t)2 * 64 * 64 * 32 * 4;

__device__ __forceinline__ unsigned cvt_pk_bf16(float lo, float hi) { unsigned r; asm volatile("v_cvt_pk_bf16_f32 %0, %1, %2" : "=v"(r) : "v"(lo), "v"(hi)); return r; }
__device__ __forceinline__ unsigned short f2bf(float f) { unsigned u = __builtin_bit_cast(unsigned, f); return (unsigned short)((u + 0x7fffu + ((u >> 16) & 1u)) >> 16); }
__device__ __forceinline__ float bflo(unsigned w) { return __builtin_bit_cast(float, w << 16); }
__device__ __forceinline__ float bfhi(unsigned w) { return __builtin_bit_cast(float, w & 0xffff0000u); }
__device__ __forceinline__ void unpack8(u32x4 w, float (&f)[8]) {
    f[0] = bflo(w.x); f[1] = bfhi(w.x); f[2] = bflo(w.y); f[3] = bfhi(w.y); f[4] = bflo(w.z); f[5] = bfhi(w.z); f[6] = bflo(w.w); f[7] = bfhi(w.w);
}
__device__ __forceinline__ float wave_sum(float v) {
#pragma unroll
    for (int o = 32; o > 0; o >>= 1) v += __shfl_xor(v, o);
    return v;
}
__device__ __forceinline__ float sigmoidf_(float x) { return 1.0f / (1.0f + __expf(-x)); }
__device__ __forceinline__ float ex2(float x) { return __builtin_amdgcn_exp2f(x); }

namespace pg8 {
constexpr int BM = 256, BK = 64, HALF = 128, HTB = HALF * BK * 2, STAGE_BYTES = 8 * HTB, NXCD = 8, WGM = 8;
__device__ __forceinline__ int lds_byte(int r, int c) { const int st = (r >> 4) * 2 + (c >> 5), rr = r & 15, cc = c & 31, ob = rr * 64 + cc * 2; return st * 1024 + (ob ^ (((ob >> 9) & 1) << 5)); }
__device__ __forceinline__ void stage_rc(int b, int& R, int& C) { const int st = b / 1024, sb = b % 1024, swz = sb ^ (((sb >> 9) & 1) << 5); R = (st >> 1) * 16 + swz / 64; C = (st & 1) * 32 + (swz % 64) / 2; }
__device__ __forceinline__ int perm32(int rho) { const int n = rho >> 4, i = rho & 15; return 8 * (i >> 2) + 4 * n + (i & 3); }

struct Unit { int pm, pn; };
struct Gemm { const bf16_t* A; const bf16_t* Bt; int M, N, K; };

struct StaticOrder {
    int nM, nN, nwg, G, c;
    __device__ void init(int M, int N, int G_, int c_) { nM = M / BM; nN = N / BM; nwg = nM * nN; G = G_; c = c_; }
    __device__ bool next(int i, Unit& u) const {
        const long L = (long)i * G + c; if (L >= nwg) return false;
        int wgid = (int)L; { const int q = nwg / NXCD, r = nwg % NXCD, xcd = wgid % NXCD, off = wgid / NXCD; wgid = (xcd < r ? xcd * (q + 1) : r * (q + 1) + (xcd - r) * q) + off; }
        const int nig = WGM * nN, gid = wgid / nig, fm = gid * WGM, gsz = (nM - fm) < WGM ? (nM - fm) : WGM;
        u.pm = fm + ((wgid % nig) % gsz); u.pn = (wgid % nig) / gsz; return true;
    }
};

struct EpiBf16 {
    static constexpr bool PERM = true;
    bf16_t* O; int ldc; int act;
    __device__ __forceinline__ void operator()(const f32x4 (&acc)[2][2][4][2], const Unit& u, int wr, int wc, int fr, int fq) const {
        const int row0 = u.pm * BM + wr * 64 + fr, col0 = u.pn * BM + wc * 32 + 8 * fq;
#pragma unroll
        for (int ai = 0; ai < 2; ++ai)
#pragma unroll
            for (int m = 0; m < 4; ++m) { bf16_t* rowp = O + (size_t)(row0 + ai * HALF + m * 16) * ldc + col0;
#pragma unroll
                for (int bj = 0; bj < 2; ++bj) { f32x4 v0 = acc[ai][bj][m][0], v1 = acc[ai][bj][m][1];
                    if (act) {
#pragma unroll
                        for (int j = 0; j < 4; ++j) { float a = fmaxf(v0[j], 0.f), b = fmaxf(v1[j], 0.f); v0[j] = a * a; v1[j] = b * b; } }
                    u32x4 w; w.x = cvt_pk_bf16(v0[0], v0[1]); w.y = cvt_pk_bf16(v0[2], v0[3]); w.z = cvt_pk_bf16(v1[0], v1[1]); w.w = cvt_pk_bf16(v1[2], v1[3]);
                    *(u32x4*)(rowp + bj * HALF) = w; } }
    }
};
struct EpiGlu {
    static constexpr bool PERM = true;
    const bf16_t* Y; const float* bias; bf16_t* O; int ldo;
    __device__ __forceinline__ void operator()(const f32x4 (&acc)[2][2][4][2], const Unit& u, int wr, int wc, int fr, int fq) const {
        const int row0 = u.pm * BM + wr * 64 + fr, col0 = u.pn * BM + wc * 32 + 8 * fq;
#pragma unroll
        for (int ai = 0; ai < 2; ++ai)
#pragma unroll
            for (int m = 0; m < 4; ++m) { const int row = row0 + ai * HALF + m * 16;
#pragma unroll
                for (int bj = 0; bj < 2; ++bj) { const int col = col0 + bj * HALF;
                    const f32x4 b0 = *(const f32x4*)(bias + col), b1 = *(const f32x4*)(bias + col + 4);
                    const u32x4 yw = *(const u32x4*)(Y + (size_t)row * 1024 + col); float y[8]; unpack8(yw, y);
                    const f32x4 v0 = acc[ai][bj][m][0] + b0, v1 = acc[ai][bj][m][1] + b1; float o[8];
#pragma unroll
                    for (int j = 0; j < 4; ++j) { o[j] = y[j] * sigmoidf_(v0[j]); o[4 + j] = y[4 + j] * sigmoidf_(v1[j]); }
                    u32x4 w; w.x = cvt_pk_bf16(o[0], o[1]); w.y = cvt_pk_bf16(o[2], o[3]); w.z = cvt_pk_bf16(o[4], o[5]); w.w = cvt_pk_bf16(o[6], o[7]);
                    *(u32x4*)(O + (size_t)row * ldo + col) = w; } }
    }
};
struct EpiResid {
    static constexpr bool PERM = false;
    const float* base; float* out;
    __device__ __forceinline__ void operator()(const f32x4 (&acc)[2][2][4][2], const Unit& u, int wr, int wc, int fr, int fq) const {
        const int row0 = u.pm * BM + wr * 64 + fr, col0 = u.pn * BM + wc * 32 + 4 * fq;
#pragma unroll
        for (int ai = 0; ai < 2; ++ai)
#pragma unroll
            for (int m = 0; m < 4; ++m) { const size_t ro = (size_t)(row0 + ai * HALF + m * 16) * 2048 + col0;
#pragma unroll
                for (int bj = 0; bj < 2; ++bj)
#pragma unroll
                    for (int n = 0; n < 2; ++n) { const size_t o = ro + bj * HALF + n * 16; *(f32x4*)(out + o) = *(const f32x4*)(base + o) + acc[ai][bj][m][n]; } }
    }
};

template <class Epi>
__device__ __forceinline__ void gemm_phase(LAS unsigned char* lds, const Gemm g, const StaticOrder& S, const Epi& E) {
    int tid = threadIdx.x; asm volatile("" : "+v"(tid));
    const int wid = __builtin_amdgcn_readfirstlane(tid >> 6), lane = tid & 63, wr = wid >> 2, wc = wid & 3, fr = lane & 15, fq = lane >> 4;
    const int K = g.K, nt = K / BK;
    unsigned voffA[2], voffB[2];
#pragma unroll
    for (int i = 0; i < 2; ++i) { int R, C; stage_rc(tid * 16 + i * 8192, R, C); const int Rb = Epi::PERM ? ((R & ~31) + perm32(R & 31)) : R;
        voffA[i] = (unsigned)(R * K + C) * 2u; voffB[i] = (unsigned)(Rb * K + C) * 2u; }
    const size_t kstep = (size_t)(BK * 2);
    const size_t hstep = (size_t)HALF * K * 2;
    const size_t tstep = 2 * hstep;
    const unsigned ldsw = (unsigned)wid * 1024u;
    const int aoff = lds_byte(wr * 64 + fr, fq * 8), boff = lds_byte(wc * 32 + fr, fq * 8);
#define PG8_SA(b, h) (((b) * 2 + (h)) * HTB)
#define PG8_SB(b, h) ((4 + (b) * 2 + (h)) * HTB)
#define PG8_STAGE(bufoff, gbase, voff) do { _Pragma("unroll") for (int _i = 0; _i < 2; ++_i) \
        __builtin_amdgcn_global_load_lds((const unsigned*)((const char*)(gbase) + (voff)[_i]), (LAS unsigned*)(lds + (bufoff) + ldsw + _i * 8192), 16, 0, 0); } while (0)
#define PG8_LDA(dst, b, h) do { _Pragma("unroll") for (int m = 0; m < 4; ++m) _Pragma("unroll") for (int k = 0; k < 2; ++k) dst[m][k] = *(const LAS bf16x8*)(lds + PG8_SA(b, h) + aoff + m * 2048 + k * 1024); } while (0)
#define PG8_LDB(dst, b, h) do { _Pragma("unroll") for (int n = 0; n < 2; ++n) _Pragma("unroll") for (int k = 0; k < 2; ++k) dst[n][k] = *(const LAS bf16x8*)(lds + PG8_SB(b, h) + boff + n * 2048 + k * 1024); } while (0)
#define PG8_MMA(ai, bj, At, Bt) do { __builtin_amdgcn_s_setprio(1); _Pragma("unroll") for (int m = 0; m < 4; ++m) _Pragma("unroll") for (int n = 0; n < 2; ++n) _Pragma("unroll") for (int k = 0; k < 2; ++k) \
        acc[ai][bj][m][n] = __builtin_amdgcn_mfma_f32_16x16x32_bf16(Bt[n][k], At[m][k], acc[ai][bj][m][n], 0, 0, 0); __builtin_amdgcn_s_setprio(0); } while (0)
#define PG8_WAIT_V(n) asm volatile("s_waitcnt vmcnt(" #n ")" ::: "memory")
#define PG8_WAIT_L(n) asm volatile("s_waitcnt lgkmcnt(" #n ")" ::: "memory")
#define PG8_BAR __builtin_amdgcn_s_barrier()
#define PG8_SCHED __builtin_amdgcn_sched_barrier(0)
    Unit cur, nxt; int ui = 0;
    if (!S.next(0, cur)) return;
    f32x4 acc[2][2][4][2];
#pragma unroll
    for (int a = 0; a < 2; ++a)
#pragma unroll
        for (int b = 0; b < 2; ++b)
#pragma unroll
            for (int m = 0; m < 4; ++m)
#pragma unroll
                for (int n = 0; n < 2; ++n) acc[a][b][m][n] = (f32x4){0.f, 0.f, 0.f, 0.f};
    bf16x8 At[4][2], B0[2][2], B1[2][2];
    const char* cA = (const char*)g.A + (size_t)cur.pm * tstep; const char* cB = (const char*)g.Bt + (size_t)cur.pn * tstep;
    PG8_STAGE(PG8_SB(0, 0), cB, voffB); PG8_STAGE(PG8_SA(0, 0), cA, voffA); PG8_STAGE(PG8_SB(0, 1), cB + hstep, voffB); PG8_STAGE(PG8_SA(0, 1), cA + hstep, voffA);
    if (wr == 1) PG8_BAR;
    PG8_WAIT_V(4); PG8_BAR;
    PG8_STAGE(PG8_SB(1, 0), cB + kstep, voffB); PG8_STAGE(PG8_SA(1, 0), cA + kstep, voffA); PG8_STAGE(PG8_SB(1, 1), cB + hstep + kstep, voffB);
    PG8_WAIT_V(6); PG8_BAR;
    for (;;) {
        const bool has_next = S.next(ui + 1, nxt);
        const char* nA = has_next ? (const char*)g.A + (size_t)nxt.pm * tstep : cA; const char* nB = has_next ? (const char*)g.Bt + (size_t)nxt.pn * tstep : cB;
        for (int t = 0; t < nt; t += 2) {
            const bool last = (t == nt - 2);
            const char* a1 = cA + (size_t)(t + 1) * kstep;
            const char* a2 = last ? nA : cA + (size_t)(t + 2) * kstep; const char* b2 = last ? nB : cB + (size_t)(t + 2) * kstep;
            const char* a3 = a2 + kstep; const char* b3 = b2 + kstep;
            PG8_LDB(B0, 0, 0); PG8_SCHED; PG8_LDA(At, 0, 0); PG8_STAGE(PG8_SA(1, 1), a1 + hstep, voffA);
            PG8_WAIT_L(8); PG8_BAR; PG8_WAIT_L(0); PG8_MMA(0, 0, At, B0); PG8_BAR; PG8_SCHED;
            PG8_LDB(B1, 0, 1); PG8_STAGE(PG8_SB(0, 0), b2, voffB);
            PG8_BAR; PG8_WAIT_L(0); PG8_MMA(0, 1, At, B1); PG8_BAR;
            PG8_LDA(At, 0, 1); PG8_STAGE(PG8_SA(0, 0), a2, voffA);
            PG8_BAR; PG8_WAIT_L(0); PG8_MMA(1, 0, At, B0); PG8_BAR; PG8_SCHED;
            PG8_STAGE(PG8_SB(0, 1), b2 + hstep, voffB);
            PG8_WAIT_V(6); PG8_BAR; PG8_MMA(1, 1, At, B1); PG8_BAR;
            PG8_LDB(B0, 1, 0); PG8_SCHED; PG8_LDA(At, 1, 0); PG8_STAGE(PG8_SA(0, 1), a2 + hstep, voffA);
            PG8_WAIT_L(8); PG8_BAR; PG8_WAIT_L(0); PG8_MMA(0, 0, At, B0); PG8_BAR; PG8_SCHED;
            PG8_LDB(B1, 1, 1); PG8_STAGE(PG8_SB(1, 0), b3, voffB);
            PG8_BAR; PG8_WAIT_L(0); PG8_MMA(0, 1, At, B1); PG8_BAR;
            PG8_LDA(At, 1, 1); PG8_STAGE(PG8_SA(1, 0), a3, voffA);
            PG8_BAR; PG8_WAIT_L(0); PG8_MMA(1, 0, At, B0); PG8_BAR; PG8_SCHED;
            PG8_STAGE(PG8_SB(1, 1), b3 + hstep, voffB);
            PG8_WAIT_V(6); PG8_BAR; PG8_MMA(1, 1, At, B1); PG8_BAR;
        }
        E(acc, cur, wr, wc, fr, fq);
        if (!has_next) break;
#pragma unroll
        for (int a = 0; a < 2; ++a)
#pragma unroll
            for (int b = 0; b < 2; ++b)
#pragma unroll
                for (int m = 0; m < 4; ++m)
#pragma unroll
                    for (int n = 0; n < 2; ++n) acc[a][b][m][n] = (f32x4){0.f, 0.f, 0.f, 0.f};
        cur = nxt; cA = nA; cB = nB; ++ui;
    }
    PG8_WAIT_V(0);
    if (wr == 0) PG8_BAR;
    PG8_BAR;
#undef PG8_SA
#undef PG8_SB
#undef PG8_STAGE
#undef PG8_LDA
#undef PG8_LDB
#undef PG8_MMA
#undef PG8_WAIT_V
#undef PG8_WAIT_L
#undef PG8_BAR
#undef PG8_SCHED
}
}

__device__ __forceinline__ void transpose_cvt(const float* __restrict__ W, bf16_t* __restrict__ Wt, int K, int N, float* sm) {
    int tid = threadIdx.x; asm volatile("" : "+v"(tid));
    const int tn = N >> 8, ntile = tn * (K >> 6);
    for (int tile = blockIdx.x; tile < ntile; tile += gridDim.x) {
        const int k0 = (tile / tn) << 6, n0 = (tile % tn) << 8;
        f32x4 v[8];
#pragma unroll
        for (int i = 0; i < 8; ++i) { const int idx = tid + i * 512; const int rest = idx >> 6; const int r = ((rest >> 3) << 3) + (idx & 7), c4 = ((rest & 7) << 3) + ((idx >> 3) & 7);
            v[i] = *(const f32x4*)(W + (size_t)(k0 + r) * N + n0 + c4 * 4); }
#pragma unroll
        for (int i = 0; i < 8; ++i) { const int idx = tid + i * 512; const int rest = idx >> 6; const int r = ((rest >> 3) << 3) + (idx & 7), c4 = ((rest & 7) << 3) + ((idx >> 3) & 7);
            float* d = sm + r * 257 + c4 * 4; d[0] = v[i][0]; d[1] = v[i][1]; d[2] = v[i][2]; d[3] = v[i][3]; }
        __syncthreads();
        const int ks = tid & 7;
#pragma unroll
        for (int i = 0; i < 4; ++i) { const int n = (tid >> 3) + 64 * i; float f[8];
#pragma unroll
            for (int j = 0; j < 8; ++j) f[j] = sm[(ks * 8 + j) * 257 + n];
            u32x4 w; w.x = cvt_pk_bf16(f[0], f[1]); w.y = cvt_pk_bf16(f[2], f[3]); w.z = cvt_pk_bf16(f[4], f[5]); w.w = cvt_pk_bf16(f[6], f[7]);
            *(u32x4*)(Wt + (size_t)(n0 + n) * K + k0 + ks * 8) = w; }
        __syncthreads();
    }
}

__device__ __forceinline__ void s5_params(const float* lam_re, const float* lam_im, const float* log_dt, const float* b_re, const float* b_im, float* S5A, float* S5B) {
    int tid = threadIdx.x; asm volatile("" : "+v"(tid));
    for (int idx = blockIdx.x * 512 + tid; idx < 8192; idx += gridDim.x * 512) {
        const float lr = fminf(lam_re[idx], -1e-4f), li = lam_im[idx], dt = expf(log_dt[idx >> 6]);
        const float mag = expf(lr * dt), th = li * dt;
        const float ar = mag * cosf(th), ai = mag * sinf(th);
        const float den = lr * lr + li * li;
        const float zr = ((ar - 1.0f) * lr + ai * li) / den, zi = (ai * lr - (ar - 1.0f) * li) / den;
        S5A[idx * 2] = ar; S5A[idx * 2 + 1] = ai;
#pragma unroll
        for (int c = 0; c < 16; ++c) { const float br = b_re[(size_t)idx * 16 + c], bi = b_im[(size_t)idx * 16 + c];
            S5B[(size_t)idx * 32 + c] = zr * br - zi * bi; S5B[(size_t)idx * 32 + 16 + c] = zr * bi + zi * br; }
    }
}

__device__ __forceinline__ void norm_phase(const float* __restrict__ h, const float* __restrict__ gain, bf16_t* __restrict__ xn) {
    int tid = threadIdx.x; asm volatile("" : "+v"(tid));
    const int lane = tid & 63, wave = tid >> 6;
    for (int row = blockIdx.x * 8 + wave; row < T; row += gridDim.x * 8) {
        const float* p = h + (size_t)row * 2048 + lane * 4;
        f32x4 v[8]; float ss = 0.f;
#pragma unroll
        for (int i = 0; i < 8; ++i) { v[i] = *(const f32x4*)(p + i * 256); ss += v[i][0] * v[i][0] + v[i][1] * v[i][1] + v[i][2] * v[i][2] + v[i][3] * v[i][3]; }
        ss = wave_sum(ss);
        const float r = rsqrtf(ss * (1.0f / 2048.0f) + 1e-6f);
#pragma unroll
        for (int i = 0; i < 8; ++i) { const f32x4 g = *(const f32x4*)(gain + i * 256 + lane * 4);
            u32x2 w; w.x = cvt_pk_bf16(v[i][0] * r * g[0], v[i][1] * r * g[1]); w.y = cvt_pk_bf16(v[i][2] * r * g[2], v[i][3] * r * g[3]);
            *(u32x2*)(xn + (size_t)row * 2048 + i * 256 + lane * 4) = w; }
    }
}

__device__ __forceinline__ float hgrn_lb(const float* lbp, int j, int ch) { return j == 0 ? 0.f : sigmoidf_(lbp[1024 + ch] - lbp[ch]); }

__device__ __forceinline__ void hgrn_p1(int item, const bf16_t* __restrict__ proj, const float* __restrict__ lbp, int j, float* __restrict__ HST, float* __restrict__ HDEC, float* sm) {
    int tid = threadIdx.x; asm volatile("" : "+v"(tid));
    const int c = item & 63, h = (item >> 6) & 7, b = item >> 9;
    const size_t tok0 = (size_t)b * SEQ + c * 64;
    float* KT = sm; float* V = sm + 8192; float* B = sm + 16384;
    {
        const int kg = tid & 15; float lb[8];
#pragma unroll
        for (int jj = 0; jj < 8; ++jj) lb[jj] = hgrn_lb(lbp, j, h * 128 + kg * 8 + jj);
#pragma unroll
        for (int i = 0; i < 2; ++i) { const int t = (tid + i * 512) >> 4;
            const bf16_t* rowp = proj + (tok0 + t) * 5120 + h * 128 + kg * 8;
            const u32x4 fw = *(const u32x4*)(rowp + 2048), vw = *(const u32x4*)(rowp + 3072);
            float f[8], v[8]; unpack8(fw, f); unpack8(vw, v);
#pragma unroll
            for (int jj = 0; jj < 8; ++jj) { const int k = kg * 8 + jj; const float fg = lb[jj] + (1.0f - lb[jj]) * sigmoidf_(f[jj]);
                B[t * 128 + k] = logf(fg); KT[t * 128 + k] = 1.0f - fg; V[t * 128 + k] = v[jj]; } }
    }
    __syncthreads();
    if (tid < 128) { float run = 0.f;
        for (int t = 0; t < 64; ++t) { run += B[t * 128 + tid]; B[t * 128 + tid] = run; } }
    __syncthreads();
#pragma unroll
    for (int i = 0; i < 16; ++i) { const int e = tid + i * 512; const int k = e & 127; KT[e] *= expf(B[63 * 128 + k] - B[e]); }
    if (tid < 128) HDEC[(size_t)item * 128 + tid] = expf(B[63 * 128 + tid]);
    __syncthreads();
    {
        const int k0 = (tid >> 4) * 4, v0 = (tid & 15) * 8;
        float acc[4][8];
#pragma unroll
        for (int i = 0; i < 4; ++i)
#pragma unroll
            for (int jj = 0; jj < 8; ++jj) acc[i][jj] = 0.f;
#pragma unroll 4
        for (int s = 0; s < 64; ++s) { const f32x4 a = *(const f32x4*)(KT + s * 128 + k0), b0 = *(const f32x4*)(V + s * 128 + v0), b1 = *(const f32x4*)(V + s * 128 + v0 + 4);
#pragma unroll
            for (int i = 0; i < 4; ++i)
#pragma unroll
                for (int jj = 0; jj < 4; ++jj) { acc[i][jj] += a[i] * b0[jj]; acc[i][4 + jj] += a[i] * b1[jj]; } }
        float* dst = HST + (size_t)item * 16384;
#pragma unroll
        for (int i = 0; i < 4; ++i) { *(f32x4*)(dst + (k0 + i) * 128 + v0) = (f32x4){acc[i][0], acc[i][1], acc[i][2], acc[i][3]}; *(f32x4*)(dst + (k0 + i) * 128 + v0 + 4) = (f32x4){acc[i][4], acc[i][5], acc[i][6], acc[i][7]}; }
    }
    __syncthreads();
}

__device__ __forceinline__ void hgrn_p2(float* __restrict__ HST, const float* __restrict__ HDEC) {
    int tid = threadIdx.x; asm volatile("" : "+v"(tid));
    for (int gid = blockIdx.x * 512 + tid; gid < 131072; gid += gridDim.x * 512) {
        const int bh = gid >> 13, off = (gid & 8191) * 2, k = off >> 7;
        f32x2 st = (f32x2){0.f, 0.f};
#pragma unroll 8
        for (int c = 0; c < 64; ++c) { const size_t idx = (size_t)bh * 64 + c; const float d = HDEC[idx * 128 + k];
            f32x2* p = (f32x2*)(HST + idx * 16384 + off); const f32x2 kv = *p; st = st * d + kv; *p = st; }
    }
}

__device__ __forceinline__ void hgrn_p3(int item, const bf16_t* __restrict__ proj, const float* __restrict__ lbp, int j, const float* __restrict__ HST, const float* __restrict__ ogain, bf16_t* __restrict__ ycat, float* sm) {
    int tid = threadIdx.x; asm volatile("" : "+v"(tid));
    const int c = item & 63, h = (item >> 6) & 7, b = item >> 9;
    const size_t tok0 = (size_t)b * SEQ + c * 64;
    float* BT = sm; float* QT = sm + 8704; float* KKT = sm + 2 * 8704; float* SCT = sm + 3 * 8704;
    {
        const int t = tid & 63;
#pragma unroll
        for (int i = 0; i < 2; ++i) { const int kg = (tid >> 6) + 8 * i;
            const bf16_t* rowp = proj + (tok0 + t) * 5120 + h * 128 + kg * 8;
            const u32x4 qw = *(const u32x4*)(rowp + 1024), fw = *(const u32x4*)(rowp + 2048);
            float q[8], f[8]; unpack8(qw, q); unpack8(fw, f);
#pragma unroll
            for (int jj = 0; jj < 8; ++jj) { const int k = kg * 8 + jj; const float lb = hgrn_lb(lbp, j, h * 128 + k); const float fg = lb + (1.0f - lb) * sigmoidf_(f[jj]);
                BT[k * 68 + t] = logf(fg) * LOG2E; KKT[k * 68 + t] = 1.0f - fg; QT[k * 68 + t] = q[jj] * sigmoidf_(q[jj]); } }
    }
    __syncthreads();
    if (tid < 128) { float run = 0.f;
#pragma unroll
        for (int t4 = 0; t4 < 16; ++t4) { f32x4 v = *(f32x4*)(BT + tid * 68 + t4 * 4); run += v[0]; v[0] = run; run += v[1]; v[1] = run; run += v[2]; v[2] = run; run += v[3]; v[3] = run; *(f32x4*)(BT + tid * 68 + t4 * 4) = v; } }
    __syncthreads();
    {
        const int kh = tid >> 8, tile = tid & 255, tt = tile >> 4, ss = tile & 15;
        float acc[4][4];
#pragma unroll
        for (int i = 0; i < 4; ++i)
#pragma unroll
            for (int jx = 0; jx < 4; ++jx) acc[i][jx] = 0.f;
        if (ss <= tt) {
#pragma unroll 2
            for (int k = kh * 64; k < kh * 64 + 64; ++k) {
                const f32x4 bt = *(const f32x4*)(BT + k * 68 + tt * 4), qt = *(const f32x4*)(QT + k * 68 + tt * 4), bs = *(const f32x4*)(BT + k * 68 + ss * 4), ks = *(const f32x4*)(KKT + k * 68 + ss * 4);
#pragma unroll
                for (int i = 0; i < 4; ++i)
#pragma unroll
                    for (int jx = 0; jx < 4; ++jx) acc[i][jx] += qt[i] * ks[jx] * ex2(fminf(bt[i] - bs[jx], 0.f));
            }
            if (ss == tt) {
#pragma unroll
                for (int i = 0; i < 4; ++i)
#pragma unroll
                    for (int jx = 0; jx < 4; ++jx) if (i < jx) acc[i][jx] = 0.f;
            }
        }
        if (kh == 0) {
#pragma unroll
            for (int jx = 0; jx < 4; ++jx) *(f32x4*)(SCT + (ss * 4 + jx) * 68 + tt * 4) = (f32x4){acc[0][jx], acc[1][jx], acc[2][jx], acc[3][jx]};
        }
        __syncthreads();
        if (kh == 1) {
#pragma unroll
            for (int jx = 0; jx < 4; ++jx) { f32x4* p = (f32x4*)(SCT + (ss * 4 + jx) * 68 + tt * 4); *p = *p + (f32x4){acc[0][jx], acc[1][jx], acc[2][jx], acc[3][jx]}; }
        }
    }
#pragma unroll
    for (int i = 0; i < 16; ++i) { const int e = tid + i * 512; const int k = e >> 6, t = e & 63; QT[k * 68 + t] *= ex2(BT[k * 68 + t]); }
    __syncthreads();
    float* V = BT;
    {
        const int kg = tid & 15;
#pragma unroll
        for (int i = 0; i < 2; ++i) { const int t = (tid + i * 512) >> 4;
            const u32x4 vw = *(const u32x4*)(proj + (tok0 + t) * 5120 + 3072 + h * 128 + kg * 8); float v[8]; unpack8(vw, v);
            *(f32x4*)(V + t * 128 + kg * 8) = (f32x4){v[0], v[1], v[2], v[3]}; *(f32x4*)(V + t * 128 + kg * 8 + 4) = (f32x4){v[4], v[5], v[6], v[7]}; }
    }
    __syncthreads();
    {
        const int tt = tid >> 5, v0 = (tid & 31) * 4;
        float acc[4][4];
#pragma unroll
        for (int i = 0; i < 4; ++i)
#pragma unroll
            for (int jx = 0; jx < 4; ++jx) acc[i][jx] = 0.f;
#pragma unroll 4
        for (int s = 0; s < 64; ++s) { const f32x4 a = *(const f32x4*)(SCT + s * 68 + tt * 4), bq = *(const f32x4*)(V + s * 128 + v0);
#pragma unroll
            for (int i = 0; i < 4; ++i)
#pragma unroll
                for (int jx = 0; jx < 4; ++jx) acc[i][jx] += a[i] * bq[jx]; }
        if (c > 0) { const float* P = HST + (size_t)(item - 1) * 16384 + v0;
#pragma unroll 8
            for (int k = 0; k < 128; ++k) { const f32x4 a = *(const f32x4*)(QT + k * 68 + tt * 4), bq = *(const f32x4*)(P + k * 128);
#pragma unroll
                for (int i = 0; i < 4; ++i)
#pragma unroll
                    for (int jx = 0; jx < 4; ++jx) acc[i][jx] += a[i] * bq[jx]; } }
        const f32x4 gn = *(const f32x4*)(ogain + v0);
#pragma unroll
        for (int i = 0; i < 4; ++i) { float ssq = acc[i][0] * acc[i][0] + acc[i][1] * acc[i][1] + acc[i][2] * acc[i][2] + acc[i][3] * acc[i][3];
#pragma unroll
            for (int o = 16; o > 0; o >>= 1) ssq += __shfl_xor(ssq, o);
            const float r = rsqrtf(ssq * (1.0f / 128.0f) + 1e-6f);
            const size_t tok = tok0 + tt * 4 + i;
            const u32x2 gw = *(const u32x2*)(proj + tok * 5120 + 4096 + h * 128 + v0);
            const float g0 = bflo(gw.x), g1 = bfhi(gw.x), g2 = bflo(gw.y), g3 = bfhi(gw.y);
            u32x2 w; w.x = cvt_pk_bf16(acc[i][0] * r * gn[0] * g0 * sigmoidf_(g0), acc[i][1] * r * gn[1] * g1 * sigmoidf_(g1));
            w.y = cvt_pk_bf16(acc[i][2] * r * gn[2] * g2 * sigmoidf_(g2), acc[i][3] * r * gn[3] * g3 * sigmoidf_(g3));
            *(u32x2*)(ycat + tok * 2048 + 1024 + h * 128 + v0) = w; }
    }
    __syncthreads();
}

__device__ __forceinline__ void s5_load_u(const bf16_t* __restrict__ proj, size_t tok0, int g, int lane, float* Uw) {
    const bf16_t* rowp = proj + (tok0 + lane) * 5120 + g * 16;
    const u32x4 w0 = *(const u32x4*)rowp, w1 = *(const u32x4*)(rowp + 8); float a[8], b[8]; unpack8(w0, a); unpack8(w1, b);
    *(f32x4*)(Uw + lane * 16) = (f32x4){a[0], a[1], a[2], a[3]}; *(f32x4*)(Uw + lane * 16 + 4) = (f32x4){a[4], a[5], a[6], a[7]};
    *(f32x4*)(Uw + lane * 16 + 8) = (f32x4){b[0], b[1], b[2], b[3]}; *(f32x4*)(Uw + lane * 16 + 12) = (f32x4){b[4], b[5], b[6], b[7]};
}
#define S5_STEP(t_) do { const f32x4 u0 = *(const f32x4*)(Uw + (t_) * 16), u1 = *(const f32x4*)(Uw + (t_) * 16 + 4), u2 = *(const f32x4*)(Uw + (t_) * 16 + 8), u3 = *(const f32x4*)(Uw + (t_) * 16 + 12); \
        float bur = 0.f, bui = 0.f; \
        _Pragma("unroll") for (int q_ = 0; q_ < 4; ++q_) { bur += bbr[q_] * u0[q_]; bui += bbi[q_] * u0[q_]; } \
        _Pragma("unroll") for (int q_ = 0; q_ < 4; ++q_) { bur += bbr[4 + q_] * u1[q_]; bui += bbi[4 + q_] * u1[q_]; } \
        _Pragma("unroll") for (int q_ = 0; q_ < 4; ++q_) { bur += bbr[8 + q_] * u2[q_]; bui += bbi[8 + q_] * u2[q_]; } \
        _Pragma("unroll") for (int q_ = 0; q_ < 4; ++q_) { bur += bbr[12 + q_] * u3[q_]; bui += bbi[12 + q_] * u3[q_]; } \
        const float nxr = ar * xr - ai * xi + bur, nxi = ar * xi + ai * xr + bui; xr = nxr; xi = nxi; } while (0)

__device__ __forceinline__ void s5_p1(int item, const bf16_t* __restrict__ proj, const float* __restrict__ S5A, const float* __restrict__ S5B, float* __restrict__ S5F, float* sm) {
    int tid = threadIdx.x; asm volatile("" : "+v"(tid));
    const int wave = tid >> 6, lane = tid & 63;
    const int sg = item & 7, g = (item >> 3) & 63, b = item >> 9;
    const int seg = sg * 8 + wave; const size_t tok0 = (size_t)b * SEQ + seg * 64;
    float* Uw = sm + wave * 1024;
    s5_load_u(proj, tok0, g, lane, Uw);
    float bbr[16], bbi[16];
    { const float* bb = S5B + (size_t)(g * 64 + lane) * 32;
#pragma unroll
      for (int q = 0; q < 4; ++q) { const f32x4 r = *(const f32x4*)(bb + q * 4), im = *(const f32x4*)(bb + 16 + q * 4);
#pragma unroll
          for (int e = 0; e < 4; ++e) { bbr[q * 4 + e] = r[e]; bbi[q * 4 + e] = im[e]; } } }
    const float ar = S5A[(g * 64 + lane) * 2], ai = S5A[(g * 64 + lane) * 2 + 1];
    __syncthreads();
    float xr = 0.f, xi = 0.f;
#pragma unroll 4
    for (int t = 0; t < 64; ++t) S5_STEP(t);
    *(f32x2*)(S5F + ((size_t)((b * 64 + g) * 64 + seg) * 64 + lane) * 2) = (f32x2){xr, xi};
    __syncthreads();
}

__device__ __forceinline__ float gelu_tanh(float y) { const float z = 0.7978845608028654f * (y + 0.044715f * y * y * y); const float e = __expf(2.0f * z); return 0.5f * y * (2.0f - 2.0f / (1.0f + e)); }

__device__ __forceinline__ void s5_p2(int item, const bf16_t* __restrict__ proj, const float* __restrict__ S5A, const float* __restrict__ S5B, const float* __restrict__ S5F,
                                      const float* __restrict__ c_re, const float* __restrict__ c_im, const float* __restrict__ dsk, bf16_t* __restrict__ ys5, float* sm) {
    int tid = threadIdx.x; asm volatile("" : "+v"(tid));
    const int wave = tid >> 6, lane = tid & 63;
    const int sg = item & 7, g = (item >> 3) & 63, b = item >> 9;
    const int seg = sg * 8 + wave; const size_t tok0 = (size_t)b * SEQ + seg * 64;
    float* Cre = sm; float* Cim = sm + 1024;
    float* Uw = sm + 2048 + wave * 3584; float* Xre = Uw + 1024; float* Xim = Xre + 1280;
#pragma unroll
    for (int i = 0; i < 2; ++i) { const int e = tid + i * 512; const int cc = e >> 6, p = e & 63; Cre[p * 16 + cc] = c_re[(size_t)g * 1024 + e]; Cim[p * 16 + cc] = c_im[(size_t)g * 1024 + e]; }
    s5_load_u(proj, tok0, g, lane, Uw);
    float bbr[16], bbi[16];
    { const float* bb = S5B + (size_t)(g * 64 + lane) * 32;
#pragma unroll
      for (int q = 0; q < 4; ++q) { const f32x4 r = *(const f32x4*)(bb + q * 4), im = *(const f32x4*)(bb + 16 + q * 4);
#pragma unroll
          for (int e = 0; e < 4; ++e) { bbr[q * 4 + e] = r[e]; bbi[q * 4 + e] = im[e]; } } }
    const float ar = S5A[(g * 64 + lane) * 2], ai = S5A[(g * 64 + lane) * 2 + 1];
    float xr = 0.f, xi = 0.f;
    { float pr = ar, pi = ai;
#pragma unroll
      for (int q = 0; q < 6; ++q) { const float nr = pr * pr - pi * pi, ni = 2.0f * pr * pi; pr = nr; pi = ni; }
      const float* F = S5F + ((size_t)((b * 64 + g) * 64) * 64 + lane) * 2;
      for (int js = 0; js < seg; ++js) { const f32x2 f = *(const f32x2*)(F + (size_t)js * 128); const float nr = pr * xr - pi * xi + f[0], ni = pr * xi + pi * xr + f[1]; xr = nr; xi = ni; } }
    __syncthreads();
    const int cch = lane & 15, tq = lane >> 4;
    const float dv = dsk[g * 16 + cch];
    for (int sub = 0; sub < 4; ++sub) {
#pragma unroll
        for (int t4 = 0; t4 < 4; ++t4) { f32x4 vr, vi;
#pragma unroll
            for (int q = 0; q < 4; ++q) { S5_STEP(sub * 16 + t4 * 4 + q); vr[q] = xr; vi[q] = xi; }
            *(f32x4*)(Xre + lane * 20 + t4 * 4) = vr; *(f32x4*)(Xim + lane * 20 + t4 * 4) = vi; }
        __syncthreads();
        float acc[4] = {0.f, 0.f, 0.f, 0.f};
#pragma unroll 8
        for (int p = 0; p < 64; ++p) { const f32x4 a = *(const f32x4*)(Xre + p * 20 + tq * 4), bq = *(const f32x4*)(Xim + p * 20 + tq * 4); const float cr = Cre[p * 16 + cch], ci = Cim[p * 16 + cch];
#pragma unroll
            for (int q = 0; q < 4; ++q) acc[q] += a[q] * cr - bq[q] * ci; }
#pragma unroll
        for (int q = 0; q < 4; ++q) { const int t = sub * 16 + tq * 4 + q; const float y = acc[q] + dv * Uw[t * 16 + cch];
            ys5[(tok0 + t) * 1024 + g * 16 + cch] = f2bf(gelu_tanh(y)); }
        __syncthreads();
    }
}

__device__ __forceinline__ void attn_item(int item, const bf16_t* __restrict__ qkv, const float* __restrict__ qg, const float* __restrict__ kg, const float* __restrict__ sinks, bf16_t* __restrict__ ycat, float* sm) {
    int tid = threadIdx.x; asm volatile("" : "+v"(tid));
    const int wave = tid >> 6, lane = tid & 63;
    const int qb = item & 63, kvh = (item >> 6) & 3, b = item >> 8;
    const int q0 = qb * 64; const size_t tokb = (size_t)b * SEQ;
    float* Ks = sm; float* Vs = sm + 191 * 64;
#pragma unroll
    for (int i = 0; i < 3; ++i) { const int idx = tid + i * 512; const int kidx = idx >> 3, dg = idx & 7; const int s = q0 - 127 + kidx; const bool ok = (idx < 1528) && (s >= 0);
        u32x4 kw = (u32x4){0u, 0u, 0u, 0u}, vw = kw;
        if (ok) { const bf16_t* rp = qkv + (tokb + s) * 2560 + kvh * 64 + dg * 8; kw = *(const u32x4*)(rp + 2048); vw = *(const u32x4*)(rp + 2304); }
        float k[8], v[8]; unpack8(kw, k); unpack8(vw, v);
        float ss = 0.f;
#pragma unroll
        for (int jj = 0; jj < 8; ++jj) ss += k[jj] * k[jj];
        ss += __shfl_xor(ss, 1); ss += __shfl_xor(ss, 2); ss += __shfl_xor(ss, 4);
        const float r = rsqrtf(ss * (1.0f / 64.0f) + 1e-6f);
        if (idx < 1528) {
            const f32x4 g0 = *(const f32x4*)(kg + dg * 8), g1 = *(const f32x4*)(kg + dg * 8 + 4);
            *(f32x4*)(Ks + kidx * 64 + dg * 8) = (f32x4){k[0] * r * g0[0], k[1] * r * g0[1], k[2] * r * g0[2], k[3] * r * g0[3]};
            *(f32x4*)(Ks + kidx * 64 + dg * 8 + 4) = (f32x4){k[4] * r * g1[0], k[5] * r * g1[1], k[6] * r * g1[2], k[7] * r * g1[3]};
            *(f32x4*)(Vs + kidx * 64 + dg * 8) = (f32x4){v[0], v[1], v[2], v[3]}; *(f32x4*)(Vs + kidx * 64 + dg * 8 + 4) = (f32x4){v[4], v[5], v[6], v[7]}; } }
    const int tq = lane & 7, gh = lane >> 3; const int t = q0 + wave * 8 + tq, hq = kvh * 8 + gh;
    float q[64];
    { const bf16_t* qp = qkv + (tokb + t) * 2560 + hq * 64; float ss = 0.f;
#pragma unroll
      for (int i = 0; i < 8; ++i) { const u32x4 w = *(const u32x4*)(qp + i * 8); float f[8]; unpack8(w, f);
#pragma unroll
          for (int jj = 0; jj < 8; ++jj) { q[i * 8 + jj] = f[jj]; ss += f[jj] * f[jj]; } }
      const float r = rsqrtf(ss * (1.0f / 64.0f) + 1e-6f) * 0.125f * LOG2E;
#pragma unroll
      for (int i = 0; i < 16; ++i) { const f32x4 g = *(const f32x4*)(qg + i * 4);
#pragma unroll
          for (int e = 0; e < 4; ++e) q[i * 4 + e] *= r * g[e]; } }
    const float slope2 = exp2f(-0.25f * (float)(hq + 1)) * LOG2E;
    float m = sinks[hq] * LOG2E, l = 1.0f;
    float acc[64];
#pragma unroll
    for (int d = 0; d < 64; ++d) acc[d] = 0.f;
    __syncthreads();
#pragma unroll 1
    for (int kk = 0; kk < 135; ++kk) {
        const int kidx = wave * 8 + kk;
        if (q0 - 127 + kidx < 0) continue;
        const int dist = tq + 127 - kk;
        const float* kp = Ks + kidx * 64;
        float dot = 0.f;
#pragma unroll
        for (int i = 0; i < 16; ++i) { const f32x4 kv = *(const f32x4*)(kp + i * 4); dot += q[i * 4] * kv[0] + q[i * 4 + 1] * kv[1] + q[i * 4 + 2] * kv[2] + q[i * 4 + 3] * kv[3]; }
        if (dist >= 0 && dist < 128) {
            const float sc = dot - slope2 * (float)dist;
            if (sc > m) { const float corr = ex2(m - sc); l *= corr;
#pragma unroll
                for (int d = 0; d < 64; ++d) acc[d] *= corr;
                m = sc; }
            const float p = ex2(sc - m); l += p;
            const float* vp = Vs + kidx * 64;
#pragma unroll
            for (int i = 0; i < 16; ++i) { const f32x4 vv = *(const f32x4*)(vp + i * 4); acc[i * 4] += p * vv[0]; acc[i * 4 + 1] += p * vv[1]; acc[i * 4 + 2] += p * vv[2]; acc[i * 4 + 3] += p * vv[3]; }
        }
    }
    { const float inv = 1.0f / l; bf16_t* op = ycat + (tokb + t) * 2048 + hq * 64;
#pragma unroll
      for (int i = 0; i < 8; ++i) { u32x4 w; w.x = cvt_pk_bf16(acc[i * 8] * inv, acc[i * 8 + 1] * inv); w.y = cvt_pk_bf16(acc[i * 8 + 2] * inv, acc[i * 8 + 3] * inv);
          w.z = cvt_pk_bf16(acc[i * 8 + 4] * inv, acc[i * 8 + 5] * inv); w.w = cvt_pk_bf16(acc[i * 8 + 6] * inv, acc[i * 8 + 7] * inv); *(u32x4*)(op + i * 8) = w; } }
    __syncthreads();
}

struct Args { const float* in[25]; float* out; unsigned char* ws; int ph_lo, ph_hi; };

__global__ void __launch_bounds__(512, 2) mega(Args a) {
    extern __shared__ __attribute__((aligned(16))) unsigned char lds[];
    float* sm = (float*)lds;
    unsigned char* ws = a.ws;
    bf16_t* Win_t = (bf16_t*)(ws + WS_WIN); bf16_t* Wglu_t = (bf16_t*)(ws + WS_WGLU); bf16_t* WoE_t = (bf16_t*)(ws + WS_WOE); bf16_t* Wqkv_t = (bf16_t*)(ws + WS_WQKV);
    bf16_t* WoO_t = (bf16_t*)(ws + WS_WOO); bf16_t* Wup_t = (bf16_t*)(ws + WS_WUP); bf16_t* Wdn_t = (bf16_t*)(ws + WS_WDN);
    bf16_t* XN = (bf16_t*)(ws + WS_XN); bf16_t* PROJ = (bf16_t*)(ws + WS_PROJ); bf16_t* YCAT = (bf16_t*)(ws + WS_YCAT); bf16_t* YS5 = (bf16_t*)(ws + WS_YS5); bf16_t* HID = (bf16_t*)(ws + WS_HID);
    float* HST = (float*)(ws + WS_HST); float* HDEC = (float*)(ws + WS_HDEC); float* S5F = (float*)(ws + WS_S5F); float* S5A = (float*)(ws + WS_S5A); float* S5B = (float*)(ws + WS_S5B);
    const int G = gridDim.x, bid = blockIdx.x;

    for (int ph = a.ph_lo; ph < a.ph_hi; ++ph) {
        if (ph == 0) {
            for (int j = 0; j < 2; ++j) {
                transpose_cvt(a.in[2] + (size_t)j * 2048 * 5120, Win_t + (size_t)j * 5120 * 2048, 2048, 5120, sm);
                transpose_cvt(a.in[11] + (size_t)j * 1024 * 1024, Wglu_t + (size_t)j * 1024 * 1024, 1024, 1024, sm);
                transpose_cvt(a.in[15] + (size_t)j * 2048 * 2048, WoE_t + (size_t)j * 2048 * 2048, 2048, 2048, sm);
                transpose_cvt(a.in[17] + (size_t)j * 2048 * 2560, Wqkv_t + (size_t)j * 2560 * 2048, 2048, 2560, sm);
                transpose_cvt(a.in[21] + (size_t)j * 2048 * 2048, WoO_t + (size_t)j * 2048 * 2048, 2048, 2048, sm);
            }
            for (int l = 0; l < 4; ++l) {
                transpose_cvt(a.in[23] + (size_t)l * 2048 * 8192, Wup_t + (size_t)l * 8192 * 2048, 2048, 8192, sm);
                transpose_cvt(a.in[24] + (size_t)l * 8192 * 2048, Wdn_t + (size_t)l * 2048 * 8192, 8192, 2048, sm);
            }
            s5_params(a.in[3], a.in[4], a.in[5], a.in[6], a.in[7], S5A, S5B);
        } else {
            const int q = ph - 1, pair = q / 17, r = q % 17;
            const bool odd = r >= 10; const int layer = pair * 2 + (odd ? 1 : 0), j = pair; const int rr = odd ? r - 10 : r;
            int kind;
            if (!odd) kind = rr; else { const int map[7] = {0, 1, 10, 6, 7, 8, 9}; kind = rr == 0 ? 0 : rr == 1 ? 1 : rr == 2 ? 10 : rr == 3 ? 6 : rr == 4 ? 7 : rr == 5 ? 8 : 9; (void)map; }
            const float* hin = (layer == 0) ? a.in[0] : a.out;
            switch (kind) {
            case 0: norm_phase(hin, (odd ? a.in[16] : a.in[1]) + (size_t)j * 2048, XN); break;
            case 7: norm_phase(a.out, a.in[22] + (size_t)layer * 2048, XN); break;
            case 1: case 8: {
                pg8::Gemm g; pg8::EpiBf16 E;
                if (kind == 8) { g = pg8::Gemm{XN, Wup_t + (size_t)layer * 8192 * 2048, T, 8192, 2048}; E = pg8::EpiBf16{HID, 8192, 1}; }
                else if (!odd) { g = pg8::Gemm{XN, Win_t + (size_t)j * 5120 * 2048, T, 5120, 2048}; E = pg8::EpiBf16{PROJ, 5120, 0}; }
                else { g = pg8::Gemm{XN, Wqkv_t + (size_t)j * 2560 * 2048, T, 2560, 2048}; E = pg8::EpiBf16{PROJ, 2560, 0}; }
                pg8::StaticOrder S; S.init(g.M, g.N, G, bid);
                pg8::gemm_phase<pg8::EpiBf16>((LAS unsigned char*)lds, g, S, E);
            } break;
            case 5: {
                pg8::Gemm g{YS5, Wglu_t + (size_t)j * 1024 * 1024, T, 1024, 1024}; pg8::EpiGlu E{YS5, a.in[12] + (size_t)j * 1024, YCAT, 2048};
                pg8::StaticOrder S; S.init(g.M, g.N, G, bid);
                pg8::gemm_phase<pg8::EpiGlu>((LAS unsigned char*)lds, g, S, E);
            } break;
            case 6: case 9: {
                pg8::Gemm g;
                if (kind == 9) g = pg8::Gemm{HID, Wdn_t + (size_t)layer * 2048 * 8192, T, 2048, 8192};
                else g = pg8::Gemm{YCAT, (odd ? WoO_t : WoE_t) + (size_t)j * 2048 * 2048, T, 2048, 2048};
                pg8::EpiResid E{kind == 9 ? (const float*)a.out : hin, a.out};
                pg8::StaticOrder S; S.init(g.M, g.N, G, bid);
                pg8::gemm_phase<pg8::EpiResid>((LAS unsigned char*)lds, g, S, E);
            } break;
            case 2:
                for (int it = bid; it < 1024; it += G) hgrn_p1(it, PROJ, a.in[13], j, HST, HDEC, sm);
                for (int it = bid; it < 1024; it += G) s5_p1(it, PROJ, S5A + (size_t)j * 8192, S5B + (size_t)j * 131072, S5F, sm);
                break;
            case 3: hgrn_p2(HST, HDEC); break;
            case 4:
                for (int it = bid; it < 1024; it += G) hgrn_p3(it, PROJ, a.in[13], j, HST, a.in[14] + (size_t)j * 128, YCAT, sm);
                for (int it = bid; it < 1024; it += G) s5_p2(it, PROJ, S5A + (size_t)j * 8192, S5B + (size_t)j * 131072, S5F, a.in[8] + (size_t)j * 65536, a.in[9] + (size_t)j * 65536, a.in[10] + (size_t)j * 1024, YS5, sm);
                break;
            case 10:
                for (int it = bid; it < 512; it += G) attn_item(it, PROJ, a.in[18] + (size_t)j * 64, a.in[19] + (size_t)j * 64, a.in[20] + (size_t)j * 32, YCAT, sm);
                break;
            default: break;
            }
        }
        if (ph + 1 < a.ph_hi) cg::this_grid().sync();
    }
}

extern "C" void kernel_launch(void* const* d_in, const int* in_sizes, int n_in, void* d_out, int out_size, void* d_ws, size_t ws_size, hipStream_t stream) {
    static int grid = 0;
    if (grid == 0) {
        if (n_in != 25 || ws_size < WS_END) { fprintf(stderr, "kernel_launch: need 25 inputs and %zu bytes of workspace; got %d, %zu\n", (size_t)WS_END, n_in, ws_size); grid = -1; return; }
        int dev = 0, cus = 0, per_cu = 0;
        hipGetDevice(&dev); hipDeviceGetAttribute(&cus, hipDeviceAttributeMultiprocessorCount, dev);
        if (hipFuncSetAttribute((const void*)mega, hipFuncAttributeMaxDynamicSharedMemorySize, LDS_BYTES) != hipSuccess) { fprintf(stderr, "kernel_launch: hipFuncSetAttribute failed\n"); grid = -1; return; }
        if (hipOccupancyMaxActiveBlocksPerMultiprocessor(&per_cu, (const void*)mega, 512, LDS_BYTES) != hipSuccess || per_cu < 1) { fprintf(stderr, "kernel_launch: occupancy query says %d\n", per_cu); per_cu = 1; }
        (void)hipGetLastError();
        grid = cus > 0 ? cus : 256;
    }
    if (grid < 0) return;
    Args a{};
    for (int i = 0; i < 25; ++i) a.in[i] = (const float*)d_in[i];
    a.out = (float*)d_out; a.ws = (unsigned char*)d_ws;
#if MK_ONE_LAUNCH
    a.ph_lo = 0; a.ph_hi = NPH;
    void* args[] = {&a};
    hipError_t e = hipLaunchCooperativeKernel((const void*)mega, dim3(grid), dim3(512), args, LDS_BYTES, stream);
    if (e != hipSuccess) fprintf(stderr, "kernel_launch: cooperative launch failed: %s (grid %d)\n", hipGetErrorString(e), grid);
#else
    for (int ph = 0; ph < NPH; ++ph) { a.ph_lo = ph; a.ph_hi = ph + 1; hipLaunchKernelGGL(mega, dim3(grid), dim3(512), LDS_BYTES, stream, a); }
#endif
}
```

```cpp
#include <hip/hip_runtime.h>
#include <hip/hip_cooperative_groups.h>
#include <cstdio>
namespace cg = cooperative_groups;

#ifndef REP_MASK
#define REP_MASK 0
#endif
#ifndef H3REP
#define H3REP 0
#endif
#ifndef REP2
#define REP2 0
#endif
#ifndef GEMM_SP2
#define GEMM_SP2 true
#endif
#ifndef MK_ONE_LAUNCH
#define MK_ONE_LAUNCH 1
#endif

#define LAS __attribute__((address_space(3)))
typedef unsigned short bf16_t;
typedef short bf16x8 __attribute__((ext_vector_type(8)));
typedef float f32x4 __attribute__((ext_vector_type(4)));
typedef float f32x2 __attribute__((ext_vector_type(2)));
typedef unsigned u32x4 __attribute__((ext_vector_type(4)));
typedef unsigned u32x2 __attribute__((ext_vector_type(2)));

constexpr int T = 8192, SEQ = 4096;
constexpr int NPH = 27;
constexpr int LDS_STAGE = 135168;
constexpr int LDS_BYTES = LDS_STAGE + 16;
constexpr int XCD_BAR_WORDS_C = 3456;
constexpr float LOG2E = 1.4426950408889634f;

constexpr size_t SZ_WIN = (size_t)5120 * 2048 * 2, SZ_WGLU = (size_t)1024 * 1024 * 2, SZ_WSQ = (size_t)2048 * 2048 * 2, SZ_WQKV = (size_t)2560 * 2048 * 2, SZ_WUP = (size_t)8192 * 2048 * 2;
constexpr size_t WS_WIN = 0;
constexpr size_t WS_WGLU = WS_WIN + 2 * SZ_WIN;
constexpr size_t WS_WOE = WS_WGLU + 2 * SZ_WGLU;
constexpr size_t WS_WQKV = WS_WOE + 2 * SZ_WSQ;
constexpr size_t WS_WOO = WS_WQKV + 2 * SZ_WQKV;
constexpr size_t WS_WUP = WS_WOO + 2 * SZ_WSQ;
constexpr size_t WS_WDN = WS_WUP + 4 * SZ_WUP;
constexpr size_t WS_XN = WS_WDN + 4 * SZ_WUP;
constexpr size_t WS_PROJ = WS_XN + (size_t)T * 2048 * 2;
constexpr size_t WS_YCAT = WS_PROJ + (size_t)T * 5120 * 2;
constexpr size_t WS_YS5 = WS_YCAT + (size_t)T * 2048 * 2;
constexpr size_t WS_HID = WS_YS5 + (size_t)T * 1024 * 2;
constexpr size_t WS_HST = WS_HID + (size_t)T * 8192 * 2;
constexpr size_t WS_HDEC = WS_HST + (size_t)16 * 64 * 16384 * 4;
constexpr size_t WS_S5F = WS_HDEC + (size_t)16 * 64 * 128 * 4;
constexpr size_t WS_S5A = WS_S5F + (size_t)128 * 64 * 64 * 2 * 4;
constexpr size_t WS_S5B = WS_S5A + (size_t)2 * 64 * 64 * 2 * 4;
constexpr size_t WS_RS = WS_S5B + (size_t)2 * 64 * 64 * 32 * 4;
constexpr size_t WS_BAR = WS_RS + (size_t)9 * T * 32 * 4;
constexpr size_t WS_END = WS_BAR + (size_t)XCD_BAR_WORDS_C * 4;


__device__ __forceinline__ unsigned cvt_pk_bf16(float lo, float hi) { unsigned r; asm volatile("v_cvt_pk_bf16_f32 %0, %1, %2" : "=v"(r) : "v"(lo), "v"(hi)); return r; }
__device__ __forceinline__ unsigned short f2bf(float f) { unsigned u = __builtin_bit_cast(unsigned, f); return (unsigned short)((u + 0x7fffu + ((u >> 16) & 1u)) >> 16); }
__device__ __forceinline__ float bflo(unsigned w) { return __builtin_bit_cast(float, w << 16); }
__device__ __forceinline__ float bfhi(unsigned w) { return __builtin_bit_cast(float, w & 0xffff0000u); }
__device__ __forceinline__ void unpack8(u32x4 w, float (&f)[8]) {
    f[0] = bflo(w.x); f[1] = bfhi(w.x); f[2] = bflo(w.y); f[3] = bfhi(w.y); f[4] = bflo(w.z); f[5] = bfhi(w.z); f[6] = bflo(w.w); f[7] = bfhi(w.w);
}
__device__ __forceinline__ float wave_sum(float v) {
#pragma unroll
    for (int o = 32; o > 0; o >>= 1) v += __shfl_xor(v, o);
    return v;
}
__device__ __forceinline__ float sigmoidf_(float x) { return __builtin_amdgcn_rcpf(1.0f + __expf(-x)); }
__device__ __forceinline__ float ex2(float x) { return __builtin_amdgcn_exp2f(x); }

namespace pg8 {
constexpr int BM = 256, BK = 64, HALF = 128, HTB = HALF * BK * 2, STAGE_BYTES = 8 * HTB, NXCD = 8, WGM = 8;
__device__ __forceinline__ int lds_byte(int r, int c) { const int st = (r >> 4) * 2 + (c >> 5), rr = r & 15, cc = c & 31, ob = rr * 64 + cc * 2; return st * 1024 + (ob ^ (((ob >> 9) & 1) << 5)); }
__device__ __forceinline__ void stage_rc(int b, int& R, int& C) { const int st = b / 1024, sb = b % 1024, swz = sb ^ (((sb >> 9) & 1) << 5); R = (st >> 1) * 16 + swz / 64; C = (st & 1) * 32 + (swz % 64) / 2; }
__device__ __forceinline__ int perm32(int rho) { const int n = rho >> 4, i = rho & 15; return 8 * (i >> 2) + 4 * n + (i & 3); }

struct Unit { int pm, pn; };
struct Gemm { const bf16_t* A; const bf16_t* Bt; int M, N, K; };

struct StaticOrder {
    int nM, nN, nwg, G, c;
    __device__ void init(int M, int N, int G_, int c_) { nM = M / BM; nN = N / BM; nwg = nM * nN; G = G_; c = c_; }
    __device__ bool next(int i, Unit& u) const {
        const long L = (long)i * G + c; if (L >= nwg) return false;
        int wgid = (int)L; { const int q = nwg / NXCD, r = nwg % NXCD, xcd = wgid % NXCD, off = wgid / NXCD; wgid = (xcd < r ? xcd * (q + 1) : r * (q + 1) + (xcd - r) * q) + off; }
        const int nig = WGM * nN, gid = wgid / nig, fm = gid * WGM, gsz = (nM - fm) < WGM ? (nM - fm) : WGM;
        u.pm = fm + ((wgid % nig) % gsz); u.pn = (wgid % nig) / gsz; return true;
    }
};

struct EpiBf16 {
    static constexpr bool PERM = true;
    bf16_t* O; int ldc; int act; const float* rl;
    __device__ __forceinline__ void operator()(const f32x4 (&acc)[2][2][4][2], const Unit& u, int ui, int wr, int wc, int fr, int fq) const {
        const int row0 = u.pm * BM + wr * 64 + fr, col0 = u.pn * BM + wc * 32 + 8 * fq;
#pragma unroll
        for (int ai = 0; ai < 2; ++ai)
#pragma unroll
            for (int m = 0; m < 4; ++m) { const int row = row0 + ai * HALF + m * 16; bf16_t* rowp = O + (size_t)row * ldc + col0;
                const float r = rl[ui * 256 + wr * 64 + fr + ai * HALF + m * 16];
#pragma unroll
                for (int bj = 0; bj < 2; ++bj) { f32x4 v0 = acc[ai][bj][m][0] * r, v1 = acc[ai][bj][m][1] * r;
                    if (act) {
#pragma unroll
                        for (int j = 0; j < 4; ++j) { float a = fmaxf(v0[j], 0.f), b = fmaxf(v1[j], 0.f); v0[j] = a * a; v1[j] = b * b; } }
                    u32x4 w; w.x = cvt_pk_bf16(v0[0], v0[1]); w.y = cvt_pk_bf16(v0[2], v0[3]); w.z = cvt_pk_bf16(v1[0], v1[1]); w.w = cvt_pk_bf16(v1[2], v1[3]);
                    *(u32x4*)(rowp + bj * HALF) = w; } }
    }
};
struct EpiGlu {
    static constexpr bool PERM = true;
    const bf16_t* Y; const float* bias; bf16_t* O; int ldo;
    __device__ __forceinline__ void operator()(const f32x4 (&acc)[2][2][4][2], const Unit& u, int ui, int wr, int wc, int fr, int fq) const {
        const int row0 = u.pm * BM + wr * 64 + fr, col0 = u.pn * BM + wc * 32 + 8 * fq;
        f32x4 bb[2][2];
#pragma unroll
        for (int bj = 0; bj < 2; ++bj) { bb[bj][0] = *(const f32x4*)(bias + col0 + bj * HALF); bb[bj][1] = *(const f32x4*)(bias + col0 + bj * HALF + 4); }
#pragma unroll
        for (int ai = 0; ai < 2; ++ai) { u32x4 yw[4][2];
#pragma unroll
            for (int m = 0; m < 4; ++m)
#pragma unroll
                for (int bj = 0; bj < 2; ++bj) yw[m][bj] = *(const u32x4*)(Y + (size_t)(row0 + ai * HALF + m * 16) * 1024 + col0 + bj * HALF);
#pragma unroll
            for (int m = 0; m < 4; ++m) { const int row = row0 + ai * HALF + m * 16;
#pragma unroll
                for (int bj = 0; bj < 2; ++bj) { const int col = col0 + bj * HALF; float y[8]; unpack8(yw[m][bj], y);
                    const f32x4 v0 = acc[ai][bj][m][0] + bb[bj][0], v1 = acc[ai][bj][m][1] + bb[bj][1]; float o[8];
#pragma unroll
                    for (int j = 0; j < 4; ++j) { o[j] = y[j] * sigmoidf_(v0[j]); o[4 + j] = y[4 + j] * sigmoidf_(v1[j]); }
                    u32x4 w; w.x = cvt_pk_bf16(o[0], o[1]); w.y = cvt_pk_bf16(o[2], o[3]); w.z = cvt_pk_bf16(o[4], o[5]); w.w = cvt_pk_bf16(o[6], o[7]);
                    *(u32x4*)(O + (size_t)row * ldo + col) = w; } } }
    }
};
struct EpiResid {
    static constexpr bool PERM = true;
    bf16_t* hb; float* rs; float* outf;
    __device__ __forceinline__ void operator()(const f32x4 (&acc)[2][2][4][2], const Unit& u, int ui, int wr, int wc, int fr, int fq) const {
        const int row0 = u.pm * BM + wr * 64 + fr, col0 = u.pn * BM + wc * 32 + 8 * fq;
#pragma unroll
        for (int ai = 0; ai < 2; ++ai) { u32x4 bv[4][2];
#pragma unroll
            for (int m = 0; m < 4; ++m)
#pragma unroll
                for (int bj = 0; bj < 2; ++bj) bv[m][bj] = *(const u32x4*)(hb + (size_t)(row0 + ai * HALF + m * 16) * 2048 + col0 + bj * HALF);
#pragma unroll
            for (int m = 0; m < 4; ++m) { const int row = row0 + ai * HALF + m * 16; const size_t ro = (size_t)row * 2048 + col0; float ss = 0.f;
#pragma unroll
                for (int bj = 0; bj < 2; ++bj) { const size_t o = ro + bj * HALF; float f[8]; unpack8(bv[m][bj], f);
                    const f32x4 v0 = (f32x4){f[0], f[1], f[2], f[3]} + acc[ai][bj][m][0], v1 = (f32x4){f[4], f[5], f[6], f[7]} + acc[ai][bj][m][1];
                    if (outf) { __builtin_nontemporal_store(v0, (f32x4*)(outf + o)); __builtin_nontemporal_store(v1, (f32x4*)(outf + o + 4)); }
                    else { u32x4 w; w.x = cvt_pk_bf16(v0[0], v0[1]); w.y = cvt_pk_bf16(v0[2], v0[3]); w.z = cvt_pk_bf16(v1[0], v1[1]); w.w = cvt_pk_bf16(v1[2], v1[3]); *(u32x4*)(hb + o) = w;
                        float r[8]; unpack8(w, r);
#pragma unroll
                        for (int q = 0; q < 8; ++q) ss += r[q] * r[q]; } }
                if (!outf) { ss += __shfl_xor(ss, 16); ss += __shfl_xor(ss, 32); if (fq == 0) rs[(size_t)row * 32 + u.pn * 4 + wc] = ss; } } }
    }
};

template <class Epi, bool ALIGN_EPI, bool SP2>
__device__ __forceinline__ void gemm_phase(LAS unsigned char* lds, const Gemm g, const StaticOrder& S, const Epi& E) {
    int tid = threadIdx.x; asm volatile("" : "+v"(tid));
    const int wid = __builtin_amdgcn_readfirstlane(tid >> 6), lane = tid & 63, wr = wid >> 2, wc = wid & 3, fr = lane & 15, fq = lane >> 4;
    const int K = g.K, nt = K / BK;
    unsigned voffA[2], voffB[2];
#pragma unroll
    for (int i = 0; i < 2; ++i) { int R, C; stage_rc(tid * 16 + i * 8192, R, C); const int Rb = Epi::PERM ? ((R & ~31) + perm32(R & 31)) : R;
        voffA[i] = (unsigned)(R * K + C) * 2u; voffB[i] = (unsigned)(Rb * K + C) * 2u; }
    const size_t kstep = (size_t)(BK * 2);
    const size_t hstep = (size_t)HALF * K * 2;
    const size_t tstep = 2 * hstep;
    const unsigned ldsw = (unsigned)wid * 1024u;
    const int aoff = lds_byte(wr * 64 + fr, fq * 8), boff = lds_byte(wc * 32 + fr, fq * 8);
#define PG8_SA(b, h) (((b) * 2 + (h)) * HTB)
#define PG8_SB(b, h) ((4 + (b) * 2 + (h)) * HTB)
#define PG8_STAGE(bufoff, gbase, voff) do { _Pragma("unroll") for (int _i = 0; _i < 2; ++_i) \
        __builtin_amdgcn_global_load_lds((const unsigned*)((const char*)(gbase) + (voff)[_i]), (LAS unsigned*)(lds + (bufoff) + ldsw + _i * 8192), 16, 0, 0); } while (0)
#define PG8_LDA(dst, b, h) do { _Pragma("unroll") for (int m = 0; m < 4; ++m) _Pragma("unroll") for (int k = 0; k < 2; ++k) dst[m][k] = *(const LAS bf16x8*)(lds + PG8_SA(b, h) + aoff + m * 2048 + k * 1024); } while (0)
#define PG8_LDB(dst, b, h) do { _Pragma("unroll") for (int n = 0; n < 2; ++n) _Pragma("unroll") for (int k = 0; k < 2; ++k) dst[n][k] = *(const LAS bf16x8*)(lds + PG8_SB(b, h) + boff + n * 2048 + k * 1024); } while (0)
#define PG8_MMA(ai, bj, At, Bt) do { __builtin_amdgcn_s_setprio(1); _Pragma("unroll") for (int m = 0; m < 4; ++m) _Pragma("unroll") for (int n = 0; n < 2; ++n) _Pragma("unroll") for (int k = 0; k < 2; ++k) \
        acc[ai][bj][m][n] = __builtin_amdgcn_mfma_f32_16x16x32_bf16(Bt[n][k], At[m][k], acc[ai][bj][m][n], 0, 0, 0); __builtin_amdgcn_s_setprio(0); } while (0)
#define PG8_WAIT_V(n) asm volatile("s_waitcnt vmcnt(" #n ")" ::: "memory")
#define PG8_WAIT_L(n) asm volatile("s_waitcnt lgkmcnt(" #n ")" ::: "memory")
#define PG8_BAR __builtin_amdgcn_s_barrier()
#define PG8_SCHED __builtin_amdgcn_sched_barrier(0)
    Unit cur, nxt; int ui = 0;
    if (!S.next(0, cur)) return;
    f32x4 acc[2][2][4][2];
#pragma unroll
    for (int a = 0; a < 2; ++a)
#pragma unroll
        for (int b = 0; b < 2; ++b)
#pragma unroll
            for (int m = 0; m < 4; ++m)
#pragma unroll
                for (int n = 0; n < 2; ++n) acc[a][b][m][n] = (f32x4){0.f, 0.f, 0.f, 0.f};
    bf16x8 At[4][2], B0[2][2], B1[2][2];
    const char* cA = (const char*)g.A + (size_t)cur.pm * tstep; const char* cB = (const char*)g.Bt + (size_t)cur.pn * tstep;
    if constexpr (SP2) {
        PG8_STAGE(PG8_SB(0, 0), cB, voffB); PG8_STAGE(PG8_SB(0, 1), cB + hstep, voffB); PG8_STAGE(PG8_SA(0, 0), cA, voffA); PG8_STAGE(PG8_SA(0, 1), cA + hstep, voffA);
        if (wr == 1) PG8_BAR;
        PG8_WAIT_V(2); PG8_BAR;
        PG8_STAGE(PG8_SB(1, 0), cB + kstep, voffB); PG8_STAGE(PG8_SA(1, 0), cA + kstep, voffA); PG8_STAGE(PG8_SB(1, 1), cB + hstep + kstep, voffB);
        PG8_WAIT_V(6); PG8_BAR;
    } else {
    PG8_STAGE(PG8_SB(0, 0), cB, voffB); PG8_STAGE(PG8_SA(0, 0), cA, voffA); PG8_STAGE(PG8_SB(0, 1), cB + hstep, voffB); PG8_STAGE(PG8_SA(0, 1), cA + hstep, voffA);
    if (wr == 1) PG8_BAR;
    PG8_WAIT_V(4); PG8_BAR;
    PG8_STAGE(PG8_SB(1, 0), cB + kstep, voffB); PG8_STAGE(PG8_SA(1, 0), cA + kstep, voffA); PG8_STAGE(PG8_SB(1, 1), cB + hstep + kstep, voffB);
    PG8_WAIT_V(6); PG8_BAR;
    }
    for (;;) {
        const bool has_next = S.next(ui + 1, nxt);
        const char* nA = has_next ? (const char*)g.A + (size_t)nxt.pm * tstep : cA; const char* nB = has_next ? (const char*)g.Bt + (size_t)nxt.pn * tstep : cB;
        for (int t = 0; t < nt; t += 2) {
            const bool last = (t == nt - 2);
            const char* a1 = cA + (size_t)(t + 1) * kstep;
            const char* a2 = last ? nA : cA + (size_t)(t + 2) * kstep; const char* b2 = last ? nB : cB + (size_t)(t + 2) * kstep;
            const char* a3 = a2 + kstep; const char* b3 = b2 + kstep;
            if constexpr (SP2) {
            PG8_LDB(B0, 0, 0); PG8_LDB(B1, 0, 1); PG8_SCHED; PG8_LDA(At, 0, 0); PG8_STAGE(PG8_SA(1, 1), a1 + hstep, voffA);
            PG8_WAIT_V(8); PG8_WAIT_L(0); PG8_BAR; PG8_MMA(0, 0, At, B0); PG8_MMA(0, 1, At, B1); PG8_BAR; PG8_SCHED;
            PG8_LDA(At, 0, 1); PG8_STAGE(PG8_SB(0, 0), b2, voffB); PG8_STAGE(PG8_SB(0, 1), b2 + hstep, voffB); PG8_STAGE(PG8_SA(0, 0), a2, voffA);
            PG8_WAIT_V(8); PG8_WAIT_L(0); PG8_BAR; PG8_MMA(1, 0, At, B0); PG8_MMA(1, 1, At, B1); PG8_BAR; PG8_SCHED;
            PG8_LDB(B0, 1, 0); PG8_LDB(B1, 1, 1); PG8_SCHED; PG8_LDA(At, 1, 0); PG8_STAGE(PG8_SA(0, 1), a2 + hstep, voffA);
            PG8_WAIT_V(8); PG8_WAIT_L(0); PG8_BAR; PG8_MMA(0, 0, At, B0); PG8_MMA(0, 1, At, B1); PG8_BAR; PG8_SCHED;
            PG8_LDA(At, 1, 1); PG8_STAGE(PG8_SB(1, 0), b3, voffB); PG8_STAGE(PG8_SB(1, 1), b3 + hstep, voffB); PG8_STAGE(PG8_SA(1, 0), a3, voffA);
            PG8_WAIT_V(8); PG8_WAIT_L(0); PG8_BAR; PG8_MMA(1, 0, At, B0); PG8_MMA(1, 1, At, B1); PG8_BAR; PG8_SCHED;
            } else {
            PG8_LDB(B0, 0, 0); PG8_SCHED; PG8_LDA(At, 0, 0); PG8_STAGE(PG8_SA(1, 1), a1 + hstep, voffA);
            PG8_WAIT_L(8); PG8_BAR; PG8_WAIT_L(0); PG8_MMA(0, 0, At, B0); PG8_BAR; PG8_SCHED;
            PG8_LDB(B1, 0, 1); PG8_STAGE(PG8_SB(0, 0), b2, voffB);
            PG8_BAR; PG8_WAIT_L(0); PG8_MMA(0, 1, At, B1); PG8_BAR;
            PG8_LDA(At, 0, 1); PG8_STAGE(PG8_SA(0, 0), a2, voffA);
            PG8_BAR; PG8_WAIT_L(0); PG8_MMA(1, 0, At, B0); PG8_BAR; PG8_SCHED;
            PG8_STAGE(PG8_SB(0, 1), b2 + hstep, voffB);
            PG8_WAIT_V(6); PG8_BAR; PG8_MMA(1, 1, At, B1); PG8_BAR;
            PG8_LDB(B0, 1, 0); PG8_SCHED; PG8_LDA(At, 1, 0); PG8_STAGE(PG8_SA(0, 1), a2 + hstep, voffA);
            PG8_WAIT_L(8); PG8_BAR; PG8_WAIT_L(0); PG8_MMA(0, 0, At, B0); PG8_BAR; PG8_SCHED;
            PG8_LDB(B1, 1, 1); PG8_STAGE(PG8_SB(1, 0), b3, voffB);
            PG8_BAR; PG8_WAIT_L(0); PG8_MMA(0, 1, At, B1); PG8_BAR;
            PG8_LDA(At, 1, 1); PG8_STAGE(PG8_SA(1, 0), a3, voffA);
            PG8_BAR; PG8_WAIT_L(0); PG8_MMA(1, 0, At, B0); PG8_BAR; PG8_SCHED;
            PG8_STAGE(PG8_SB(1, 1), b3 + hstep, voffB);
            PG8_WAIT_V(6); PG8_BAR; PG8_MMA(1, 1, At, B1); PG8_BAR;
            }
        }
        if constexpr (ALIGN_EPI) { if (wr == 0) PG8_BAR; }
        E(acc, cur, ui, wr, wc, fr, fq);
        if (!has_next) break;
#pragma unroll
        for (int a = 0; a < 2; ++a)
#pragma unroll
            for (int b = 0; b < 2; ++b)
#pragma unroll
                for (int m = 0; m < 4; ++m)
#pragma unroll
                    for (int n = 0; n < 2; ++n) acc[a][b][m][n] = (f32x4){0.f, 0.f, 0.f, 0.f};
        cur = nxt; cA = nA; cB = nB; ++ui;
        if constexpr (ALIGN_EPI) { if (wr == 1) PG8_BAR; }
    }
    PG8_WAIT_V(0);
    if constexpr (!ALIGN_EPI) { if (wr == 0) PG8_BAR; }
    PG8_BAR;
#undef PG8_SA
#undef PG8_SB
#undef PG8_STAGE
#undef PG8_LDA
#undef PG8_LDB
#undef PG8_MMA
#undef PG8_WAIT_V
#undef PG8_WAIT_L
#undef PG8_BAR
#undef PG8_SCHED
}
}

__device__ __forceinline__ void transpose_cvt(const float* __restrict__ W, bf16_t* __restrict__ Wt, int K, int N, float* sm, const float* __restrict__ gain, int tstart, int tstride) {
    int tid = threadIdx.x; asm volatile("" : "+v"(tid));
    const int tn = N >> 8, ntile = tn * (K >> 6);
    for (int tile = tstart; tile < ntile; tile += tstride) {
        const int k0 = (tile / tn) << 6, n0 = (tile % tn) << 8;
        f32x4 v[8];
#pragma unroll
        for (int i = 0; i < 8; ++i) { const int idx = tid + i * 512; const int rest = idx >> 6; const int r = ((rest >> 3) << 3) + (idx & 7), c4 = ((rest & 7) << 3) + ((idx >> 3) & 7);
            v[i] = __builtin_nontemporal_load((const f32x4*)(W + (size_t)(k0 + r) * N + n0 + c4 * 4)); if (gain) v[i] = v[i] * gain[k0 + r]; }
#pragma unroll
        for (int i = 0; i < 8; ++i) { const int idx = tid + i * 512; const int rest = idx >> 6; const int r = ((rest >> 3) << 3) + (idx & 7), c4 = ((rest & 7) << 3) + ((idx >> 3) & 7);
            float* d = sm + r * 257 + c4 * 4; d[0] = v[i][0]; d[1] = v[i][1]; d[2] = v[i][2]; d[3] = v[i][3]; }
        __syncthreads();
        const int ks = tid & 7;
#pragma unroll
        for (int i = 0; i < 4; ++i) { const int n = (tid >> 3) + 64 * i; float f[8];
#pragma unroll
            for (int j = 0; j < 8; ++j) f[j] = sm[(ks * 8 + j) * 257 + n];
            u32x4 w; w.x = cvt_pk_bf16(f[0], f[1]); w.y = cvt_pk_bf16(f[2], f[3]); w.z = cvt_pk_bf16(f[4], f[5]); w.w = cvt_pk_bf16(f[6], f[7]);
            __builtin_nontemporal_store(w, (u32x4*)(Wt + (size_t)(n0 + n) * K + k0 + ks * 8)); }
        __syncthreads();
    }
}

__device__ __forceinline__ void s5_params(const float* lam_re, const float* lam_im, const float* log_dt, const float* b_re, const float* b_im, float* S5A, float* S5B) {
    int tid = threadIdx.x; asm volatile("" : "+v"(tid));
    for (int idx = blockIdx.x * 512 + tid; idx < 8192; idx += gridDim.x * 512) {
        const float lr = fminf(lam_re[idx], -1e-4f), li = lam_im[idx], dt = expf(log_dt[idx >> 6]);
        const float mag = expf(lr * dt), th = li * dt;
        const float ar = mag * cosf(th), ai = mag * sinf(th);
        const float den = lr * lr + li * li;
        const float zr = ((ar - 1.0f) * lr + ai * li) / den, zi = (ai * lr - (ar - 1.0f) * li) / den;
        S5A[idx * 2] = ar; S5A[idx * 2 + 1] = ai;
#pragma unroll
        for (int c = 0; c < 16; ++c) { const float br = b_re[(size_t)idx * 16 + c], bi = b_im[(size_t)idx * 16 + c];
            S5B[(size_t)idx * 32 + c] = zr * br - zi * bi; S5B[(size_t)idx * 32 + 16 + c] = zr * bi + zi * br; }
    }
}

__device__ __forceinline__ void x_stats_phase(const float* __restrict__ h, bf16_t* __restrict__ hb, float* __restrict__ rs) {
    int tid = threadIdx.x; asm volatile("" : "+v"(tid));
    const int lane = tid & 63, wave = tid >> 6;
    for (int row = blockIdx.x * 8 + wave; row < T; row += gridDim.x * 8) {
        const float* p = h + (size_t)row * 2048 + lane * 8;
        f32x4 v[8]; float ss = 0.f;
#pragma unroll
        for (int i = 0; i < 4; ++i) { v[2 * i] = __builtin_nontemporal_load((const f32x4*)(p + i * 512)); v[2 * i + 1] = __builtin_nontemporal_load((const f32x4*)(p + i * 512 + 4)); }
#pragma unroll
        for (int i = 0; i < 8; ++i) ss += v[i][0] * v[i][0] + v[i][1] * v[i][1] + v[i][2] * v[i][2] + v[i][3] * v[i][3];
        ss = wave_sum(ss);
        if (lane < 32) rs[(size_t)row * 32 + lane] = lane == 0 ? ss : 0.f;
#pragma unroll
        for (int i = 0; i < 4; ++i) { u32x4 w; w.x = cvt_pk_bf16(v[2 * i][0], v[2 * i][1]); w.y = cvt_pk_bf16(v[2 * i][2], v[2 * i][3]); w.z = cvt_pk_bf16(v[2 * i + 1][0], v[2 * i + 1][1]); w.w = cvt_pk_bf16(v[2 * i + 1][2], v[2 * i + 1][3]);
            *(u32x4*)(hb + (size_t)row * 2048 + i * 512 + lane * 8) = w; }
    }
}

__device__ __forceinline__ float hgrn_lb(const float* lbp, int j, int ch) { return j == 0 ? 0.f : sigmoidf_(lbp[1024 + ch] - lbp[ch]); }

__device__ __forceinline__ void hgrn_cumsum(float* base, int st_t, int st_k, int tid) {
    const int k = tid & 127, qd = tid >> 7;
    float* p = base + k * st_k + (16 * qd) * st_t;
    float run = 0.f;
#pragma unroll
    for (int t = 0; t < 16; ++t) { run += p[t * st_t]; p[t * st_t] = run; }
    __syncthreads();
    float off = 0.f;
#pragma unroll
    for (int q = 0; q < 3; ++q) if (q < qd) off += base[k * st_k + (16 * q + 15) * st_t];
    __syncthreads();
    if (qd > 0) {
#pragma unroll
        for (int t = 0; t < 16; ++t) p[t * st_t] += off; }
    __syncthreads();
}

__device__ __forceinline__ void hgrn_p1(int item, const bf16_t* __restrict__ proj, const float* __restrict__ lbp, int j, bf16_t* __restrict__ HST, float* __restrict__ HDEC, unsigned char* smb) {
    int tid = threadIdx.x; asm volatile("" : "+v"(tid));
    const int wave = tid >> 6, lane = tid & 63, fr = lane & 15, fq = lane >> 4;
    const int c = item & 63, h = (item >> 6) & 7, b = item >> 9;
    const size_t tok0 = (size_t)b * SEQ + c * 64;
    float* BT = (float*)smb; float* KT = BT + 8704;
    unsigned char* KH = smb + 2 * 34816; unsigned char* Vt = KH + 18432;
    {
        const int t = lane;
#pragma unroll
        for (int i = 0; i < 2; ++i) { const int kg = wave + 8 * i;
            const bf16_t* rowp = proj + (tok0 + t) * 5120 + h * 128 + kg * 8;
            const u32x4 fw = *(const u32x4*)(rowp + 2048), vw = *(const u32x4*)(rowp + 3072);
            float f[8]; unpack8(fw, f);
#pragma unroll
            for (int jj = 0; jj < 8; ++jj) { const int k = kg * 8 + jj; const float lb = hgrn_lb(lbp, j, h * 128 + k); const float fg = lb + (1.0f - lb) * sigmoidf_(f[jj]);
                BT[k * 65 + t] = __log2f(fg); KT[k * 65 + t] = 1.0f - fg; }
            unsigned short* vcol = (unsigned short*)(Vt + (kg * 8) * 144 + t * 2);
            vcol[0 * 72] = (unsigned short)(vw.x & 0xffffu); vcol[1 * 72] = (unsigned short)(vw.x >> 16); vcol[2 * 72] = (unsigned short)(vw.y & 0xffffu); vcol[3 * 72] = (unsigned short)(vw.y >> 16);
            vcol[4 * 72] = (unsigned short)(vw.z & 0xffffu); vcol[5 * 72] = (unsigned short)(vw.z >> 16); vcol[6 * 72] = (unsigned short)(vw.w & 0xffffu); vcol[7 * 72] = (unsigned short)(vw.w >> 16); }
    }
    __syncthreads();
    hgrn_cumsum(BT, 1, 65, tid);
#pragma unroll
    for (int i = 0; i < 16; ++i) { const int e = tid + i * 512; const int k = e >> 6, s = e & 63;
        *(unsigned short*)(KH + k * 144 + s * 2) = f2bf(KT[k * 65 + s] * ex2(BT[k * 65 + 63] - BT[k * 65 + s])); }
    if (tid < 128) HDEC[(size_t)item * 128 + tid] = ex2(BT[tid * 65 + 63]);
    __syncthreads();
    {
        bf16x8 bfr[2];
#pragma unroll
        for (int ks = 0; ks < 2; ++ks) bfr[ks] = *(const bf16x8*)(KH + (16 * wave + fr) * 144 + ks * 64 + fq * 16);
        bf16_t* dst = HST + (size_t)item * 16384 + fr * 128 + 16 * wave + 4 * fq;
#pragma unroll
        for (int mt = 0; mt < 8; ++mt) { f32x4 acc = (f32x4){0.f, 0.f, 0.f, 0.f};
#pragma unroll
            for (int ks = 0; ks < 2; ++ks) { const bf16x8 af = *(const bf16x8*)(Vt + (16 * mt + fr) * 144 + ks * 64 + fq * 16); acc = __builtin_amdgcn_mfma_f32_16x16x32_bf16(bfr[ks], af, acc, 0, 0, 0); }
            { u32x2 w2; w2.x = (unsigned)f2bf(acc[0]) | ((unsigned)f2bf(acc[1]) << 16); w2.y = (unsigned)f2bf(acc[2]) | ((unsigned)f2bf(acc[3]) << 16);
              *(u32x2*)(dst + (size_t)(16 * mt) * 128) = w2; } }
    }
    __syncthreads();
}

__device__ __forceinline__ void hgrn_p2(bf16_t* __restrict__ HST, const float* __restrict__ HDEC) {
    int tid = threadIdx.x; asm volatile("" : "+v"(tid));
    for (int gid = blockIdx.x * 512 + tid; gid < 131072; gid += gridDim.x * 512) {
        const int bh = gid >> 13, off = (gid & 8191) * 2, k = off & 127;
        f32x2 st = (f32x2){0.f, 0.f};
        bf16_t* hp = HST + (size_t)bh * 64 * 16384 + off; const float* dp = HDEC + (size_t)bh * 64 * 128 + k;
#pragma unroll 1
        for (int c0 = 0; c0 < 64; c0 += 16) {
            f32x2 d[16]; unsigned kv[16];
#pragma unroll
            for (int u = 0; u < 16; ++u) { d[u] = *(const f32x2*)(dp + (size_t)(c0 + u) * 128); kv[u] = *(const unsigned*)(hp + (size_t)(c0 + u) * 16384); }
#pragma unroll
            for (int u = 0; u < 16; ++u) { st = st * d[u] + (f32x2){bflo(kv[u]), bfhi(kv[u])}; kv[u] = cvt_pk_bf16(st[0], st[1]); }
#pragma unroll
            for (int u = 0; u < 16; ++u) *(unsigned*)(hp + (size_t)(c0 + u) * 16384) = kv[u];
        }
    }
}

__device__ __forceinline__ void hgrn_p3(int item, const bf16_t* __restrict__ proj, const float* __restrict__ lbp, int j, const bf16_t* __restrict__ HST, const float* __restrict__ ogain, bf16_t* __restrict__ ycat, unsigned char* smb) {
    int tid = threadIdx.x; asm volatile("" : "+v"(tid));
    const int wave = tid >> 6, lane = tid & 63, fr = lane & 15, fq = lane >> 4;
    const int c = item & 63, h = (item >> 6) & 7, b = item >> 9;
    const size_t tok0 = (size_t)b * SEQ + c * 64;
    float* FB = (float*)smb; float* FQ = FB + 8704; float* FK = FQ + 8704;
    unsigned char* SC = smb + 3 * 34816; unsigned char* Vt = SC + 9216; float* RED = (float*)(Vt + 18432);
    unsigned char* Pt = (unsigned char*)FK; unsigned char* QEb = (unsigned char*)FB;
    u32x4 pre[4];
#pragma unroll
    for (int i = 0; i < 4; ++i) pre[i] = (u32x4){0u, 0u, 0u, 0u};
    u32x2 graw[4];
#pragma unroll
    for (int mt = 0; mt < 4; ++mt) graw[mt] = *(const u32x2*)(proj + (tok0 + 16 * mt + fr) * 5120 + 4096 + h * 128 + 16 * wave + 4 * fq);
    if (c > 0) { const bf16_t* P = HST + (size_t)(item - 1) * 16384;
#pragma unroll
        for (int i = 0; i < 4; ++i) pre[i] = *(const u32x4*)(P + (size_t)(tid + i * 512) * 8); }
    for (int ra = 0; ra < ((H3REP & 1) ? 3 : 1); ++ra) {
    {
        const int kg = tid & 15;
#pragma unroll
        for (int i = 0; i < 2; ++i) { const int t = (tid + i * 512) >> 4;
            const bf16_t* rowp = proj + (tok0 + t) * 5120 + h * 128 + kg * 8;
            const u32x4 qw = *(const u32x4*)(rowp + 1024), fw = *(const u32x4*)(rowp + 2048), vw = *(const u32x4*)(rowp + 3072);
            float q[8], f[8]; unpack8(qw, q); unpack8(fw, f);
            float lg[8], kk[8], qs[8];
#pragma unroll
            for (int jj = 0; jj < 8; ++jj) { const float lb = hgrn_lb(lbp, j, h * 128 + kg * 8 + jj); const float fg = lb + (1.0f - lb) * sigmoidf_(f[jj]);
                lg[jj] = __log2f(fg); kk[jj] = 1.0f - fg; qs[jj] = q[jj] * sigmoidf_(q[jj]); }
            *(f32x4*)(FB + t * 132 + kg * 8) = (f32x4){lg[0], lg[1], lg[2], lg[3]}; *(f32x4*)(FB + t * 132 + kg * 8 + 4) = (f32x4){lg[4], lg[5], lg[6], lg[7]};
            *(f32x4*)(FQ + t * 132 + kg * 8) = (f32x4){qs[0], qs[1], qs[2], qs[3]}; *(f32x4*)(FQ + t * 132 + kg * 8 + 4) = (f32x4){qs[4], qs[5], qs[6], qs[7]};
            *(f32x4*)(FK + t * 132 + kg * 8) = (f32x4){kk[0], kk[1], kk[2], kk[3]}; *(f32x4*)(FK + t * 132 + kg * 8 + 4) = (f32x4){kk[4], kk[5], kk[6], kk[7]};
            unsigned short* vcol = (unsigned short*)(Vt + (kg * 8) * 144 + t * 2);
            vcol[0 * 72] = (unsigned short)(vw.x & 0xffffu); vcol[1 * 72] = (unsigned short)(vw.x >> 16); vcol[2 * 72] = (unsigned short)(vw.y & 0xffffu); vcol[3 * 72] = (unsigned short)(vw.y >> 16);
            vcol[4 * 72] = (unsigned short)(vw.z & 0xffffu); vcol[5 * 72] = (unsigned short)(vw.z >> 16); vcol[6 * 72] = (unsigned short)(vw.w & 0xffffu); vcol[7 * 72] = (unsigned short)(vw.w >> 16); }
    }
    __syncthreads();
    hgrn_cumsum(FB, 132, 1, tid);
    }
    for (int rb = 0; rb < ((H3REP & 2) ? 3 : 1); ++rb) {
    if (wave < 6) {
        const int I = wave < 1 ? 1 : wave < 3 ? 2 : 3, J = wave < 1 ? 0 : wave < 3 ? wave - 1 : wave - 3;
        const float* bt = FB + (16 * I + fr) * 132, *qt = FQ + (16 * I + fr) * 132, *be = FB + (16 * J + 15) * 132, *bs = FB + (16 * J + fr) * 132, *ks_ = FK + (16 * J + fr) * 132;
        f32x4 acc = (f32x4){0.f, 0.f, 0.f, 0.f};
#pragma unroll
        for (int ks = 0; ks < 4; ++ks) { const int k0 = ks * 32 + fq * 8; float av[8], bv[8];
#pragma unroll
            for (int hh = 0; hh < 2; ++hh) { const f32x4 b4 = *(const f32x4*)(bt + k0 + 4 * hh), q4 = *(const f32x4*)(qt + k0 + 4 * hh), e4 = *(const f32x4*)(be + k0 + 4 * hh), s4 = *(const f32x4*)(bs + k0 + 4 * hh), k4 = *(const f32x4*)(ks_ + k0 + 4 * hh);
#pragma unroll
                for (int e = 0; e < 4; ++e) { av[4 * hh + e] = q4[e] * ex2(b4[e] - e4[e]); bv[4 * hh + e] = k4[e] * ex2(e4[e] - s4[e]); } }
            u32x4 aw, bw; aw.x = cvt_pk_bf16(av[0], av[1]); aw.y = cvt_pk_bf16(av[2], av[3]); aw.z = cvt_pk_bf16(av[4], av[5]); aw.w = cvt_pk_bf16(av[6], av[7]);
            bw.x = cvt_pk_bf16(bv[0], bv[1]); bw.y = cvt_pk_bf16(bv[2], bv[3]); bw.z = cvt_pk_bf16(bv[4], bv[5]); bw.w = cvt_pk_bf16(bv[6], bv[7]);
            acc = __builtin_amdgcn_mfma_f32_16x16x32_bf16(__builtin_bit_cast(bf16x8, aw), __builtin_bit_cast(bf16x8, bw), acc, 0, 0, 0); }
#pragma unroll
        for (int e = 0; e < 4; ++e) *(unsigned short*)(SC + (16 * I + 4 * fq + e) * 144 + (16 * J + fr) * 2) = f2bf(acc[e]);
    } else {
#pragma unroll
        for (int u = 0; u < 3; ++u) { const int id = (wave - 6) * 3 + u; const int I = id < 3 ? 0 : id < 5 ? 1 : 2, J = id < 3 ? id + 1 : id < 5 ? id - 1 : 3;
#pragma unroll
            for (int e = 0; e < 4; ++e) *(unsigned short*)(SC + (16 * I + 4 * fq + e) * 144 + (16 * J + fr) * 2) = (unsigned short)0; }
    }
    {
        const int I = lane >> 4, ks16 = lane & 15;
#pragma unroll
        for (int half = 0; half < 2; ++half) { const int tl = half == 0 ? wave : 15 - wave; const int t = 16 * I + tl;
            const float* qrow = FQ + t * 132 + 8 * ks16;
            const f32x4 q0v = *(const f32x4*)qrow, q1v = *(const f32x4*)(qrow + 4);
            float part[16]; f32x4 w0 = (f32x4){1.f, 1.f, 1.f, 1.f}, w1 = w0;
#pragma unroll
            for (int sl = 15; sl >= 0; --sl) { part[sl] = 0.f;
                if (sl <= tl) { const float* krow = FK + (16 * I + sl) * 132 + 8 * ks16;
                    const f32x4 k0 = *(const f32x4*)krow, k1 = *(const f32x4*)(krow + 4);
                    float av = 0.f;
#pragma unroll
                    for (int e = 0; e < 4; ++e) { av += q0v[e] * k0[e] * w0[e]; av += q1v[e] * k1[e] * w1[e]; w0[e] *= 1.0f - k0[e]; w1[e] *= 1.0f - k1[e]; }
                    part[sl] = av; } }
#pragma unroll
            for (int i = 0; i < 8; ++i) { const bool hi = (ks16 & 8) != 0; const float send = hi ? part[i] : part[i + 8], keep = hi ? part[i + 8] : part[i]; part[i] = keep + __shfl_xor(send, 8); }
#pragma unroll
            for (int i = 0; i < 4; ++i) { const bool hi = (ks16 & 4) != 0; const float send = hi ? part[i] : part[i + 4], keep = hi ? part[i + 4] : part[i]; part[i] = keep + __shfl_xor(send, 4); }
#pragma unroll
            for (int i = 0; i < 2; ++i) { const bool hi = (ks16 & 2) != 0; const float send = hi ? part[i] : part[i + 2], keep = hi ? part[i + 2] : part[i]; part[i] = keep + __shfl_xor(send, 2); }
            { const bool hi = (ks16 & 1) != 0; const float send = hi ? part[0] : part[1], keep = hi ? part[1] : part[0]; part[0] = keep + __shfl_xor(send, 1); }
            *(unsigned short*)(SC + t * 144 + (16 * I + ks16) * 2) = f2bf(part[0]); }
    }
    __syncthreads();
    }
    for (int rc = 0; rc < ((H3REP & 4) ? 3 : 1); ++rc) {
    u32x4 qe[2];
    { const int kg = tid & 15;
#pragma unroll
      for (int i = 0; i < 2; ++i) { const int t = (tid + i * 512) >> 4; const float* bp = FB + t * 132 + kg * 8, *qp = FQ + t * 132 + kg * 8;
          const f32x4 b0 = *(const f32x4*)bp, b1 = *(const f32x4*)(bp + 4), q0 = *(const f32x4*)qp, q1 = *(const f32x4*)(qp + 4);
          qe[i].x = cvt_pk_bf16(q0[0] * ex2(b0[0]), q0[1] * ex2(b0[1])); qe[i].y = cvt_pk_bf16(q0[2] * ex2(b0[2]), q0[3] * ex2(b0[3]));
          qe[i].z = cvt_pk_bf16(q1[0] * ex2(b1[0]), q1[1] * ex2(b1[1])); qe[i].w = cvt_pk_bf16(q1[2] * ex2(b1[2]), q1[3] * ex2(b1[3])); } }
    __syncthreads();
#pragma unroll
    for (int i = 0; i < 4; ++i) { const int idx = tid + i * 512; const int v = idx >> 4, k8 = idx & 15; *(u32x4*)(Pt + v * 272 + k8 * 16) = pre[i]; }
    { const int kg = tid & 15;
#pragma unroll
      for (int i = 0; i < 2; ++i) { const int t = (tid + i * 512) >> 4; *(u32x4*)(QEb + t * 272 + kg * 16) = qe[i]; } }
    __syncthreads();
    f32x4 o[4];
    {
        bf16x8 bv[2], bp[4];
#pragma unroll
        for (int ks = 0; ks < 2; ++ks) bv[ks] = *(const bf16x8*)(Vt + (16 * wave + fr) * 144 + ks * 64 + fq * 16);
#pragma unroll
        for (int ks = 0; ks < 4; ++ks) bp[ks] = *(const bf16x8*)(Pt + (16 * wave + fr) * 272 + ks * 64 + fq * 16);
#pragma unroll
        for (int mt = 0; mt < 4; ++mt) { f32x4 acc = (f32x4){0.f, 0.f, 0.f, 0.f};
#pragma unroll
            for (int ks = 0; ks < 2; ++ks) { const bf16x8 af = *(const bf16x8*)(SC + (16 * mt + fr) * 144 + ks * 64 + fq * 16); acc = __builtin_amdgcn_mfma_f32_16x16x32_bf16(bv[ks], af, acc, 0, 0, 0); }
#pragma unroll
            for (int ks = 0; ks < 4; ++ks) { const bf16x8 af = *(const bf16x8*)(QEb + (16 * mt + fr) * 272 + ks * 64 + fq * 16); acc = __builtin_amdgcn_mfma_f32_16x16x32_bf16(bp[ks], af, acc, 0, 0, 0); }
            o[mt] = acc;
            float ssq = acc[0] * acc[0] + acc[1] * acc[1] + acc[2] * acc[2] + acc[3] * acc[3]; ssq += __shfl_xor(ssq, 16); ssq += __shfl_xor(ssq, 32);
            if (fq == 0) RED[wave * 64 + 16 * mt + fr] = ssq; }
    }
    __syncthreads();
    {
        const int v0 = 16 * wave + 4 * fq; const f32x4 gn = *(const f32x4*)(ogain + v0);
#pragma unroll
        for (int mt = 0; mt < 4; ++mt) { const int t = 16 * mt + fr; float tot = 0.f;
#pragma unroll
            for (int w = 0; w < 8; ++w) tot += RED[w * 64 + t];
            const float r = rsqrtf(tot * (1.0f / 128.0f) + 1e-6f);
            const size_t tok = tok0 + t;
            const float g0 = bflo(graw[mt].x), g1 = bfhi(graw[mt].x), g2 = bflo(graw[mt].y), g3 = bfhi(graw[mt].y);
            u32x2 w2; w2.x = cvt_pk_bf16(o[mt][0] * r * gn[0] * g0 * sigmoidf_(g0), o[mt][1] * r * gn[1] * g1 * sigmoidf_(g1));
            w2.y = cvt_pk_bf16(o[mt][2] * r * gn[2] * g2 * sigmoidf_(g2), o[mt][3] * r * gn[3] * g3 * sigmoidf_(g3));
            *(u32x2*)(ycat + tok * 2048 + 1024 + h * 128 + v0) = w2; }
    }
    __syncthreads();
    }
    __syncthreads();
}

__device__ __forceinline__ float gelu_tanh(float y) { const float z = 0.7978845608028654f * (y + 0.044715f * y * y * y); const float e = __expf(2.0f * z); return y * (1.0f - __builtin_amdgcn_rcpf(1.0f + e)); }
__device__ __forceinline__ bf16x8 pack8(const f32x4 a, const f32x4 b, float sgn) {
    u32x4 w; w.x = cvt_pk_bf16(a[0] * sgn, a[1] * sgn); w.y = cvt_pk_bf16(a[2] * sgn, a[3] * sgn); w.z = cvt_pk_bf16(b[0] * sgn, b[1] * sgn); w.w = cvt_pk_bf16(b[2] * sgn, b[3] * sgn); return __builtin_bit_cast(bf16x8, w);
}
template <bool FINAL>
__device__ __forceinline__ void s5_pass(int item, const bf16_t* __restrict__ proj, const float* __restrict__ S5A, const float* __restrict__ S5B, float* __restrict__ S5F,
                                        const float* __restrict__ c_re, const float* __restrict__ c_im, const float* __restrict__ dsk, bf16_t* __restrict__ ys5, unsigned char* smb) {
    int tid = threadIdx.x; asm volatile("" : "+v"(tid));
    const int wave = tid >> 6, lane = tid & 63, fr = lane & 15, fq = lane >> 4;
    const int sg = item & 7, g = (item >> 3) & 63, b = item >> 9;
    const int seg = sg * 8 + wave; const size_t tok0 = (size_t)b * SEQ + seg * 64;
    float* Bu = (float*)(smb + wave * 12800);
    unsigned char* X = smb + wave * 12800 + 8448;
    const bf16x8 zero8 = __builtin_bit_cast(bf16x8, (u32x4){0u, 0u, 0u, 0u});
    bf16x8 af[8], uf[4];
#pragma unroll
    for (int mt = 0; mt < 8; ++mt) { af[mt] = zero8;
        if (fq < 2) { const int pp = 16 * mt + fr; const float* src = S5B + (size_t)(g * 64 + (pp & 63)) * 32 + (pp >> 6) * 16 + fq * 8; af[mt] = pack8(*(const f32x4*)src, *(const f32x4*)(src + 4), 1.0f); } }
#pragma unroll
    for (int blk = 0; blk < 4; ++blk) { uf[blk] = zero8;
        if (fq < 2) uf[blk] = *(const bf16x8*)(proj + (tok0 + 16 * blk + fr) * 5120 + g * 16 + fq * 8); }
    const float ar = S5A[(g * 64 + lane) * 2], ai = S5A[(g * 64 + lane) * 2 + 1];
    float xr = 0.f, xi = 0.f;
    bf16x8 cf[4]; float dv = 0.f; unsigned short uraw[16];
    if (FINAL) {
#pragma unroll
        for (int q = 0; q < 16; ++q) uraw[q] = proj[(tok0 + 16 * (q >> 2) + 4 * fq + (q & 3)) * 5120 + g * 16 + fr];
        const f32x2 cin = *(const f32x2*)(S5F + ((size_t)((b * 64 + g) * 64 + seg) * 64 + lane) * 2); xr = cin[0]; xi = cin[1];
#pragma unroll
        for (int ks = 0; ks < 4; ++ks) { const float* src = (ks < 2 ? c_re : c_im) + (size_t)g * 1024 + fr * 64 + ((ks & 1) * 32 + fq * 8); cf[ks] = pack8(*(const f32x4*)src, *(const f32x4*)(src + 4), ks < 2 ? 1.0f : -1.0f); }
        dv = dsk[g * 16 + fr];
    }
#pragma unroll
    for (int blk = 0; blk < 4; ++blk) {
#pragma unroll
        for (int mt = 0; mt < 8; ++mt) { const f32x4 acc = __builtin_amdgcn_mfma_f32_16x16x32_bf16(af[mt], uf[blk], (f32x4){0.f, 0.f, 0.f, 0.f}, 0, 0, 0); *(f32x4*)(Bu + fr * 132 + 16 * mt + 4 * fq) = acc; }
        __syncthreads();
#pragma unroll
        for (int t = 0; t < 16; ++t) { const float bur = Bu[t * 132 + lane], bui = Bu[t * 132 + 64 + lane];
            const float nxr = ar * xr - ai * xi + bur, nxi = ar * xi + ai * xr + bui; xr = nxr; xi = nxi;
            if (FINAL) { *(unsigned short*)(X + t * 272 + lane * 2) = f2bf(xr); *(unsigned short*)(X + t * 272 + 128 + lane * 2) = f2bf(xi); } }
        __syncthreads();
        if (FINAL) {
            f32x4 acc = (f32x4){0.f, 0.f, 0.f, 0.f};
#pragma unroll
            for (int ks = 0; ks < 4; ++ks) { const bf16x8 a = *(const bf16x8*)(X + fr * 272 + ks * 64 + fq * 16); acc = __builtin_amdgcn_mfma_f32_16x16x32_bf16(a, cf[ks], acc, 0, 0, 0); }
#pragma unroll
            for (int e = 0; e < 4; ++e) { const size_t tok = tok0 + 16 * blk + 4 * fq + e; const float u = bflo((unsigned)uraw[blk * 4 + e]);
                ys5[tok * 1024 + g * 16 + fr] = f2bf(gelu_tanh(acc[e] + dv * u)); }
        }
    }
    if (!FINAL) *(f32x2*)(S5F + ((size_t)((b * 64 + g) * 64 + seg) * 64 + lane) * 2) = (f32x2){xr, xi};
    __syncthreads();
}

#define WAVE_LDS_SYNC() do { asm volatile("s_waitcnt lgkmcnt(0)" ::: "memory"); __builtin_amdgcn_s_barrier(); asm volatile("" ::: "memory"); } while (0)
template <bool FINAL>
__device__ __forceinline__ void s5_wg(int bid, const bf16_t* __restrict__ proj, const float* __restrict__ S5A, const float* __restrict__ S5B, float* __restrict__ S5F,
                                      const float* __restrict__ c_re, const float* __restrict__ c_im, const float* __restrict__ dsk, bf16_t* __restrict__ ys5, unsigned char* smb) {
    int tid = threadIdx.x; asm volatile("" : "+v"(tid));
    const int wave = tid >> 6, lane = tid & 63, fr = lane & 15, fq = lane >> 4;
    const int g = bid >> 2, r0 = (bid & 3) * 4;
    float* Bu = (float*)(smb + wave * 12800);
    unsigned char* X = smb + wave * 12800 + 8448;
    const bf16x8 zero8 = __builtin_bit_cast(bf16x8, (u32x4){0u, 0u, 0u, 0u});
    bf16x8 af[8];
#pragma unroll
    for (int mt = 0; mt < 8; ++mt) { af[mt] = zero8;
        if (fq < 2) { const int pp = 16 * mt + fr; const float* src = S5B + (size_t)(g * 64 + (pp & 63)) * 32 + (pp >> 6) * 16 + fq * 8; af[mt] = pack8(*(const f32x4*)src, *(const f32x4*)(src + 4), 1.0f); } }
    const float ar = S5A[(g * 64 + lane) * 2], ai = S5A[(g * 64 + lane) * 2 + 1];
    bf16x8 cf[4]; f32x4 dv4 = (f32x4){0.f, 0.f, 0.f, 0.f};
    if (FINAL) {
#pragma unroll
        for (int ks = 0; ks < 4; ++ks) { const float* src = (ks < 2 ? c_re : c_im) + (size_t)g * 1024 + fr * 64 + ((ks & 1) * 32 + fq * 8); cf[ks] = pack8(*(const f32x4*)src, *(const f32x4*)(src + 4), ks < 2 ? 1.0f : -1.0f); }
        dv4 = *(const f32x4*)(dsk + g * 16 + 4 * fq);
    }
    bf16x8 ufb[2][4]; u32x2 urb[2][4]; f32x2 cinb[2];
#define S5_FETCH(k_, slot_) do { const int r_ = r0 + (k_); const int b_ = r_ >> 3, seg_ = (r_ & 7) * 8 + wave; const size_t tk_ = (size_t)b_ * SEQ + seg_ * 64; \
        _Pragma("unroll") for (int blk_ = 0; blk_ < 4; ++blk_) { ufb[slot_][blk_] = zero8; if (fq < 2) ufb[slot_][blk_] = *(const bf16x8*)(proj + (tk_ + 16 * blk_ + fr) * 5120 + g * 16 + fq * 8); } \
        if (FINAL) { _Pragma("unroll") for (int q_ = 0; q_ < 4; ++q_) urb[slot_][q_] = *(const u32x2*)(proj + (tk_ + 16 * q_ + fr) * 5120 + g * 16 + 4 * fq); \
            cinb[slot_] = *(const f32x2*)(S5F + ((size_t)((b_ * 64 + g) * 64 + seg_) * 64 + lane) * 2); } } while (0)
    S5_FETCH(0, 0);
#pragma unroll
    for (int k = 0; k < 4; ++k) {
        const int cur = k & 1;
        if (k < 3) S5_FETCH(k + 1, cur ^ 1);
        const int r = r0 + k; const int b = r >> 3, seg = (r & 7) * 8 + wave; const size_t tok0 = (size_t)b * SEQ + seg * 64;
        float xr = 0.f, xi = 0.f;
        if (FINAL) { xr = cinb[cur][0]; xi = cinb[cur][1]; }
#pragma unroll
        for (int blk = 0; blk < 4; ++blk) {
#pragma unroll
            for (int mt = 0; mt < 8; ++mt) { const f32x4 acc = __builtin_amdgcn_mfma_f32_16x16x32_bf16(af[mt], ufb[cur][blk], (f32x4){0.f, 0.f, 0.f, 0.f}, 0, 0, 0); *(f32x4*)(Bu + fr * 132 + 16 * mt + 4 * fq) = acc; }
            WAVE_LDS_SYNC();
#pragma unroll
            for (int t = 0; t < 16; ++t) { const float bur = Bu[t * 132 + lane], bui = Bu[t * 132 + 64 + lane];
                const float nxr = ar * xr - ai * xi + bur, nxi = ar * xi + ai * xr + bui; xr = nxr; xi = nxi;
                if (FINAL) { *(unsigned short*)(X + t * 272 + lane * 2) = f2bf(xr); *(unsigned short*)(X + t * 272 + 128 + lane * 2) = f2bf(xi); } }
            WAVE_LDS_SYNC();
            if (FINAL) {
                f32x4 acc = (f32x4){0.f, 0.f, 0.f, 0.f};
#pragma unroll
                for (int ks = 0; ks < 4; ++ks) { const bf16x8 a = *(const bf16x8*)(X + fr * 272 + ks * 64 + fq * 16); acc = __builtin_amdgcn_mfma_f32_16x16x32_bf16(cf[ks], a, acc, 0, 0, 0); }
                { const size_t tok = tok0 + 16 * blk + fr; const u32x2 uw = urb[cur][blk];
                  u32x2 w2; w2.x = cvt_pk_bf16(gelu_tanh(acc[0] + dv4[0] * bflo(uw.x)), gelu_tanh(acc[1] + dv4[1] * bfhi(uw.x)));
                  w2.y = cvt_pk_bf16(gelu_tanh(acc[2] + dv4[2] * bflo(uw.y)), gelu_tanh(acc[3] + dv4[3] * bfhi(uw.y)));
                  *(u32x2*)(ys5 + tok * 1024 + g * 16 + 4 * fq) = w2; }
                WAVE_LDS_SYNC();
            }
        }
        if (!FINAL) *(f32x2*)(S5F + ((size_t)((b * 64 + g) * 64 + seg) * 64 + lane) * 2) = (f32x2){xr, xi};
    }
#undef S5_FETCH
    __syncthreads();
}

__device__ __forceinline__ void s5_carry(float* __restrict__ S5F, const float* __restrict__ S5A) {
    int tid = threadIdx.x; asm volatile("" : "+v"(tid));
    for (int gid = blockIdx.x * 512 + tid; gid < 8192; gid += gridDim.x * 512) {
        const int p = gid & 63, bg = gid >> 6, g = bg & 63;
        float pr = S5A[(g * 64 + p) * 2], pi = S5A[(g * 64 + p) * 2 + 1];
#pragma unroll
        for (int q = 0; q < 6; ++q) { const float nr = pr * pr - pi * pi, ni = 2.0f * pr * pi; pr = nr; pi = ni; }
        float xr = 0.f, xi = 0.f;
        f32x2* F = (f32x2*)(S5F + ((size_t)bg * 64 * 64 + p) * 2);
#pragma unroll 1
        for (int s0 = 0; s0 < 64; s0 += 16) { f32x2 f[16];
#pragma unroll
            for (int u = 0; u < 16; ++u) f[u] = F[(size_t)(s0 + u) * 64];
#pragma unroll
            for (int u = 0; u < 16; ++u) { const f32x2 fin = f[u]; f[u] = (f32x2){xr, xi}; const float nr = pr * xr - pi * xi + fin[0], ni = pr * xi + pi * xr + fin[1]; xr = nr; xi = ni; }
#pragma unroll
            for (int u = 0; u < 16; ++u) F[(size_t)(s0 + u) * 64] = f[u];
        }
    }
}

__device__ __forceinline__ void attn_item(int item, const bf16_t* __restrict__ qkv, const float* __restrict__ qg, const float* __restrict__ kg, const float* __restrict__ sinks, bf16_t* __restrict__ ycat, unsigned char* smb) {
    int tid = threadIdx.x; asm volatile("" : "+v"(tid));
    const int wave = tid >> 6, lane = tid & 63, fr = lane & 15, fq = lane >> 4;
    const int qb = item & 63, kvh = (item >> 6) & 3, b = item >> 8;
    const int q0 = qb * 64; const size_t tokb = (size_t)b * SEQ;
    unsigned char* Ks = smb;
    unsigned char* Vt = smb + 192 * 144;
    const int hq = kvh * 8 + wave;
    u32x4 qraw[4][2];
#pragma unroll
    for (int i = 0; i < 4; ++i) { const bf16_t* qp = qkv + (tokb + q0 + 16 * i + fr) * 2560 + hq * 64 + fq * 8; qraw[i][0] = *(const u32x4*)qp; qraw[i][1] = *(const u32x4*)(qp + 32); }
#pragma unroll
    for (int i = 0; i < 3; ++i) { const int idx = tid + i * 512; const int kidx = idx >> 3, dg = idx & 7; const int s = q0 - 127 + kidx; const bool ok = (s >= 0) && (kidx < 191);
        u32x4 kw = (u32x4){0u, 0u, 0u, 0u}, vw = kw;
        if (ok) { const bf16_t* rp = qkv + (tokb + s) * 2560 + kvh * 64 + dg * 8; kw = *(const u32x4*)(rp + 2048); vw = *(const u32x4*)(rp + 2304); }
        float k[8]; unpack8(kw, k);
        float ss = 0.f;
#pragma unroll
        for (int jj = 0; jj < 8; ++jj) ss += k[jj] * k[jj];
        ss += __shfl_xor(ss, 1); ss += __shfl_xor(ss, 2); ss += __shfl_xor(ss, 4);
        const float r = rsqrtf(ss * (1.0f / 64.0f) + 1e-6f);
        const f32x4 g0 = *(const f32x4*)(kg + dg * 8), g1 = *(const f32x4*)(kg + dg * 8 + 4);
        u32x4 w; w.x = cvt_pk_bf16(k[0] * r * g0[0], k[1] * r * g0[1]); w.y = cvt_pk_bf16(k[2] * r * g0[2], k[3] * r * g0[3]); w.z = cvt_pk_bf16(k[4] * r * g1[0], k[5] * r * g1[1]); w.w = cvt_pk_bf16(k[6] * r * g1[2], k[7] * r * g1[3]);
        *(u32x4*)(Ks + kidx * 144 + dg * 16) = w;
        unsigned short* vcol = (unsigned short*)(Vt + (dg * 8) * 392 + kidx * 2);
        vcol[0 * 196] = (unsigned short)(vw.x & 0xffffu); vcol[1 * 196] = (unsigned short)(vw.x >> 16); vcol[2 * 196] = (unsigned short)(vw.y & 0xffffu); vcol[3 * 196] = (unsigned short)(vw.y >> 16);
        vcol[4 * 196] = (unsigned short)(vw.z & 0xffffu); vcol[5 * 196] = (unsigned short)(vw.z >> 16); vcol[6 * 196] = (unsigned short)(vw.w & 0xffffu); vcol[7 * 196] = (unsigned short)(vw.w >> 16); }
    const float slope2 = exp2f(-0.25f * (float)(hq + 1)) * LOG2E, sink2 = sinks[hq] * LOG2E;
    __syncthreads();
#pragma unroll
    for (int i = 0; i < 4; ++i) {
        bf16x8 qf[2];
        { const u32x4 w0 = qraw[i][0], w1 = qraw[i][1]; float f0[8], f1[8]; unpack8(w0, f0); unpack8(w1, f1);
          float ss = 0.f;
#pragma unroll
          for (int jj = 0; jj < 8; ++jj) ss += f0[jj] * f0[jj] + f1[jj] * f1[jj];
          ss += __shfl_xor(ss, 16); ss += __shfl_xor(ss, 32);
          const float r = rsqrtf(ss * (1.0f / 64.0f) + 1e-6f) * 0.125f * LOG2E;
          const f32x4 ga = *(const f32x4*)(qg + fq * 8), gb = *(const f32x4*)(qg + fq * 8 + 4), gc = *(const f32x4*)(qg + 32 + fq * 8), gd = *(const f32x4*)(qg + 32 + fq * 8 + 4);
          u32x4 a, c;
          a.x = cvt_pk_bf16(f0[0] * r * ga[0], f0[1] * r * ga[1]); a.y = cvt_pk_bf16(f0[2] * r * ga[2], f0[3] * r * ga[3]); a.z = cvt_pk_bf16(f0[4] * r * gb[0], f0[5] * r * gb[1]); a.w = cvt_pk_bf16(f0[6] * r * gb[2], f0[7] * r * gb[3]);
          c.x = cvt_pk_bf16(f1[0] * r * gc[0], f1[1] * r * gc[1]); c.y = cvt_pk_bf16(f1[2] * r * gc[2], f1[3] * r * gc[3]); c.z = cvt_pk_bf16(f1[4] * r * gd[0], f1[5] * r * gd[1]); c.w = cvt_pk_bf16(f1[6] * r * gd[2], f1[7] * r * gd[3]);
          qf[0] = __builtin_bit_cast(bf16x8, a); qf[1] = __builtin_bit_cast(bf16x8, c); }
        f32x4 sc[9];
#pragma unroll
        for (int jr = 0; jr < 9; ++jr) { const unsigned char* kp = Ks + (16 * (i + jr) + fr) * 144 + fq * 16;
            const bf16x8 k0 = *(const bf16x8*)kp, k1 = *(const bf16x8*)(kp + 64);
            f32x4 acc = (f32x4){0.f, 0.f, 0.f, 0.f};
            acc = __builtin_amdgcn_mfma_f32_16x16x32_bf16(k0, qf[0], acc, 0, 0, 0);
            acc = __builtin_amdgcn_mfma_f32_16x16x32_bf16(k1, qf[1], acc, 0, 0, 0);
            sc[jr] = acc; }
        float m = sink2;
        const float nb = -slope2 * (float)(fr + 127 - 4 * fq); const bool head = q0 < 128;
#pragma unroll
        for (int jr = 0; jr < 9; ++jr)
#pragma unroll
            for (int e = 0; e < 4; ++e) { const int dist = fr + 127 - 16 * jr - 4 * fq - e; const int kidx = 16 * (i + jr) + 4 * fq + e;
                bool valid = true;
                if (jr == 0) valid = dist < 128;
                if (jr == 8) valid = dist >= 0;
                if (head) valid = valid && (q0 - 127 + kidx >= 0);
                const float v = valid ? fmaf(slope2, (float)(16 * jr + e), sc[jr][e]) + nb : -1e30f; sc[jr][e] = v; m = fmaxf(m, v); }
        m = fmaxf(m, __shfl_xor(m, 16)); m = fmaxf(m, __shfl_xor(m, 32));
        float l = 0.f;
#pragma unroll
        for (int jr = 0; jr < 9; ++jr)
#pragma unroll
            for (int e = 0; e < 4; ++e) { const float pv = ex2(sc[jr][e] - m); sc[jr][e] = pv; l += pv; }
        l += __shfl_xor(l, 16); l += __shfl_xor(l, 32);
        l += ex2(sink2 - m);
        const float inv = 1.0f / l;
        bf16x8 pf[5];
#pragma unroll
        for (int pp = 0; pp < 5; ++pp) { u32x4 w; w.x = cvt_pk_bf16(sc[2 * pp][0], sc[2 * pp][1]); w.y = cvt_pk_bf16(sc[2 * pp][2], sc[2 * pp][3]);
            if (pp < 4) { w.z = cvt_pk_bf16(sc[2 * pp + 1][0], sc[2 * pp + 1][1]); w.w = cvt_pk_bf16(sc[2 * pp + 1][2], sc[2 * pp + 1][3]); } else { w.z = 0u; w.w = 0u; }
            pf[pp] = __builtin_bit_cast(bf16x8, w); }
#pragma unroll
        for (int nt = 0; nt < 4; ++nt) { f32x4 o = (f32x4){0.f, 0.f, 0.f, 0.f};
            const unsigned char* vp = Vt + (nt * 16 + fr) * 392 + (16 * i + 4 * fq) * 2;
#pragma unroll
            for (int pp = 0; pp < 5; ++pp) { u32x4 w; const u32x2 lo = *(const u32x2*)(vp + (2 * pp) * 32); w.x = lo.x; w.y = lo.y;
                if (pp < 4) { const u32x2 hi = *(const u32x2*)(vp + (2 * pp + 1) * 32); w.z = hi.x; w.w = hi.y; } else { w.z = 0u; w.w = 0u; }
                o = __builtin_amdgcn_mfma_f32_16x16x32_bf16(__builtin_bit_cast(bf16x8, w), pf[pp], o, 0, 0, 0); }
            u32x2 w2; w2.x = cvt_pk_bf16(o[0] * inv, o[1] * inv); w2.y = cvt_pk_bf16(o[2] * inv, o[3] * inv);
            *(u32x2*)(ycat + (tokb + q0 + 16 * i + fr) * 2048 + hq * 64 + nt * 16 + 4 * fq) = w2; }
    }
    __syncthreads();
}

#define XB_TMO      128
#define XB_XCNT(j)  (256  + 64 * (j))
#define XB_XSUB(j)  (1280 + 64 * (j))
#define XB_XGEN(j)  (2304 + 64 * (j))
#define XB_TOP      3328
#define XB_TOPGEN   3392
#define XCD_BAR_WORDS 3456
#define XB_SPIN_CAP (1u << 18)
__device__ __forceinline__ unsigned xb_ld(unsigned* p)              { return __hip_atomic_load(p, __ATOMIC_RELAXED, __HIP_MEMORY_SCOPE_AGENT); }
__device__ __forceinline__ unsigned xb_add(unsigned* p, unsigned v) { return __hip_atomic_fetch_add(p, v, __ATOMIC_RELAXED, __HIP_MEMORY_SCOPE_AGENT); }
__device__ __forceinline__ unsigned xb_xcc_id() { return (unsigned)__builtin_amdgcn_s_getreg((3 << 11) | 20) & 0xFu; }
#define XB_SPIN(cond, bar) do { unsigned _sp = 0; while (cond) { __builtin_amdgcn_s_sleep(1); \
    if ((++_sp & 255u) == 0u) { if (xb_ld(&(bar)[XB_TMO])) break; if (_sp > XB_SPIN_CAP) { atomicAdd(&(bar)[XB_TMO], 1u); break; } } } } while (0)
struct XcdBarrier { unsigned* bar; unsigned x; volatile LAS unsigned* st; };
__device__ __forceinline__ XcdBarrier xcd_barrier_post(unsigned* bar, volatile LAS unsigned* st) {
    XcdBarrier b; b.bar = bar; b.x = xb_xcc_id(); b.st = st;
    if (threadIdx.x == 0) (void)xb_add(&bar[XB_XCNT(b.x)], 1u);
    return b;
}
__device__ __forceinline__ void xcd_barrier_complete(unsigned* bar, unsigned x, unsigned& nloc, unsigned& nx) {
    const unsigned G = gridDim.x * gridDim.y * gridDim.z;
    unsigned sum, cnt, mine, sp = 0u;
    for (;;) {
        sum = 0u; cnt = 0u; mine = 0u;
#pragma unroll
        for (unsigned j = 0; j < 16; ++j) { const unsigned c = xb_ld(&bar[XB_XCNT(j)]); sum += c; cnt += (c > 0u) ? 1u : 0u; mine = (j == x) ? c : mine; }
        if (sum == G) break;
        __builtin_amdgcn_s_sleep(1);
        if ((++sp & 255u) == 0u) { if (xb_ld(&bar[XB_TMO])) break; if (sp > XB_SPIN_CAP) { atomicAdd(&bar[XB_TMO], 1u); break; } }
    }
    nloc = mine > 0u ? mine : 1u; nx = cnt > 0u ? cnt : 1u;
}
__device__ __forceinline__ void xcd_barrier(const XcdBarrier& b) {
    asm volatile("s_waitcnt vmcnt(0)" ::: "memory");
    __syncthreads();
    if (threadIdx.x == 0) {
        unsigned* bar = b.bar;
        __builtin_amdgcn_s_waitcnt(0);
        unsigned nloc = b.st[0], nx = b.st[1];
        if (nloc == 0u) { xcd_barrier_complete(bar, b.x, nloc, nx); b.st[0] = nloc; b.st[1] = nx; }
        const unsigned old = xb_add(&bar[XB_XSUB(b.x)], 1u);
        const unsigned gen = old / nloc;
        if (old + 1u == (gen + 1u) * nloc) {
            __builtin_amdgcn_fence(__ATOMIC_RELEASE, "agent");
            asm volatile("s_waitcnt vmcnt(0)" ::: "memory");
            const unsigned og = xb_add(&bar[XB_TOP], 1u);
            const unsigned tg = og / nx;
            if (og + 1u == (tg + 1u) * nx) xb_add(&bar[XB_TOPGEN], 1u);
            else XB_SPIN(xb_ld(&bar[XB_TOPGEN]) == tg, bar);
            __builtin_amdgcn_fence(__ATOMIC_ACQUIRE, "agent");
            xb_add(&bar[XB_XGEN(b.x)], 1u);
            asm volatile("s_waitcnt vmcnt(0)" ::: "memory");
        } else {
            XB_SPIN(xb_ld(&bar[XB_XGEN(b.x)]) == gen, bar);
            __builtin_amdgcn_fence(__ATOMIC_ACQUIRE, "agent");
            asm volatile("s_waitcnt vmcnt(0)" ::: "memory");
        }
    }
    __syncthreads();
}

struct Args { const float* in[25]; float* out; unsigned char* ws; int ph_lo, ph_hi; };

__global__ void __launch_bounds__(512, 2) mega(Args a) {
    extern __shared__ __attribute__((aligned(16))) unsigned char lds[];
    float* sm = (float*)lds;
    unsigned char* ws = a.ws;
    bf16_t* Win_t = (bf16_t*)(ws + WS_WIN); bf16_t* Wglu_t = (bf16_t*)(ws + WS_WGLU); bf16_t* WoE_t = (bf16_t*)(ws + WS_WOE); bf16_t* Wqkv_t = (bf16_t*)(ws + WS_WQKV);
    bf16_t* WoO_t = (bf16_t*)(ws + WS_WOO); bf16_t* Wup_t = (bf16_t*)(ws + WS_WUP); bf16_t* Wdn_t = (bf16_t*)(ws + WS_WDN);
    bf16_t* XN = (bf16_t*)(ws + WS_XN); bf16_t* PROJ = (bf16_t*)(ws + WS_PROJ); bf16_t* YCAT = (bf16_t*)(ws + WS_YCAT); bf16_t* YS5 = (bf16_t*)(ws + WS_YS5); bf16_t* HID = (bf16_t*)(ws + WS_HID);
    bf16_t* HST = (bf16_t*)(ws + WS_HST); float* HDEC = (float*)(ws + WS_HDEC); float* S5F = (float*)(ws + WS_S5F); float* S5A = (float*)(ws + WS_S5A); float* S5B = (float*)(ws + WS_S5B); float* RS = (float*)(ws + WS_RS);
    const int G = gridDim.x, bid = blockIdx.x;
    if (threadIdx.x < 4) ((volatile LAS unsigned*)((LAS unsigned char*)lds + LDS_STAGE))[threadIdx.x] = 0u;
    __syncthreads();
    XcdBarrier xbar; xbar.bar = (unsigned*)(ws + WS_BAR); xbar.x = 0; xbar.st = nullptr;
    if (a.ph_hi - a.ph_lo > 1) xbar = xcd_barrier_post((unsigned*)(ws + WS_BAR), (volatile LAS unsigned*)((LAS unsigned char*)lds + LDS_STAGE));
    if (a.ph_lo > 1000) cg::this_grid().sync();

    for (int ph = a.ph_lo; ph < a.ph_hi; ++ph) {
      int nrep = 1;
      for (int rep = 0; rep < nrep; ++rep) {
        if (ph == 0) {
            if (REP_MASK & (1 << 11)) nrep = 2;
            for (int j = 0; j < 2; ++j) {
                transpose_cvt(a.in[2] + (size_t)j * 2048 * 5120, Win_t + (size_t)j * 5120 * 2048, 2048, 5120, sm, a.in[1] + (size_t)j * 2048, bid, G);
                transpose_cvt(a.in[11] + (size_t)j * 1024 * 1024, Wglu_t + (size_t)j * 1024 * 1024, 1024, 1024, sm, nullptr, bid, G);
                transpose_cvt(a.in[15] + (size_t)j * 2048 * 2048, WoE_t + (size_t)j * 2048 * 2048, 2048, 2048, sm, nullptr, bid, G);
                transpose_cvt(a.in[17] + (size_t)j * 2048 * 2560, Wqkv_t + (size_t)j * 2560 * 2048, 2048, 2560, sm, a.in[16] + (size_t)j * 2048, bid, G);
                transpose_cvt(a.in[21] + (size_t)j * 2048 * 2048, WoO_t + (size_t)j * 2048 * 2048, 2048, 2048, sm, nullptr, bid, G);
            }
            s5_params(a.in[3], a.in[4], a.in[5], a.in[6], a.in[7], S5A, S5B);
            x_stats_phase(a.in[0], XN, RS);
        } else {
            const int q = ph - 1, pair = q / 13, r = q % 13;
            const bool odd = r >= 8; const int layer = pair * 2 + (odd ? 1 : 0), j = pair; const int rr = odd ? r - 8 : r;
            int kind;
            if (!odd) kind = rr == 0 ? 1 : rr == 1 ? 2 : rr == 2 ? 3 : rr == 3 ? 4 : rr == 4 ? 5 : rr == 5 ? 6 : rr == 6 ? 8 : 9;
            else kind = rr == 0 ? 1 : rr == 1 ? 10 : rr == 2 ? 6 : rr == 3 ? 8 : 9;
            if ((REP_MASK >> kind) & 1) nrep = 2;
            switch (kind) {
            case 1: case 8: {
                pg8::Gemm g; pg8::EpiBf16 E; const float* rs;
                float* RL = (float*)(lds + 131072);
                if (kind == 8) { g = pg8::Gemm{XN, Wup_t + (size_t)layer * 8192 * 2048, T, 8192, 2048}; E = pg8::EpiBf16{HID, 8192, 1, RL}; rs = RS + (size_t)(2 * layer + 1) * T * 32; }
                else if (!odd) { g = pg8::Gemm{XN, Win_t + (size_t)j * 5120 * 2048, T, 5120, 2048}; E = pg8::EpiBf16{PROJ, 5120, 0, RL}; rs = RS + (size_t)(2 * layer) * T * 32; }
                else { g = pg8::Gemm{XN, Wqkv_t + (size_t)j * 2560 * 2048, T, 2560, 2048}; E = pg8::EpiBf16{PROJ, 2560, 0, RL}; rs = RS + (size_t)(2 * layer) * T * 32; }
                pg8::StaticOrder S; S.init(g.M, g.N, G, bid);
                { int tid = threadIdx.x; asm volatile("" : "+v"(tid));
#pragma unroll
                  for (int i0 = 0; i0 < 4; i0 += 2) { const int i = i0 + (tid >> 8); pg8::Unit u;
                      if (S.next(i, u)) { const float* rp = rs + (size_t)(u.pm * 256 + (tid & 255)) * 32; f32x4 t4 = *(const f32x4*)rp;
#pragma unroll
                          for (int q4 = 1; q4 < 8; ++q4) t4 = t4 + *(const f32x4*)(rp + 4 * q4);
                          RL[i * 256 + (tid & 255)] = rsqrtf(((t4[0] + t4[1]) + (t4[2] + t4[3])) * (1.0f / 2048.0f) + 1e-6f); } }
                  __syncthreads(); }
                pg8::gemm_phase<pg8::EpiBf16, true, GEMM_SP2>((LAS unsigned char*)lds, g, S, E);
                if (kind == 1 && rep == 0) {
                    const int nfull = S.nwg % G;
                    if (nfull != 0 && bid >= nfull) {
                        __syncthreads();
                        transpose_cvt(a.in[23] + (size_t)layer * 2048 * 8192, Wup_t + (size_t)layer * 8192 * 2048, 2048, 8192, sm, a.in[22] + (size_t)layer * 2048, bid - nfull, G - nfull);
                        if (odd) transpose_cvt(a.in[24] + (size_t)layer * 8192 * 2048, Wdn_t + (size_t)layer * 2048 * 8192, 8192, 2048, sm, nullptr, bid - nfull, G - nfull);
                    } else if (nfull == 0 && !odd) { __syncthreads(); transpose_cvt(a.in[23] + (size_t)layer * 2048 * 8192, Wup_t + (size_t)layer * 8192 * 2048, 2048, 8192, sm, a.in[22] + (size_t)layer * 2048, bid, G); }
                    else if (nfull == 0) { __syncthreads(); transpose_cvt(a.in[23] + (size_t)layer * 2048 * 8192, Wup_t + (size_t)layer * 8192 * 2048, 2048, 8192, sm, a.in[22] + (size_t)layer * 2048, bid, G);
                        transpose_cvt(a.in[24] + (size_t)layer * 8192 * 2048, Wdn_t + (size_t)layer * 2048 * 8192, 8192, 2048, sm, nullptr, bid, G); }
                }
            } break;
            case 5: {
                pg8::Gemm g{YS5, Wglu_t + (size_t)j * 1024 * 1024, T, 1024, 1024}; pg8::EpiGlu E{YS5, a.in[12] + (size_t)j * 1024, YCAT, 2048};
                pg8::StaticOrder S; S.init(g.M, g.N, G, bid);
                pg8::gemm_phase<pg8::EpiGlu, false, GEMM_SP2>((LAS unsigned char*)lds, g, S, E);
                if (rep == 0) { const int nfull = S.nwg < G ? S.nwg : 0;
                    __syncthreads();
                    if (nfull != 0) { if (bid >= nfull) transpose_cvt(a.in[24] + (size_t)layer * 8192 * 2048, Wdn_t + (size_t)layer * 2048 * 8192, 8192, 2048, sm, nullptr, bid - nfull, G - nfull); }
                    else transpose_cvt(a.in[24] + (size_t)layer * 8192 * 2048, Wdn_t + (size_t)layer * 2048 * 8192, 8192, 2048, sm, nullptr, bid, G); }
            } break;
            case 6: case 9: {
                pg8::Gemm g;
                if (kind == 9) g = pg8::Gemm{HID, Wdn_t + (size_t)layer * 2048 * 8192, T, 2048, 8192};
                else g = pg8::Gemm{YCAT, (odd ? WoO_t : WoE_t) + (size_t)j * 2048 * 2048, T, 2048, 2048};
                const int slot = kind == 9 ? 2 * layer + 2 : 2 * layer + 1;
                pg8::EpiResid E{XN, RS + (size_t)slot * T * 32, (kind == 9 && layer == 3) ? a.out : (float*)nullptr};
                pg8::StaticOrder S; S.init(g.M, g.N, G, bid);
                pg8::gemm_phase<pg8::EpiResid, false, GEMM_SP2>((LAS unsigned char*)lds, g, S, E);
            } break;
            case 2:
                for (int r2 = 0; r2 < ((REP2 & 8) ? 2 : 1); ++r2) for (int it = bid; it < 1024; it += G) hgrn_p1(it, PROJ, a.in[13], j, HST, HDEC, lds);
                if (G == 256) s5_wg<false>(bid, PROJ, S5A + (size_t)j * 8192, S5B + (size_t)j * 131072, S5F, nullptr, nullptr, nullptr, nullptr, lds);
                else for (int r2 = 0; r2 < ((REP2 & 16) ? 2 : 1); ++r2) for (int it = bid; it < 1024; it += G) s5_pass<false>(it, PROJ, S5A + (size_t)j * 8192, S5B + (size_t)j * 131072, S5F, nullptr, nullptr, nullptr, nullptr, lds);
                break;
            case 3: hgrn_p2(HST, HDEC); s5_carry(S5F, S5A + (size_t)j * 8192); break;
            case 4:
                for (int r2 = 0; r2 < ((REP2 & 1) ? 2 : 1); ++r2) for (int it = bid; it < 1024; it += G) hgrn_p3(it, PROJ, a.in[13], j, HST, a.in[14] + (size_t)j * 128, YCAT, lds);
                if (G == 256) s5_wg<true>(bid, PROJ, S5A + (size_t)j * 8192, S5B + (size_t)j * 131072, S5F, a.in[8] + (size_t)j * 65536, a.in[9] + (size_t)j * 65536, a.in[10] + (size_t)j * 1024, YS5, lds);
                else for (int r2 = 0; r2 < ((REP2 & 2) ? 2 : 1); ++r2) for (int it = bid; it < 1024; it += G) s5_pass<true>(it, PROJ, S5A + (size_t)j * 8192, S5B + (size_t)j * 131072, S5F, a.in[8] + (size_t)j * 65536, a.in[9] + (size_t)j * 65536, a.in[10] + (size_t)j * 1024, YS5, lds);
                break;
            case 10:
                for (int it = bid; it < 512; it += G) attn_item(it, PROJ, a.in[18] + (size_t)j * 64, a.in[19] + (size_t)j * 64, a.in[20] + (size_t)j * 32, YCAT, lds);
                break;
            default: break;
            }
        }
      }
        if (ph + 1 < a.ph_hi) { xcd_barrier(xbar); if (REP2 & 4) xcd_barrier(xbar); }
    }
}

extern "C" void kernel_launch(void* const* d_in, const int* in_sizes, int n_in, void* d_out, int out_size, void* d_ws, size_t ws_size, hipStream_t stream) {
    static int grid = 0;
    if (grid == 0) {
        if (n_in != 25 || ws_size < WS_END) { fprintf(stderr, "kernel_launch: need 25 inputs and %zu bytes of workspace; got %d, %zu\n", (size_t)WS_END, n_in, ws_size); grid = -1; return; }
        int dev = 0, cus = 0, per_cu = 0;
        hipGetDevice(&dev); hipDeviceGetAttribute(&cus, hipDeviceAttributeMultiprocessorCount, dev);
        if (hipFuncSetAttribute((const void*)mega, hipFuncAttributeMaxDynamicSharedMemorySize, LDS_BYTES) != hipSuccess) { fprintf(stderr, "kernel_launch: hipFuncSetAttribute failed\n"); grid = -1; return; }
        if (hipOccupancyMaxActiveBlocksPerMultiprocessor(&per_cu, (const void*)mega, 512, LDS_BYTES) != hipSuccess || per_cu < 1) { fprintf(stderr, "kernel_launch: occupancy query says %d\n", per_cu); per_cu = 1; }
        (void)hipGetLastError();
        grid = cus > 0 ? cus : 256;
    }
    if (grid < 0) return;
    Args a{};
    for (int i = 0; i < 25; ++i) a.in[i] = (const float*)d_in[i];
    a.out = (float*)d_out; a.ws = (unsigned char*)d_ws;
#if MK_ONE_LAUNCH
    a.ph_lo = 0; a.ph_hi = NPH;
    if (hipMemsetAsync((unsigned char*)d_ws + WS_BAR, 0, (size_t)XCD_BAR_WORDS_C * 4, stream) != hipSuccess) { fprintf(stderr, "kernel_launch: memset failed\n"); return; }
    void* args[] = {&a};
    hipError_t e = hipLaunchCooperativeKernel((const void*)mega, dim3(grid), dim3(512), args, LDS_BYTES, stream);
    if (e != hipSuccess) fprintf(stderr, "kernel_launch: cooperative launch failed: %s (grid %d)\n", hipGetErrorString(e), grid);
#else
    for (int ph = 0; ph < NPH; ++ph) { a.ph_lo = ph; a.ph_hi = ph + 1; hipLaunchKernelGGL(mega, dim3(grid), dim3(512), LDS_BYTES, stream, a); }
#endif
}
```

```cpp
#include <hip/hip_runtime.h>
#include <hip/hip_cooperative_groups.h>
#include <cstdio>
namespace cg = cooperative_groups;

#ifndef REP_MASK
#define REP_MASK 0
#endif
#ifndef H3REP
#define H3REP 0
#endif
#ifndef REP2
#define REP2 0
#endif
#ifndef GEMM_SP2
#define GEMM_SP2 true
#endif
#ifndef MK_ONE_LAUNCH
#define MK_ONE_LAUNCH 1
#endif

#define LAS __attribute__((address_space(3)))
typedef unsigned short bf16_t;
typedef short bf16x8 __attribute__((ext_vector_type(8)));
typedef float f32x4 __attribute__((ext_vector_type(4)));
typedef float f32x2 __attribute__((ext_vector_type(2)));
typedef unsigned u32x4 __attribute__((ext_vector_type(4)));
typedef unsigned u32x2 __attribute__((ext_vector_type(2)));

constexpr int T = 8192, SEQ = 4096;
constexpr int NPH = 27;
constexpr int LDS_STAGE = 135168;
constexpr int LDS_BYTES = LDS_STAGE + 16;
constexpr int XCD_BAR_WORDS_C = 3456;
constexpr float LOG2E = 1.4426950408889634f;

constexpr size_t SZ_WIN = (size_t)5120 * 2048 * 2, SZ_WGLU = (size_t)1024 * 1024 * 2, SZ_WSQ = (size_t)2048 * 2048 * 2, SZ_WQKV = (size_t)2560 * 2048 * 2, SZ_WUP = (size_t)8192 * 2048 * 2;
constexpr size_t WS_WIN = 0;
constexpr size_t WS_WGLU = WS_WIN + 2 * SZ_WIN;
constexpr size_t WS_WOE = WS_WGLU + 2 * SZ_WGLU;
constexpr size_t WS_WQKV = WS_WOE + 2 * SZ_WSQ;
constexpr size_t WS_WOO = WS_WQKV + 2 * SZ_WQKV;
constexpr size_t WS_WUP = WS_WOO + 2 * SZ_WSQ;
constexpr size_t WS_WDN = WS_WUP + 4 * SZ_WUP;
constexpr size_t WS_XN = WS_WDN + 4 * SZ_WUP;
constexpr size_t WS_PROJ = WS_XN + (size_t)T * 2048 * 2;
constexpr size_t WS_YCAT = WS_PROJ + (size_t)T * 5120 * 2;
constexpr size_t WS_YS5 = WS_YCAT + (size_t)T * 2048 * 2;
constexpr size_t WS_HID = WS_YS5 + (size_t)T * 1024 * 2;
constexpr size_t WS_HST = WS_HID + (size_t)T * 8192 * 2;
constexpr size_t WS_HDEC = WS_HST + (size_t)16 * 64 * 16384 * 4;
constexpr size_t WS_S5F = WS_HDEC + (size_t)16 * 64 * 128 * 4;
constexpr size_t WS_S5A = WS_S5F + (size_t)128 * 64 * 64 * 2 * 4;
constexpr size_t WS_S5B = WS_S5A + (size_t)2 * 64 * 64 * 2 * 4;
constexpr size_t WS_RS = WS_S5B + (size_t)2 * 64 * 64 * 32 * 4;
constexpr size_t WS_BAR = WS_RS + (size_t)9 * T * 32 * 4;
constexpr size_t WS_END = WS_BAR + (size_t)XCD_BAR_WORDS_C * 4;


__device__ __forceinline__ unsigned cvt_pk_bf16(float lo, float hi) { unsigned r; asm volatile("v_cvt_pk_bf16_f32 %0, %1, %2" : "=v"(r) : "v"(lo), "v"(hi)); return r; }
__device__ __forceinline__ unsigned short f2bf(float f) { unsigned u = __builtin_bit_cast(unsigned, f); return (unsigned short)((u + 0x7fffu + ((u >> 16) & 1u)) >> 16); }
__device__ __forceinline__ float bflo(unsigned w) { return __builtin_bit_cast(float, w << 16); }
__device__ __forceinline__ float bfhi(unsigned w) { return __builtin_bit_cast(float, w & 0xffff0000u); }
__device__ __forceinline__ void unpack8(u32x4 w, float (&f)[8]) {
    f[0] = bflo(w.x); f[1] = bfhi(w.x); f[2] = bflo(w.y); f[3] = bfhi(w.y); f[4] = bflo(w.z); f[5] = bfhi(w.z); f[6] = bflo(w.w); f[7] = bfhi(w.w);
}
__device__ __forceinline__ float wave_sum(float v) {
#pragma unroll
    for (int o = 32; o > 0; o >>= 1) v += __shfl_xor(v, o);
    return v;
}
__device__ __forceinline__ float sigmoidf_(float x) { return __builtin_amdgcn_rcpf(1.0f + __expf(-x)); }
__device__ __forceinline__ float ex2(float x) { return __builtin_amdgcn_exp2f(x); }

namespace pg8 {
constexpr int BM = 256, BK = 64, HALF = 128, HTB = HALF * BK * 2, STAGE_BYTES = 8 * HTB, NXCD = 8, WGM = 8;
__device__ __forceinline__ int lds_byte(int r, int c) { const int st = (r >> 4) * 2 + (c >> 5), rr = r & 15, cc = c & 31, ob = rr * 64 + cc * 2; return st * 1024 + (ob ^ (((ob >> 9) & 1) << 5)); }
__device__ __forceinline__ void stage_rc(int b, int& R, int& C) { const int st = b / 1024, sb = b % 1024, swz = sb ^ (((sb >> 9) & 1) << 5); R = (st >> 1) * 16 + swz / 64; C = (st & 1) * 32 + (swz % 64) / 2; }
__device__ __forceinline__ int perm32(int rho) { const int n = rho >> 4, i = rho & 15; return 8 * (i >> 2) + 4 * n + (i & 3); }

struct Unit { int pm, pn; };
struct Gemm { const bf16_t* A; const bf16_t* Bt; int M, N, K; };

struct StaticOrder {
    int nM, nN, nwg, G, c;
    __device__ void init(int M, int N, int G_, int c_) { nM = M / BM; nN = N / BM; nwg = nM * nN; G = G_; c = c_; }
    __device__ bool next(int i, Unit& u) const {
        const long L = (long)i * G + c; if (L >= nwg) return false;
        int wgid = (int)L; { const int q = nwg / NXCD, r = nwg % NXCD, xcd = wgid % NXCD, off = wgid / NXCD; wgid = (xcd < r ? xcd * (q + 1) : r * (q + 1) + (xcd - r) * q) + off; }
        const int nig = WGM * nN, gid = wgid / nig, fm = gid * WGM, gsz = (nM - fm) < WGM ? (nM - fm) : WGM;
        u.pm = fm + ((wgid % nig) % gsz); u.pn = (wgid % nig) / gsz; return true;
    }
};

struct EpiBf16 {
    static constexpr bool PERM = true;
    bf16_t* O; int ldc; int act; const float* rl;
    __device__ __forceinline__ void operator()(const f32x4 (&acc)[2][2][4][2], const Unit& u, int ui, int wr, int wc, int fr, int fq) const {
        const int row0 = u.pm * BM + wr * 64 + fr, col0 = u.pn * BM + wc * 32 + 8 * fq;
#pragma unroll
        for (int ai = 0; ai < 2; ++ai)
#pragma unroll
            for (int m = 0; m < 4; ++m) { const int row = row0 + ai * HALF + m * 16; bf16_t* rowp = O + (size_t)row * ldc + col0;
                const float r = rl[ui * 256 + wr * 64 + fr + ai * HALF + m * 16];
#pragma unroll
                for (int bj = 0; bj < 2; ++bj) { f32x4 v0 = acc[ai][bj][m][0] * r, v1 = acc[ai][bj][m][1] * r;
                    if (act) {
#pragma unroll
                        for (int j = 0; j < 4; ++j) { float a = fmaxf(v0[j], 0.f), b = fmaxf(v1[j], 0.f); v0[j] = a * a; v1[j] = b * b; } }
                    u32x4 w; w.x = cvt_pk_bf16(v0[0], v0[1]); w.y = cvt_pk_bf16(v0[2], v0[3]); w.z = cvt_pk_bf16(v1[0], v1[1]); w.w = cvt_pk_bf16(v1[2], v1[3]);
                    *(u32x4*)(rowp + bj * HALF) = w; } }
    }
};
struct EpiGlu {
    static constexpr bool PERM = true;
    const bf16_t* Y; const float* bias; bf16_t* O; int ldo;
    __device__ __forceinline__ void operator()(const f32x4 (&acc)[2][2][4][2], const Unit& u, int ui, int wr, int wc, int fr, int fq) const {
        const int row0 = u.pm * BM + wr * 64 + fr, col0 = u.pn * BM + wc * 32 + 8 * fq;
        f32x4 bb[2][2];
#pragma unroll
        for (int bj = 0; bj < 2; ++bj) { bb[bj][0] = *(const f32x4*)(bias + col0 + bj * HALF); bb[bj][1] = *(const f32x4*)(bias + col0 + bj * HALF + 4); }
#pragma unroll
        for (int ai = 0; ai < 2; ++ai) { u32x4 yw[4][2];
#pragma unroll
            for (int m = 0; m < 4; ++m)
#pragma unroll
                for (int bj = 0; bj < 2; ++bj) yw[m][bj] = *(const u32x4*)(Y + (size_t)(row0 + ai * HALF + m * 16) * 1024 + col0 + bj * HALF);
#pragma unroll
            for (int m = 0; m < 4; ++m) { const int row = row0 + ai * HALF + m * 16;
#pragma unroll
                for (int bj = 0; bj < 2; ++bj) { const int col = col0 + bj * HALF; float y[8]; unpack8(yw[m][bj], y);
                    const f32x4 v0 = acc[ai][bj][m][0] + bb[bj][0], v1 = acc[ai][bj][m][1] + bb[bj][1]; float o[8];
#pragma unroll
                    for (int j = 0; j < 4; ++j) { o[j] = y[j] * sigmoidf_(v0[j]); o[4 + j] = y[4 + j] * sigmoidf_(v1[j]); }
                    u32x4 w; w.x = cvt_pk_bf16(o[0], o[1]); w.y = cvt_pk_bf16(o[2], o[3]); w.z = cvt_pk_bf16(o[4], o[5]); w.w = cvt_pk_bf16(o[6], o[7]);
                    *(u32x4*)(O + (size_t)row * ldo + col) = w; } } }
    }
};
struct EpiResid {
    static constexpr bool PERM = true;
    bf16_t* hb; float* rs; float* outf;
    __device__ __forceinline__ void operator()(const f32x4 (&acc)[2][2][4][2], const Unit& u, int ui, int wr, int wc, int fr, int fq) const {
        const int row0 = u.pm * BM + wr * 64 + fr, col0 = u.pn * BM + wc * 32 + 8 * fq;
#pragma unroll
        for (int ai = 0; ai < 2; ++ai) { u32x4 bv[4][2];
#pragma unroll
            for (int m = 0; m < 4; ++m)
#pragma unroll
                for (int bj = 0; bj < 2; ++bj) bv[m][bj] = *(const u32x4*)(hb + (size_t)(row0 + ai * HALF + m * 16) * 2048 + col0 + bj * HALF);
#pragma unroll
            for (int m = 0; m < 4; ++m) { const int row = row0 + ai * HALF + m * 16; const size_t ro = (size_t)row * 2048 + col0; float ss = 0.f;
#pragma unroll
                for (int bj = 0; bj < 2; ++bj) { const size_t o = ro + bj * HALF; float f[8]; unpack8(bv[m][bj], f);
                    const f32x4 v0 = (f32x4){f[0], f[1], f[2], f[3]} + acc[ai][bj][m][0], v1 = (f32x4){f[4], f[5], f[6], f[7]} + acc[ai][bj][m][1];
                    if (outf) { *(f32x4*)(outf + o) = v0; *(f32x4*)(outf + o + 4) = v1; }
                    else { u32x4 w; w.x = cvt_pk_bf16(v0[0], v0[1]); w.y = cvt_pk_bf16(v0[2], v0[3]); w.z = cvt_pk_bf16(v1[0], v1[1]); w.w = cvt_pk_bf16(v1[2], v1[3]); *(u32x4*)(hb + o) = w;
                        float r[8]; unpack8(w, r);
#pragma unroll
                        for (int q = 0; q < 8; ++q) ss += r[q] * r[q]; } }
                if (!outf) { ss += __shfl_xor(ss, 16); ss += __shfl_xor(ss, 32); if (fq == 0) rs[(size_t)row * 32 + u.pn * 4 + wc] = ss; } } }
    }
};

template <class Epi, bool ALIGN_EPI, bool SP2>
__device__ __forceinline__ void gemm_phase(LAS unsigned char* lds, const Gemm g, const StaticOrder& S, const Epi& E) {
    int tid = threadIdx.x; asm volatile("" : "+v"(tid));
    const int wid = __builtin_amdgcn_readfirstlane(tid >> 6), lane = tid & 63, wr = wid >> 2, wc = wid & 3, fr = lane & 15, fq = lane >> 4;
    const int K = g.K, nt = K / BK;
    unsigned voffA[2], voffB[2];
#pragma unroll
    for (int i = 0; i < 2; ++i) { int R, C; stage_rc(tid * 16 + i * 8192, R, C); const int Rb = Epi::PERM ? ((R & ~31) + perm32(R & 31)) : R;
        voffA[i] = (unsigned)(R * K + C) * 2u; voffB[i] = (unsigned)(Rb * K + C) * 2u; }
    const size_t kstep = (size_t)(BK * 2);
    const size_t hstep = (size_t)HALF * K * 2;
    const size_t tstep = 2 * hstep;
    const unsigned ldsw = (unsigned)wid * 1024u;
    const int aoff = lds_byte(wr * 64 + fr, fq * 8), boff = lds_byte(wc * 32 + fr, fq * 8);
#define PG8_SA(b, h) (((b) * 2 + (h)) * HTB)
#define PG8_SB(b, h) ((4 + (b) * 2 + (h)) * HTB)
#define PG8_STAGE(bufoff, gbase, voff) do { _Pragma("unroll") for (int _i = 0; _i < 2; ++_i) \
        __builtin_amdgcn_global_load_lds((const unsigned*)((const char*)(gbase) + (voff)[_i]), (LAS unsigned*)(lds + (bufoff) + ldsw + _i * 8192), 16, 0, 0); } while (0)
#define PG8_LDA(dst, b, h) do { _Pragma("unroll") for (int m = 0; m < 4; ++m) _Pragma("unroll") for (int k = 0; k < 2; ++k) dst[m][k] = *(const LAS bf16x8*)(lds + PG8_SA(b, h) + aoff + m * 2048 + k * 1024); } while (0)
#define PG8_LDB(dst, b, h) do { _Pragma("unroll") for (int n = 0; n < 2; ++n) _Pragma("unroll") for (int k = 0; k < 2; ++k) dst[n][k] = *(const LAS bf16x8*)(lds + PG8_SB(b, h) + boff + n * 2048 + k * 1024); } while (0)
#define PG8_MMA(ai, bj, At, Bt) do { __builtin_amdgcn_s_setprio(1); _Pragma("unroll") for (int m = 0; m < 4; ++m) _Pragma("unroll") for (int n = 0; n < 2; ++n) _Pragma("unroll") for (int k = 0; k < 2; ++k) \
        acc[ai][bj][m][n] = __builtin_amdgcn_mfma_f32_16x16x32_bf16(Bt[n][k], At[m][k], acc[ai][bj][m][n], 0, 0, 0); __builtin_amdgcn_s_setprio(0); } while (0)
#define PG8_WAIT_V(n) asm volatile("s_waitcnt vmcnt(" #n ")" ::: "memory")
#define PG8_WAIT_L(n) asm volatile("s_waitcnt lgkmcnt(" #n ")" ::: "memory")
#define PG8_BAR __builtin_amdgcn_s_barrier()
#define PG8_SCHED __builtin_amdgcn_sched_barrier(0)
    Unit cur, nxt; int ui = 0;
    if (!S.next(0, cur)) return;
    f32x4 acc[2][2][4][2];
#pragma unroll
    for (int a = 0; a < 2; ++a)
#pragma unroll
        for (int b = 0; b < 2; ++b)
#pragma unroll
            for (int m = 0; m < 4; ++m)
#pragma unroll
                for (int n = 0; n < 2; ++n) acc[a][b][m][n] = (f32x4){0.f, 0.f, 0.f, 0.f};
    bf16x8 At[4][2], B0[2][2], B1[2][2];
    const char* cA = (const char*)g.A + (size_t)cur.pm * tstep; const char* cB = (const char*)g.Bt + (size_t)cur.pn * tstep;
    if constexpr (SP2) {
        PG8_STAGE(PG8_SB(0, 0), cB, voffB); PG8_STAGE(PG8_SB(0, 1), cB + hstep, voffB); PG8_STAGE(PG8_SA(0, 0), cA, voffA); PG8_STAGE(PG8_SA(0, 1), cA + hstep, voffA);
        if (wr == 1) PG8_BAR;
        PG8_WAIT_V(2); PG8_BAR;
        PG8_STAGE(PG8_SB(1, 0), cB + kstep, voffB); PG8_STAGE(PG8_SA(1, 0), cA + kstep, voffA); PG8_STAGE(PG8_SB(1, 1), cB + hstep + kstep, voffB);
        PG8_WAIT_V(6); PG8_BAR;
    } else {
    PG8_STAGE(PG8_SB(0, 0), cB, voffB); PG8_STAGE(PG8_SA(0, 0), cA, voffA); PG8_STAGE(PG8_SB(0, 1), cB + hstep, voffB); PG8_STAGE(PG8_SA(0, 1), cA + hstep, voffA);
    if (wr == 1) PG8_BAR;
    PG8_WAIT_V(4); PG8_BAR;
    PG8_STAGE(PG8_SB(1, 0), cB + kstep, voffB); PG8_STAGE(PG8_SA(1, 0), cA + kstep, voffA); PG8_STAGE(PG8_SB(1, 1), cB + hstep + kstep, voffB);
    PG8_WAIT_V(6); PG8_BAR;
    }
    for (;;) {
        const bool has_next = S.next(ui + 1, nxt);
        const char* nA = has_next ? (const char*)g.A + (size_t)nxt.pm * tstep : cA; const char* nB = has_next ? (const char*)g.Bt + (size_t)nxt.pn * tstep : cB;
        for (int t = 0; t < nt; t += 2) {
            const bool last = (t == nt - 2);
            const char* a1 = cA + (size_t)(t + 1) * kstep;
            const char* a2 = last ? nA : cA + (size_t)(t + 2) * kstep; const char* b2 = last ? nB : cB + (size_t)(t + 2) * kstep;
            const char* a3 = a2 + kstep; const char* b3 = b2 + kstep;
            if constexpr (SP2) {
            PG8_LDB(B0, 0, 0); PG8_LDB(B1, 0, 1); PG8_SCHED; PG8_LDA(At, 0, 0); PG8_STAGE(PG8_SA(1, 1), a1 + hstep, voffA);
            PG8_WAIT_V(8); PG8_WAIT_L(0); PG8_BAR; PG8_MMA(0, 0, At, B0); PG8_MMA(0, 1, At, B1); PG8_BAR; PG8_SCHED;
            PG8_LDA(At, 0, 1); PG8_STAGE(PG8_SB(0, 0), b2, voffB); PG8_STAGE(PG8_SB(0, 1), b2 + hstep, voffB); PG8_STAGE(PG8_SA(0, 0), a2, voffA);
            PG8_WAIT_V(8); PG8_WAIT_L(0); PG8_BAR; PG8_MMA(1, 0, At, B0); PG8_MMA(1, 1, At, B1); PG8_BAR; PG8_SCHED;
            PG8_LDB(B0, 1, 0); PG8_LDB(B1, 1, 1); PG8_SCHED; PG8_LDA(At, 1, 0); PG8_STAGE(PG8_SA(0, 1), a2 + hstep, voffA);
            PG8_WAIT_V(8); PG8_WAIT_L(0); PG8_BAR; PG8_MMA(0, 0, At, B0); PG8_MMA(0, 1, At, B1); PG8_BAR; PG8_SCHED;
            PG8_LDA(At, 1, 1); PG8_STAGE(PG8_SB(1, 0), b3, voffB); PG8_STAGE(PG8_SB(1, 1), b3 + hstep, voffB); PG8_STAGE(PG8_SA(1, 0), a3, voffA);
            PG8_WAIT_V(8); PG8_WAIT_L(0); PG8_BAR; PG8_MMA(1, 0, At, B0); PG8_MMA(1, 1, At, B1); PG8_BAR; PG8_SCHED;
            } else {
            PG8_LDB(B0, 0, 0); PG8_SCHED; PG8_LDA(At, 0, 0); PG8_STAGE(PG8_SA(1, 1), a1 + hstep, voffA);
            PG8_WAIT_L(8); PG8_BAR; PG8_WAIT_L(0); PG8_MMA(0, 0, At, B0); PG8_BAR; PG8_SCHED;
            PG8_LDB(B1, 0, 1); PG8_STAGE(PG8_SB(0, 0), b2, voffB);
            PG8_BAR; PG8_WAIT_L(0); PG8_MMA(0, 1, At, B1); PG8_BAR;
            PG8_LDA(At, 0, 1); PG8_STAGE(PG8_SA(0, 0), a2, voffA);
            PG8_BAR; PG8_WAIT_L(0); PG8_MMA(1, 0, At, B0); PG8_BAR; PG8_SCHED;
            PG8_STAGE(PG8_SB(0, 1), b2 + hstep, voffB);
            PG8_WAIT_V(6); PG8_BAR; PG8_MMA(1, 1, At, B1); PG8_BAR;
            PG8_LDB(B0, 1, 0); PG8_SCHED; PG8_LDA(At, 1, 0); PG8_STAGE(PG8_SA(0, 1), a2 + hstep, voffA);
            PG8_WAIT_L(8); PG8_BAR; PG8_WAIT_L(0); PG8_MMA(0, 0, At, B0); PG8_BAR; PG8_SCHED;
            PG8_LDB(B1, 1, 1); PG8_STAGE(PG8_SB(1, 0), b3, voffB);
            PG8_BAR; PG8_WAIT_L(0); PG8_MMA(0, 1, At, B1); PG8_BAR;
            PG8_LDA(At, 1, 1); PG8_STAGE(PG8_SA(1, 0), a3, voffA);
            PG8_BAR; PG8_WAIT_L(0); PG8_MMA(1, 0, At, B0); PG8_BAR; PG8_SCHED;
            PG8_STAGE(PG8_SB(1, 1), b3 + hstep, voffB);
            PG8_WAIT_V(6); PG8_BAR; PG8_MMA(1, 1, At, B1); PG8_BAR;
            }
        }
        if constexpr (ALIGN_EPI) { if (wr == 0) PG8_BAR; }
        E(acc, cur, ui, wr, wc, fr, fq);
        if (!has_next) break;
#pragma unroll
        for (int a = 0; a < 2; ++a)
#pragma unroll
            for (int b = 0; b < 2; ++b)
#pragma unroll
                for (int m = 0; m < 4; ++m)
#pragma unroll
                    for (int n = 0; n < 2; ++n) acc[a][b][m][n] = (f32x4){0.f, 0.f, 0.f, 0.f};
        cur = nxt; cA = nA; cB = nB; ++ui;
        if constexpr (ALIGN_EPI) { if (wr == 1) PG8_BAR; }
    }
    PG8_WAIT_V(0);
    if constexpr (!ALIGN_EPI) { if (wr == 0) PG8_BAR; }
    PG8_BAR;
#undef PG8_SA
#undef PG8_SB
#undef PG8_STAGE
#undef PG8_LDA
#undef PG8_LDB
#undef PG8_MMA
#undef PG8_WAIT_V
#undef PG8_WAIT_L
#undef PG8_BAR
#undef PG8_SCHED
}
}

__device__ __forceinline__ void transpose_cvt(const float* __restrict__ W, bf16_t* __restrict__ Wt, int K, int N, float* sm, const float* __restrict__ gain, int tstart, int tstride) {
    int tid = threadIdx.x; asm volatile("" : "+v"(tid));
    const int tn = N >> 8, ntile = tn * (K >> 6);
    for (int tile = tstart; tile < ntile; tile += tstride) {
        const int k0 = (tile / tn) << 6, n0 = (tile % tn) << 8;
        f32x4 v[8];
#pragma unroll
        for (int i = 0; i < 8; ++i) { const int idx = tid + i * 512; const int rest = idx >> 6; const int r = ((rest >> 3) << 3) + (idx & 7), c4 = ((rest & 7) << 3) + ((idx >> 3) & 7);
            v[i] = __builtin_nontemporal_load((const f32x4*)(W + (size_t)(k0 + r) * N + n0 + c4 * 4)); if (gain) v[i] = v[i] * gain[k0 + r]; }
#pragma unroll
        for (int i = 0; i < 8; ++i) { const int idx = tid + i * 512; const int rest = idx >> 6; const int r = ((rest >> 3) << 3) + (idx & 7), c4 = ((rest & 7) << 3) + ((idx >> 3) & 7);
            float* d = sm + r * 257 + c4 * 4; d[0] = v[i][0]; d[1] = v[i][1]; d[2] = v[i][2]; d[3] = v[i][3]; }
        __syncthreads();
        const int ks = tid & 7;
#pragma unroll
        for (int i = 0; i < 4; ++i) { const int n = (tid >> 3) + 64 * i; float f[8];
#pragma unroll
            for (int j = 0; j < 8; ++j) f[j] = sm[(ks * 8 + j) * 257 + n];
            u32x4 w; w.x = cvt_pk_bf16(f[0], f[1]); w.y = cvt_pk_bf16(f[2], f[3]); w.z = cvt_pk_bf16(f[4], f[5]); w.w = cvt_pk_bf16(f[6], f[7]);
            *(u32x4*)(Wt + (size_t)(n0 + n) * K + k0 + ks * 8) = w; }
        __syncthreads();
    }
}

__device__ __forceinline__ void s5_params(const float* lam_re, const float* lam_im, const float* log_dt, const float* b_re, const float* b_im, float* S5A, float* S5B) {
    int tid = threadIdx.x; asm volatile("" : "+v"(tid));
    for (int idx = blockIdx.x * 512 + tid; idx < 8192; idx += gridDim.x * 512) {
        const float lr = fminf(lam_re[idx], -1e-4f), li = lam_im[idx], dt = expf(log_dt[idx >> 6]);
        const float mag = expf(lr * dt), th = li * dt;
        const float ar = mag * cosf(th), ai = mag * sinf(th);
        const float den = lr * lr + li * li;
        const float zr = ((ar - 1.0f) * lr + ai * li) / den, zi = (ai * lr - (ar - 1.0f) * li) / den;
        S5A[idx * 2] = ar; S5A[idx * 2 + 1] = ai;
#pragma unroll
        for (int c = 0; c < 16; ++c) { const float br = b_re[(size_t)idx * 16 + c], bi = b_im[(size_t)idx * 16 + c];
            S5B[(size_t)idx * 32 + c] = zr * br - zi * bi; S5B[(size_t)idx * 32 + 16 + c] = zr * bi + zi * br; }
    }
}

__device__ __forceinline__ void x_stats_phase(const float* __restrict__ h, bf16_t* __restrict__ hb, float* __restrict__ rs) {
    int tid = threadIdx.x; asm volatile("" : "+v"(tid));
    const int lane = tid & 63, wave = tid >> 6;
    for (int row = blockIdx.x * 8 + wave; row < T; row += gridDim.x * 8) {
        const float* p = h + (size_t)row * 2048 + lane * 8;
        f32x4 v[8]; float ss = 0.f;
#pragma unroll
        for (int i = 0; i < 4; ++i) { v[2 * i] = *(const f32x4*)(p + i * 512); v[2 * i + 1] = *(const f32x4*)(p + i * 512 + 4); }
#pragma unroll
        for (int i = 0; i < 8; ++i) ss += v[i][0] * v[i][0] + v[i][1] * v[i][1] + v[i][2] * v[i][2] + v[i][3] * v[i][3];
        ss = wave_sum(ss);
        if (lane < 32) rs[(size_t)row * 32 + lane] = lane == 0 ? ss : 0.f;
#pragma unroll
        for (int i = 0; i < 4; ++i) { u32x4 w; w.x = cvt_pk_bf16(v[2 * i][0], v[2 * i][1]); w.y = cvt_pk_bf16(v[2 * i][2], v[2 * i][3]); w.z = cvt_pk_bf16(v[2 * i + 1][0], v[2 * i + 1][1]); w.w = cvt_pk_bf16(v[2 * i + 1][2], v[2 * i + 1][3]);
            *(u32x4*)(hb + (size_t)row * 2048 + i * 512 + lane * 8) = w; }
    }
}

__device__ __forceinline__ float hgrn_lb(const float* lbp, int j, int ch) { return j == 0 ? 0.f : sigmoidf_(lbp[1024 + ch] - lbp[ch]); }

__device__ __forceinline__ void hgrn_cumsum(float* base, int st_t, int st_k, int tid) {
    const int k = tid & 127, qd = tid >> 7;
    float* p = base + k * st_k + (16 * qd) * st_t;
    float run = 0.f;
#pragma unroll
    for (int t = 0; t < 16; ++t) { run += p[t * st_t]; p[t * st_t] = run; }
    __syncthreads();
    float off = 0.f;
#pragma unroll
    for (int q = 0; q < 3; ++q) if (q < qd) off += base[k * st_k + (16 * q + 15) * st_t];
    __syncthreads();
    if (qd > 0) {
#pragma unroll
        for (int t = 0; t < 16; ++t) p[t * st_t] += off; }
    __syncthreads();
}

__device__ __forceinline__ void hgrn_p1(int item, const bf16_t* __restrict__ proj, const float* __restrict__ lbp, int j, bf16_t* __restrict__ HST, float* __restrict__ HDEC, unsigned char* smb) {
    int tid = threadIdx.x; asm volatile("" : "+v"(tid));
    const int wave = tid >> 6, lane = tid & 63, fr = lane & 15, fq = lane >> 4;
    const int c = item & 63, h = (item >> 6) & 7, b = item >> 9;
    const size_t tok0 = (size_t)b * SEQ + c * 64;
    float* BT = (float*)smb; float* KT = BT + 8704;
    unsigned char* KH = smb + 2 * 34816; unsigned char* Vt = KH + 18432;
    {
        const int t = lane;
#pragma unroll
        for (int i = 0; i < 2; ++i) { const int kg = wave + 8 * i;
            const bf16_t* rowp = proj + (tok0 + t) * 5120 + h * 128 + kg * 8;
            const u32x4 fw = *(const u32x4*)(rowp + 2048), vw = *(const u32x4*)(rowp + 3072);
            float f[8]; unpack8(fw, f);
#pragma unroll
            for (int jj = 0; jj < 8; ++jj) { const int k = kg * 8 + jj; const float lb = hgrn_lb(lbp, j, h * 128 + k); const float fg = lb + (1.0f - lb) * sigmoidf_(f[jj]);
                BT[k * 65 + t] = __log2f(fg); KT[k * 65 + t] = 1.0f - fg; }
            unsigned short* vcol = (unsigned short*)(Vt + (kg * 8) * 144 + t * 2);
            vcol[0 * 72] = (unsigned short)(vw.x & 0xffffu); vcol[1 * 72] = (unsigned short)(vw.x >> 16); vcol[2 * 72] = (unsigned short)(vw.y & 0xffffu); vcol[3 * 72] = (unsigned short)(vw.y >> 16);
            vcol[4 * 72] = (unsigned short)(vw.z & 0xffffu); vcol[5 * 72] = (unsigned short)(vw.z >> 16); vcol[6 * 72] = (unsigned short)(vw.w & 0xffffu); vcol[7 * 72] = (unsigned short)(vw.w >> 16); }
    }
    __syncthreads();
    hgrn_cumsum(BT, 1, 65, tid);
#pragma unroll
    for (int i = 0; i < 16; ++i) { const int e = tid + i * 512; const int k = e >> 6, s = e & 63;
        *(unsigned short*)(KH + k * 144 + s * 2) = f2bf(KT[k * 65 + s] * ex2(BT[k * 65 + 63] - BT[k * 65 + s])); }
    if (tid < 128) HDEC[(size_t)item * 128 + tid] = ex2(BT[tid * 65 + 63]);
    __syncthreads();
    {
        bf16x8 bfr[2];
#pragma unroll
        for (int ks = 0; ks < 2; ++ks) bfr[ks] = *(const bf16x8*)(KH + (16 * wave + fr) * 144 + ks * 64 + fq * 16);
        bf16_t* dst = HST + (size_t)item * 16384 + fr * 128 + 16 * wave + 4 * fq;
#pragma unroll
        for (int mt = 0; mt < 8; ++mt) { f32x4 acc = (f32x4){0.f, 0.f, 0.f, 0.f};
#pragma unroll
            for (int ks = 0; ks < 2; ++ks) { const bf16x8 af = *(const bf16x8*)(Vt + (16 * mt + fr) * 144 + ks * 64 + fq * 16); acc = __builtin_amdgcn_mfma_f32_16x16x32_bf16(bfr[ks], af, acc, 0, 0, 0); }
            { u32x2 w2; w2.x = (unsigned)f2bf(acc[0]) | ((unsigned)f2bf(acc[1]) << 16); w2.y = (unsigned)f2bf(acc[2]) | ((unsigned)f2bf(acc[3]) << 16);
              *(u32x2*)(dst + (size_t)(16 * mt) * 128) = w2; } }
    }
    __syncthreads();
}

__device__ __forceinline__ void hgrn_p2(bf16_t* __restrict__ HST, const float* __restrict__ HDEC) {
    int tid = threadIdx.x; asm volatile("" : "+v"(tid));
    for (int gid = blockIdx.x * 512 + tid; gid < 131072; gid += gridDim.x * 512) {
        const int bh = gid >> 13, off = (gid & 8191) * 2, k = off & 127;
        f32x2 st = (f32x2){0.f, 0.f};
        bf16_t* hp = HST + (size_t)bh * 64 * 16384 + off; const float* dp = HDEC + (size_t)bh * 64 * 128 + k;
#pragma unroll 1
        for (int c0 = 0; c0 < 64; c0 += 16) {
            f32x2 d[16]; unsigned kv[16];
#pragma unroll
            for (int u = 0; u < 16; ++u) { d[u] = *(const f32x2*)(dp + (size_t)(c0 + u) * 128); kv[u] = *(const unsigned*)(hp + (size_t)(c0 + u) * 16384); }
#pragma unroll
            for (int u = 0; u < 16; ++u) { st = st * d[u] + (f32x2){bflo(kv[u]), bfhi(kv[u])}; kv[u] = cvt_pk_bf16(st[0], st[1]); }
#pragma unroll
            for (int u = 0; u < 16; ++u) *(unsigned*)(hp + (size_t)(c0 + u) * 16384) = kv[u];
        }
    }
}

__device__ __forceinline__ void hgrn_p3(int item, const bf16_t* __restrict__ proj, const float* __restrict__ lbp, int j, const bf16_t* __restrict__ HST, const float* __restrict__ ogain, bf16_t* __restrict__ ycat, unsigned char* smb) {
    int tid = threadIdx.x; asm volatile("" : "+v"(tid));
    const int wave = tid >> 6, lane = tid & 63, fr = lane & 15, fq = lane >> 4;
    const int c = item & 63, h = (item >> 6) & 7, b = item >> 9;
    const size_t tok0 = (size_t)b * SEQ + c * 64;
    float* FB = (float*)smb; float* FQ = FB + 8704; float* FK = FQ + 8704;
    unsigned char* SC = smb + 3 * 34816; unsigned char* Vt = SC + 9216; float* RED = (float*)(Vt + 18432);
    unsigned char* Pt = (unsigned char*)FK; unsigned char* QEb = (unsigned char*)FB;
    u32x4 pre[4];
#pragma unroll
    for (int i = 0; i < 4; ++i) pre[i] = (u32x4){0u, 0u, 0u, 0u};
    u32x2 graw[4];
#pragma unroll
    for (int mt = 0; mt < 4; ++mt) graw[mt] = *(const u32x2*)(proj + (tok0 + 16 * mt + fr) * 5120 + 4096 + h * 128 + 16 * wave + 4 * fq);
    if (c > 0) { const bf16_t* P = HST + (size_t)(item - 1) * 16384;
#pragma unroll
        for (int i = 0; i < 4; ++i) pre[i] = *(const u32x4*)(P + (size_t)(tid + i * 512) * 8); }
    for (int ra = 0; ra < ((H3REP & 1) ? 3 : 1); ++ra) {
    {
        const int kg = tid & 15;
#pragma unroll
        for (int i = 0; i < 2; ++i) { const int t = (tid + i * 512) >> 4;
            const bf16_t* rowp = proj + (tok0 + t) * 5120 + h * 128 + kg * 8;
            const u32x4 qw = *(const u32x4*)(rowp + 1024), fw = *(const u32x4*)(rowp + 2048), vw = *(const u32x4*)(rowp + 3072);
            float q[8], f[8]; unpack8(qw, q); unpack8(fw, f);
            float lg[8], kk[8], qs[8];
#pragma unroll
            for (int jj = 0; jj < 8; ++jj) { const float lb = hgrn_lb(lbp, j, h * 128 + kg * 8 + jj); const float fg = lb + (1.0f - lb) * sigmoidf_(f[jj]);
                lg[jj] = __log2f(fg); kk[jj] = 1.0f - fg; qs[jj] = q[jj] * sigmoidf_(q[jj]); }
            *(f32x4*)(FB + t * 132 + kg * 8) = (f32x4){lg[0], lg[1], lg[2], lg[3]}; *(f32x4*)(FB + t * 132 + kg * 8 + 4) = (f32x4){lg[4], lg[5], lg[6], lg[7]};
            *(f32x4*)(FQ + t * 132 + kg * 8) = (f32x4){qs[0], qs[1], qs[2], qs[3]}; *(f32x4*)(FQ + t * 132 + kg * 8 + 4) = (f32x4){qs[4], qs[5], qs[6], qs[7]};
            *(f32x4*)(FK + t * 132 + kg * 8) = (f32x4){kk[0], kk[1], kk[2], kk[3]}; *(f32x4*)(FK + t * 132 + kg * 8 + 4) = (f32x4){kk[4], kk[5], kk[6], kk[7]};
            unsigned short* vcol = (unsigned short*)(Vt + (kg * 8) * 144 + t * 2);
            vcol[0 * 72] = (unsigned short)(vw.x & 0xffffu); vcol[1 * 72] = (unsigned short)(vw.x >> 16); vcol[2 * 72] = (unsigned short)(vw.y & 0xffffu); vcol[3 * 72] = (unsigned short)(vw.y >> 16);
            vcol[4 * 72] = (unsigned short)(vw.z & 0xffffu); vcol[5 * 72] = (unsigned short)(vw.z >> 16); vcol[6 * 72] = (unsigned short)(vw.w & 0xffffu); vcol[7 * 72] = (unsigned short)(vw.w >> 16); }
    }
    __syncthreads();
    hgrn_cumsum(FB, 132, 1, tid);
    }
    for (int rb = 0; rb < ((H3REP & 2) ? 3 : 1); ++rb) {
    if (wave < 6) {
        const int I = wave < 1 ? 1 : wave < 3 ? 2 : 3, J = wave < 1 ? 0 : wave < 3 ? wave - 1 : wave - 3;
        const float* bt = FB + (16 * I + fr) * 132, *qt = FQ + (16 * I + fr) * 132, *be = FB + (16 * J + 15) * 132, *bs = FB + (16 * J + fr) * 132, *ks_ = FK + (16 * J + fr) * 132;
        f32x4 acc = (f32x4){0.f, 0.f, 0.f, 0.f};
#pragma unroll
        for (int ks = 0; ks < 4; ++ks) { const int k0 = ks * 32 + fq * 8; float av[8], bv[8];
#pragma unroll
            for (int hh = 0; hh < 2; ++hh) { const f32x4 b4 = *(const f32x4*)(bt + k0 + 4 * hh), q4 = *(const f32x4*)(qt + k0 + 4 * hh), e4 = *(const f32x4*)(be + k0 + 4 * hh), s4 = *(const f32x4*)(bs + k0 + 4 * hh), k4 = *(const f32x4*)(ks_ + k0 + 4 * hh);
#pragma unroll
                for (int e = 0; e < 4; ++e) { av[4 * hh + e] = q4[e] * ex2(b4[e] - e4[e]); bv[4 * hh + e] = k4[e] * ex2(e4[e] - s4[e]); } }
            u32x4 aw, bw; aw.x = cvt_pk_bf16(av[0], av[1]); aw.y = cvt_pk_bf16(av[2], av[3]); aw.z = cvt_pk_bf16(av[4], av[5]); aw.w = cvt_pk_bf16(av[6], av[7]);
            bw.x = cvt_pk_bf16(bv[0], bv[1]); bw.y = cvt_pk_bf16(bv[2], bv[3]); bw.z = cvt_pk_bf16(bv[4], bv[5]); bw.w = cvt_pk_bf16(bv[6], bv[7]);
            acc = __builtin_amdgcn_mfma_f32_16x16x32_bf16(__builtin_bit_cast(bf16x8, aw), __builtin_bit_cast(bf16x8, bw), acc, 0, 0, 0); }
#pragma unroll
        for (int e = 0; e < 4; ++e) *(unsigned short*)(SC + (16 * I + 4 * fq + e) * 144 + (16 * J + fr) * 2) = f2bf(acc[e]);
    } else {
#pragma unroll
        for (int u = 0; u < 3; ++u) { const int id = (wave - 6) * 3 + u; const int I = id < 3 ? 0 : id < 5 ? 1 : 2, J = id < 3 ? id + 1 : id < 5 ? id - 1 : 3;
#pragma unroll
            for (int e = 0; e < 4; ++e) *(unsigned short*)(SC + (16 * I + 4 * fq + e) * 144 + (16 * J + fr) * 2) = (unsigned short)0; }
    }
    {
        const int I = lane >> 4, ks16 = lane & 15;
#pragma unroll
        for (int half = 0; half < 2; ++half) { const int tl = half == 0 ? wave : 15 - wave; const int t = 16 * I + tl;
            const float* qrow = FQ + t * 132 + 8 * ks16;
            const f32x4 q0v = *(const f32x4*)qrow, q1v = *(const f32x4*)(qrow + 4);
            float part[16]; f32x4 w0 = (f32x4){1.f, 1.f, 1.f, 1.f}, w1 = w0;
#pragma unroll
            for (int sl = 15; sl >= 0; --sl) { part[sl] = 0.f;
                if (sl <= tl) { const float* krow = FK + (16 * I + sl) * 132 + 8 * ks16;
                    const f32x4 k0 = *(const f32x4*)krow, k1 = *(const f32x4*)(krow + 4);
                    float av = 0.f;
#pragma unroll
                    for (int e = 0; e < 4; ++e) { av += q0v[e] * k0[e] * w0[e]; av += q1v[e] * k1[e] * w1[e]; w0[e] *= 1.0f - k0[e]; w1[e] *= 1.0f - k1[e]; }
                    part[sl] = av; } }
#pragma unroll
            for (int i = 0; i < 8; ++i) { const bool hi = (ks16 & 8) != 0; const float send = hi ? part[i] : part[i + 8], keep = hi ? part[i + 8] : part[i]; part[i] = keep + __shfl_xor(send, 8); }
#pragma unroll
            for (int i = 0; i < 4; ++i) { const bool hi = (ks16 & 4) != 0; const float send = hi ? part[i] : part[i + 4], keep = hi ? part[i + 4] : part[i]; part[i] = keep + __shfl_xor(send, 4); }
#pragma unroll
            for (int i = 0; i < 2; ++i) { const bool hi = (ks16 & 2) != 0; const float send = hi ? part[i] : part[i + 2], keep = hi ? part[i + 2] : part[i]; part[i] = keep + __shfl_xor(send, 2); }
            { const bool hi = (ks16 & 1) != 0; const float send = hi ? part[0] : part[1], keep = hi ? part[1] : part[0]; part[0] = keep + __shfl_xor(send, 1); }
            *(unsigned short*)(SC + t * 144 + (16 * I + ks16) * 2) = f2bf(part[0]); }
    }
    __syncthreads();
    }
    for (int rc = 0; rc < ((H3REP & 4) ? 3 : 1); ++rc) {
    u32x4 qe[2];
    { const int kg = tid & 15;
#pragma unroll
      for (int i = 0; i < 2; ++i) { const int t = (tid + i * 512) >> 4; const float* bp = FB + t * 132 + kg * 8, *qp = FQ + t * 132 + kg * 8;
          const f32x4 b0 = *(const f32x4*)bp, b1 = *(const f32x4*)(bp + 4), q0 = *(const f32x4*)qp, q1 = *(const f32x4*)(qp + 4);
          qe[i].x = cvt_pk_bf16(q0[0] * ex2(b0[0]), q0[1] * ex2(b0[1])); qe[i].y = cvt_pk_bf16(q0[2] * ex2(b0[2]), q0[3] * ex2(b0[3]));
          qe[i].z = cvt_pk_bf16(q1[0] * ex2(b1[0]), q1[1] * ex2(b1[1])); qe[i].w = cvt_pk_bf16(q1[2] * ex2(b1[2]), q1[3] * ex2(b1[3])); } }
    __syncthreads();
#pragma unroll
    for (int i = 0; i < 4; ++i) { const int idx = tid + i * 512; const int v = idx >> 4, k8 = idx & 15; *(u32x4*)(Pt + v * 272 + k8 * 16) = pre[i]; }
    { const int kg = tid & 15;
#pragma unroll
      for (int i = 0; i < 2; ++i) { const int t = (tid + i * 512) >> 4; *(u32x4*)(QEb + t * 272 + kg * 16) = qe[i]; } }
    __syncthreads();
    f32x4 o[4];
    {
        bf16x8 bv[2], bp[4];
#pragma unroll
        for (int ks = 0; ks < 2; ++ks) bv[ks] = *(const bf16x8*)(Vt + (16 * wave + fr) * 144 + ks * 64 + fq * 16);
#pragma unroll
        for (int ks = 0; ks < 4; ++ks) bp[ks] = *(const bf16x8*)(Pt + (16 * wave + fr) * 272 + ks * 64 + fq * 16);
#pragma unroll
        for (int mt = 0; mt < 4; ++mt) { f32x4 acc = (f32x4){0.f, 0.f, 0.f, 0.f};
#pragma unroll
            for (int ks = 0; ks < 2; ++ks) { const bf16x8 af = *(const bf16x8*)(SC + (16 * mt + fr) * 144 + ks * 64 + fq * 16); acc = __builtin_amdgcn_mfma_f32_16x16x32_bf16(bv[ks], af, acc, 0, 0, 0); }
#pragma unroll
            for (int ks = 0; ks < 4; ++ks) { const bf16x8 af = *(const bf16x8*)(QEb + (16 * mt + fr) * 272 + ks * 64 + fq * 16); acc = __builtin_amdgcn_mfma_f32_16x16x32_bf16(bp[ks], af, acc, 0, 0, 0); }
            o[mt] = acc;
            float ssq = acc[0] * acc[0] + acc[1] * acc[1] + acc[2] * acc[2] + acc[3] * acc[3]; ssq += __shfl_xor(ssq, 16); ssq += __shfl_xor(ssq, 32);
            if (fq == 0) RED[wave * 64 + 16 * mt + fr] = ssq; }
    }
    __syncthreads();
    {
        const int v0 = 16 * wave + 4 * fq; const f32x4 gn = *(const f32x4*)(ogain + v0);
#pragma unroll
        for (int mt = 0; mt < 4; ++mt) { const int t = 16 * mt + fr; float tot = 0.f;
#pragma unroll
            for (int w = 0; w < 8; ++w) tot += RED[w * 64 + t];
            const float r = rsqrtf(tot * (1.0f / 128.0f) + 1e-6f);
            const size_t tok = tok0 + t;
            const float g0 = bflo(graw[mt].x), g1 = bfhi(graw[mt].x), g2 = bflo(graw[mt].y), g3 = bfhi(graw[mt].y);
            u32x2 w2; w2.x = cvt_pk_bf16(o[mt][0] * r * gn[0] * g0 * sigmoidf_(g0), o[mt][1] * r * gn[1] * g1 * sigmoidf_(g1));
            w2.y = cvt_pk_bf16(o[mt][2] * r * gn[2] * g2 * sigmoidf_(g2), o[mt][3] * r * gn[3] * g3 * sigmoidf_(g3));
            *(u32x2*)(ycat + tok * 2048 + 1024 + h * 128 + v0) = w2; }
    }
    __syncthreads();
    }
    __syncthreads();
}

__device__ __forceinline__ float gelu_tanh(float y) { const float z = 0.7978845608028654f * (y + 0.044715f * y * y * y); const float e = __expf(2.0f * z); return y * (1.0f - __builtin_amdgcn_rcpf(1.0f + e)); }
__device__ __forceinline__ bf16x8 pack8(const f32x4 a, const f32x4 b, float sgn) {
    u32x4 w; w.x = cvt_pk_bf16(a[0] * sgn, a[1] * sgn); w.y = cvt_pk_bf16(a[2] * sgn, a[3] * sgn); w.z = cvt_pk_bf16(b[0] * sgn, b[1] * sgn); w.w = cvt_pk_bf16(b[2] * sgn, b[3] * sgn); return __builtin_bit_cast(bf16x8, w);
}
template <bool FINAL>
__device__ __forceinline__ void s5_pass(int item, const bf16_t* __restrict__ proj, const float* __restrict__ S5A, const float* __restrict__ S5B, float* __restrict__ S5F,
                                        const float* __restrict__ c_re, const float* __restrict__ c_im, const float* __restrict__ dsk, bf16_t* __restrict__ ys5, unsigned char* smb) {
    int tid = threadIdx.x; asm volatile("" : "+v"(tid));
    const int wave = tid >> 6, lane = tid & 63, fr = lane & 15, fq = lane >> 4;
    const int sg = item & 7, g = (item >> 3) & 63, b = item >> 9;
    const int seg = sg * 8 + wave; const size_t tok0 = (size_t)b * SEQ + seg * 64;
    float* Bu = (float*)(smb + wave * 12800);
    unsigned char* X = smb + wave * 12800 + 8448;
    const bf16x8 zero8 = __builtin_bit_cast(bf16x8, (u32x4){0u, 0u, 0u, 0u});
    bf16x8 af[8], uf[4];
#pragma unroll
    for (int mt = 0; mt < 8; ++mt) { af[mt] = zero8;
        if (fq < 2) { const int pp = 16 * mt + fr; const float* src = S5B + (size_t)(g * 64 + (pp & 63)) * 32 + (pp >> 6) * 16 + fq * 8; af[mt] = pack8(*(const f32x4*)src, *(const f32x4*)(src + 4), 1.0f); } }
#pragma unroll
    for (int blk = 0; blk < 4; ++blk) { uf[blk] = zero8;
        if (fq < 2) uf[blk] = *(const bf16x8*)(proj + (tok0 + 16 * blk + fr) * 5120 + g * 16 + fq * 8); }
    const float ar = S5A[(g * 64 + lane) * 2], ai = S5A[(g * 64 + lane) * 2 + 1];
    float xr = 0.f, xi = 0.f;
    bf16x8 cf[4]; float dv = 0.f; unsigned short uraw[16];
    if (FINAL) {
#pragma unroll
        for (int q = 0; q < 16; ++q) uraw[q] = proj[(tok0 + 16 * (q >> 2) + 4 * fq + (q & 3)) * 5120 + g * 16 + fr];
        const f32x2 cin = *(const f32x2*)(S5F + ((size_t)((b * 64 + g) * 64 + seg) * 64 + lane) * 2); xr = cin[0]; xi = cin[1];
#pragma unroll
        for (int ks = 0; ks < 4; ++ks) { const float* src = (ks < 2 ? c_re : c_im) + (size_t)g * 1024 + fr * 64 + ((ks & 1) * 32 + fq * 8); cf[ks] = pack8(*(const f32x4*)src, *(const f32x4*)(src + 4), ks < 2 ? 1.0f : -1.0f); }
        dv = dsk[g * 16 + fr];
    }
#pragma unroll
    for (int blk = 0; blk < 4; ++blk) {
#pragma unroll
        for (int mt = 0; mt < 8; ++mt) { const f32x4 acc = __builtin_amdgcn_mfma_f32_16x16x32_bf16(af[mt], uf[blk], (f32x4){0.f, 0.f, 0.f, 0.f}, 0, 0, 0); *(f32x4*)(Bu + fr * 132 + 16 * mt + 4 * fq) = acc; }
        __syncthreads();
#pragma unroll
        for (int t = 0; t < 16; ++t) { const float bur = Bu[t * 132 + lane], bui = Bu[t * 132 + 64 + lane];
            const float nxr = ar * xr - ai * xi + bur, nxi = ar * xi + ai * xr + bui; xr = nxr; xi = nxi;
            if (FINAL) { *(unsigned short*)(X + t * 272 + lane * 2) = f2bf(xr); *(unsigned short*)(X + t * 272 + 128 + lane * 2) = f2bf(xi); } }
        __syncthreads();
        if (FINAL) {
            f32x4 acc = (f32x4){0.f, 0.f, 0.f, 0.f};
#pragma unroll
            for (int ks = 0; ks < 4; ++ks) { const bf16x8 a = *(const bf16x8*)(X + fr * 272 + ks * 64 + fq * 16); acc = __builtin_amdgcn_mfma_f32_16x16x32_bf16(a, cf[ks], acc, 0, 0, 0); }
#pragma unroll
            for (int e = 0; e < 4; ++e) { const size_t tok = tok0 + 16 * blk + 4 * fq + e; const float u = bflo((unsigned)uraw[blk * 4 + e]);
                ys5[tok * 1024 + g * 16 + fr] = f2bf(gelu_tanh(acc[e] + dv * u)); }
        }
    }
    if (!FINAL) *(f32x2*)(S5F + ((size_t)((b * 64 + g) * 64 + seg) * 64 + lane) * 2) = (f32x2){xr, xi};
    __syncthreads();
}

#define WAVE_LDS_SYNC() do { asm volatile("s_waitcnt lgkmcnt(0)" ::: "memory"); __builtin_amdgcn_s_barrier(); asm volatile("" ::: "memory"); } while (0)
template <bool FINAL>
__device__ __forceinline__ void s5_wg(int bid, const bf16_t* __restrict__ proj, const float* __restrict__ S5A, const float* __restrict__ S5B, float* __restrict__ S5F,
                                      const float* __restrict__ c_re, const float* __restrict__ c_im, const float* __restrict__ dsk, bf16_t* __restrict__ ys5, unsigned char* smb) {
    int tid = threadIdx.x; asm volatile("" : "+v"(tid));
    const int wave = tid >> 6, lane = tid & 63, fr = lane & 15, fq = lane >> 4;
    const int g = bid >> 2, r0 = (bid & 3) * 4;
    float* Bu = (float*)(smb + wave * 12800);
    unsigned char* X = smb + wave * 12800 + 8448;
    const bf16x8 zero8 = __builtin_bit_cast(bf16x8, (u32x4){0u, 0u, 0u, 0u});
    bf16x8 af[8];
#pragma unroll
    for (int mt = 0; mt < 8; ++mt) { af[mt] = zero8;
        if (fq < 2) { const int pp = 16 * mt + fr; const float* src = S5B + (size_t)(g * 64 + (pp & 63)) * 32 + (pp >> 6) * 16 + fq * 8; af[mt] = pack8(*(const f32x4*)src, *(const f32x4*)(src + 4), 1.0f); } }
    const float ar = S5A[(g * 64 + lane) * 2], ai = S5A[(g * 64 + lane) * 2 + 1];
    bf16x8 cf[4]; f32x4 dv4 = (f32x4){0.f, 0.f, 0.f, 0.f};
    if (FINAL) {
#pragma unroll
        for (int ks = 0; ks < 4; ++ks) { const float* src = (ks < 2 ? c_re : c_im) + (size_t)g * 1024 + fr * 64 + ((ks & 1) * 32 + fq * 8); cf[ks] = pack8(*(const f32x4*)src, *(const f32x4*)(src + 4), ks < 2 ? 1.0f : -1.0f); }
        dv4 = *(const f32x4*)(dsk + g * 16 + 4 * fq);
    }
    bf16x8 ufb[2][4]; u32x2 urb[2][4]; f32x2 cinb[2];
#define S5_FETCH(k_, slot_) do { const int r_ = r0 + (k_); const int b_ = r_ >> 3, seg_ = (r_ & 7) * 8 + wave; const size_t tk_ = (size_t)b_ * SEQ + seg_ * 64; \
        _Pragma("unroll") for (int blk_ = 0; blk_ < 4; ++blk_) { ufb[slot_][blk_] = zero8; if (fq < 2) ufb[slot_][blk_] = *(const bf16x8*)(proj + (tk_ + 16 * blk_ + fr) * 5120 + g * 16 + fq * 8); } \
        if (FINAL) { _Pragma("unroll") for (int q_ = 0; q_ < 4; ++q_) urb[slot_][q_] = *(const u32x2*)(proj + (tk_ + 16 * q_ + fr) * 5120 + g * 16 + 4 * fq); \
            cinb[slot_] = *(const f32x2*)(S5F + ((size_t)((b_ * 64 + g) * 64 + seg_) * 64 + lane) * 2); } } while (0)
    S5_FETCH(0, 0);
#pragma unroll
    for (int k = 0; k < 4; ++k) {
        const int cur = k & 1;
        if (k < 3) S5_FETCH(k + 1, cur ^ 1);
        const int r = r0 + k; const int b = r >> 3, seg = (r & 7) * 8 + wave; const size_t tok0 = (size_t)b * SEQ + seg * 64;
        float xr = 0.f, xi = 0.f;
        if (FINAL) { xr = cinb[cur][0]; xi = cinb[cur][1]; }
#pragma unroll
        for (int blk = 0; blk < 4; ++blk) {
#pragma unroll
            for (int mt = 0; mt < 8; ++mt) { const f32x4 acc = __builtin_amdgcn_mfma_f32_16x16x32_bf16(af[mt], ufb[cur][blk], (f32x4){0.f, 0.f, 0.f, 0.f}, 0, 0, 0); *(f32x4*)(Bu + fr * 132 + 16 * mt + 4 * fq) = acc; }
            WAVE_LDS_SYNC();
#pragma unroll
            for (int t = 0; t < 16; ++t) { const float bur = Bu[t * 132 + lane], bui = Bu[t * 132 + 64 + lane];
                const float nxr = ar * xr - ai * xi + bur, nxi = ar * xi + ai * xr + bui; xr = nxr; xi = nxi;
                if (FINAL) { *(unsigned short*)(X + t * 272 + lane * 2) = f2bf(xr); *(unsigned short*)(X + t * 272 + 128 + lane * 2) = f2bf(xi); } }
            WAVE_LDS_SYNC();
            if (FINAL) {
                f32x4 acc = (f32x4){0.f, 0.f, 0.f, 0.f};
#pragma unroll
                for (int ks = 0; ks < 4; ++ks) { const bf16x8 a = *(const bf16x8*)(X + fr * 272 + ks * 64 + fq * 16); acc = __builtin_amdgcn_mfma_f32_16x16x32_bf16(cf[ks], a, acc, 0, 0, 0); }
                { const size_t tok = tok0 + 16 * blk + fr; const u32x2 uw = urb[cur][blk];
                  u32x2 w2; w2.x = cvt_pk_bf16(gelu_tanh(acc[0] + dv4[0] * bflo(uw.x)), gelu_tanh(acc[1] + dv4[1] * bfhi(uw.x)));
                  w2.y = cvt_pk_bf16(gelu_tanh(acc[2] + dv4[2] * bflo(uw.y)), gelu_tanh(acc[3] + dv4[3] * bfhi(uw.y)));
                  *(u32x2*)(ys5 + tok * 1024 + g * 16 + 4 * fq) = w2; }
                WAVE_LDS_SYNC();
            }
        }
        if (!FINAL) *(f32x2*)(S5F + ((size_t)((b * 64 + g) * 64 + seg) * 64 + lane) * 2) = (f32x2){xr, xi};
    }
#undef S5_FETCH
    __syncthreads();
}

__device__ __forceinline__ void s5_carry(float* __restrict__ S5F, const float* __restrict__ S5A) {
    int tid = threadIdx.x; asm volatile("" : "+v"(tid));
    for (int gid = blockIdx.x * 512 + tid; gid < 8192; gid += gridDim.x * 512) {
        const int p = gid & 63, bg = gid >> 6, g = bg & 63;
        float pr = S5A[(g * 64 + p) * 2], pi = S5A[(g * 64 + p) * 2 + 1];
#pragma unroll
        for (int q = 0; q < 6; ++q) { const float nr = pr * pr - pi * pi, ni = 2.0f * pr * pi; pr = nr; pi = ni; }
        float xr = 0.f, xi = 0.f;
        f32x2* F = (f32x2*)(S5F + ((size_t)bg * 64 * 64 + p) * 2);
#pragma unroll 1
        for (int s0 = 0; s0 < 64; s0 += 16) { f32x2 f[16];
#pragma unroll
            for (int u = 0; u < 16; ++u) f[u] = F[(size_t)(s0 + u) * 64];
#pragma unroll
            for (int u = 0; u < 16; ++u) { const f32x2 fin = f[u]; f[u] = (f32x2){xr, xi}; const float nr = pr * xr - pi * xi + fin[0], ni = pr * xi + pi * xr + fin[1]; xr = nr; xi = ni; }
#pragma unroll
            for (int u = 0; u < 16; ++u) F[(size_t)(s0 + u) * 64] = f[u];
        }
    }
}

__device__ __forceinline__ void attn_item(int item, const bf16_t* __restrict__ qkv, const float* __restrict__ qg, const float* __restrict__ kg, const float* __restrict__ sinks, bf16_t* __restrict__ ycat, unsigned char* smb) {
    int tid = threadIdx.x; asm volatile("" : "+v"(tid));
    const int wave = tid >> 6, lane = tid & 63, fr = lane & 15, fq = lane >> 4;
    const int qb = item & 63, kvh = (item >> 6) & 3, b = item >> 8;
    const int q0 = qb * 64; const size_t tokb = (size_t)b * SEQ;
    unsigned char* Ks = smb;
    unsigned char* Vt = smb + 192 * 144;
    const int hq = kvh * 8 + wave;
    u32x4 qraw[4][2];
#pragma unroll
    for (int i = 0; i < 4; ++i) { const bf16_t* qp = qkv + (tokb + q0 + 16 * i + fr) * 2560 + hq * 64 + fq * 8; qraw[i][0] = *(const u32x4*)qp; qraw[i][1] = *(const u32x4*)(qp + 32); }
#pragma unroll
    for (int i = 0; i < 3; ++i) { const int idx = tid + i * 512; const int kidx = idx >> 3, dg = idx & 7; const int s = q0 - 127 + kidx; const bool ok = (s >= 0) && (kidx < 191);
        u32x4 kw = (u32x4){0u, 0u, 0u, 0u}, vw = kw;
        if (ok) { const bf16_t* rp = qkv + (tokb + s) * 2560 + kvh * 64 + dg * 8; kw = *(const u32x4*)(rp + 2048); vw = *(const u32x4*)(rp + 2304); }
        float k[8]; unpack8(kw, k);
        float ss = 0.f;
#pragma unroll
        for (int jj = 0; jj < 8; ++jj) ss += k[jj] * k[jj];
        ss += __shfl_xor(ss, 1); ss += __shfl_xor(ss, 2); ss += __shfl_xor(ss, 4);
        const float r = rsqrtf(ss * (1.0f / 64.0f) + 1e-6f);
        const f32x4 g0 = *(const f32x4*)(kg + dg * 8), g1 = *(const f32x4*)(kg + dg * 8 + 4);
        u32x4 w; w.x = cvt_pk_bf16(k[0] * r * g0[0], k[1] * r * g0[1]); w.y = cvt_pk_bf16(k[2] * r * g0[2], k[3] * r * g0[3]); w.z = cvt_pk_bf16(k[4] * r * g1[0], k[5] * r * g1[1]); w.w = cvt_pk_bf16(k[6] * r * g1[2], k[7] * r * g1[3]);
        *(u32x4*)(Ks + kidx * 144 + dg * 16) = w;
        unsigned short* vcol = (unsigned short*)(Vt + (dg * 8) * 392 + kidx * 2);
        vcol[0 * 196] = (unsigned short)(vw.x & 0xffffu); vcol[1 * 196] = (unsigned short)(vw.x >> 16); vcol[2 * 196] = (unsigned short)(vw.y & 0xffffu); vcol[3 * 196] = (unsigned short)(vw.y >> 16);
        vcol[4 * 196] = (unsigned short)(vw.z & 0xffffu); vcol[5 * 196] = (unsigned short)(vw.z >> 16); vcol[6 * 196] = (unsigned short)(vw.w & 0xffffu); vcol[7 * 196] = (unsigned short)(vw.w >> 16); }
    const float slope2 = exp2f(-0.25f * (float)(hq + 1)) * LOG2E, sink2 = sinks[hq] * LOG2E;
    __syncthreads();
#pragma unroll
    for (int i = 0; i < 4; ++i) {
        bf16x8 qf[2];
        { const u32x4 w0 = qraw[i][0], w1 = qraw[i][1]; float f0[8], f1[8]; unpack8(w0, f0); unpack8(w1, f1);
          float ss = 0.f;
#pragma unroll
          for (int jj = 0; jj < 8; ++jj) ss += f0[jj] * f0[jj] + f1[jj] * f1[jj];
          ss += __shfl_xor(ss, 16); ss += __shfl_xor(ss, 32);
          const float r = rsqrtf(ss * (1.0f / 64.0f) + 1e-6f) * 0.125f * LOG2E;
          const f32x4 ga = *(const f32x4*)(qg + fq * 8), gb = *(const f32x4*)(qg + fq * 8 + 4), gc = *(const f32x4*)(qg + 32 + fq * 8), gd = *(const f32x4*)(qg + 32 + fq * 8 + 4);
          u32x4 a, c;
          a.x = cvt_pk_bf16(f0[0] * r * ga[0], f0[1] * r * ga[1]); a.y = cvt_pk_bf16(f0[2] * r * ga[2], f0[3] * r * ga[3]); a.z = cvt_pk_bf16(f0[4] * r * gb[0], f0[5] * r * gb[1]); a.w = cvt_pk_bf16(f0[6] * r * gb[2], f0[7] * r * gb[3]);
          c.x = cvt_pk_bf16(f1[0] * r * gc[0], f1[1] * r * gc[1]); c.y = cvt_pk_bf16(f1[2] * r * gc[2], f1[3] * r * gc[3]); c.z = cvt_pk_bf16(f1[4] * r * gd[0], f1[5] * r * gd[1]); c.w = cvt_pk_bf16(f1[6] * r * gd[2], f1[7] * r * gd[3]);
          qf[0] = __builtin_bit_cast(bf16x8, a); qf[1] = __builtin_bit_cast(bf16x8, c); }
        f32x4 sc[9];
#pragma unroll
        for (int jr = 0; jr < 9; ++jr) { const unsigned char* kp = Ks + (16 * (i + jr) + fr) * 144 + fq * 16;
            const bf16x8 k0 = *(const bf16x8*)kp, k1 = *(const bf16x8*)(kp + 64);
            f32x4 acc = (f32x4){0.f, 0.f, 0.f, 0.f};
            acc = __builtin_amdgcn_mfma_f32_16x16x32_bf16(k0, qf[0], acc, 0, 0, 0);
            acc = __builtin_amdgcn_mfma_f32_16x16x32_bf16(k1, qf[1], acc, 0, 0, 0);
            sc[jr] = acc; }
        float m = sink2;
        const float nb = -slope2 * (float)(fr + 127 - 4 * fq); const bool head = q0 < 128;
#pragma unroll
        for (int jr = 0; jr < 9; ++jr)
#pragma unroll
            for (int e = 0; e < 4; ++e) { const int dist = fr + 127 - 16 * jr - 4 * fq - e; const int kidx = 16 * (i + jr) + 4 * fq + e;
                bool valid = true;
                if (jr == 0) valid = dist < 128;
                if (jr == 8) valid = dist >= 0;
                if (head) valid = valid && (q0 - 127 + kidx >= 0);
                const float v = valid ? fmaf(slope2, (float)(16 * jr + e), sc[jr][e]) + nb : -1e30f; sc[jr][e] = v; m = fmaxf(m, v); }
        m = fmaxf(m, __shfl_xor(m, 16)); m = fmaxf(m, __shfl_xor(m, 32));
        float l = 0.f;
#pragma unroll
        for (int jr = 0; jr < 9; ++jr)
#pragma unroll
            for (int e = 0; e < 4; ++e) { const float pv = ex2(sc[jr][e] - m); sc[jr][e] = pv; l += pv; }
        l += __shfl_xor(l, 16); l += __shfl_xor(l, 32);
        l += ex2(sink2 - m);
        const float inv = 1.0f / l;
        bf16x8 pf[5];
#pragma unroll
        for (int pp = 0; pp < 5; ++pp) { u32x4 w; w.x = cvt_pk_bf16(sc[2 * pp][0], sc[2 * pp][1]); w.y = cvt_pk_bf16(sc[2 * pp][2], sc[2 * pp][3]);
            if (pp < 4) { w.z = cvt_pk_bf16(sc[2 * pp + 1][0], sc[2 * pp + 1][1]); w.w = cvt_pk_bf16(sc[2 * pp + 1][2], sc[2 * pp + 1][3]); } else { w.z = 0u; w.w = 0u; }
            pf[pp] = __builtin_bit_cast(bf16x8, w); }
#pragma unroll
        for (int nt = 0; nt < 4; ++nt) { f32x4 o = (f32x4){0.f, 0.f, 0.f, 0.f};
            const unsigned char* vp = Vt + (nt * 16 + fr) * 392 + (16 * i + 4 * fq) * 2;
#pragma unroll
            for (int pp = 0; pp < 5; ++pp) { u32x4 w; const u32x2 lo = *(const u32x2*)(vp + (2 * pp) * 32); w.x = lo.x; w.y = lo.y;
                if (pp < 4) { const u32x2 hi = *(const u32x2*)(vp + (2 * pp + 1) * 32); w.z = hi.x; w.w = hi.y; } else { w.z = 0u; w.w = 0u; }
                o = __builtin_amdgcn_mfma_f32_16x16x32_bf16(__builtin_bit_cast(bf16x8, w), pf[pp], o, 0, 0, 0); }
            u32x2 w2; w2.x = cvt_pk_bf16(o[0] * inv, o[1] * inv); w2.y = cvt_pk_bf16(o[2] * inv, o[3] * inv);
            *(u32x2*)(ycat + (tokb + q0 + 16 * i + fr) * 2048 + hq * 64 + nt * 16 + 4 * fq) = w2; }
    }
    __syncthreads();
}

#define XB_TMO      128
#define XB_XCNT(j)  (256  + 64 * (j))
#define XB_XSUB(j)  (1280 + 64 * (j))
#define XB_XGEN(j)  (2304 + 64 * (j))
#define XB_TOP      3328
#define XB_TOPGEN   3392
#define XCD_BAR_WORDS 3456
#define XB_SPIN_CAP (1u << 18)
__device__ __forceinline__ unsigned xb_ld(unsigned* p)              { return __hip_atomic_load(p, __ATOMIC_RELAXED, __HIP_MEMORY_SCOPE_AGENT); }
__device__ __forceinline__ unsigned xb_add(unsigned* p, unsigned v) { return __hip_atomic_fetch_add(p, v, __ATOMIC_RELAXED, __HIP_MEMORY_SCOPE_AGENT); }
__device__ __forceinline__ unsigned xb_xcc_id() { return (unsigned)__builtin_amdgcn_s_getreg((3 << 11) | 20) & 0xFu; }
#define XB_SPIN(cond, bar) do { unsigned _sp = 0; while (cond) { __builtin_amdgcn_s_sleep(1); \
    if ((++_sp & 255u) == 0u) { if (xb_ld(&(bar)[XB_TMO])) break; if (_sp > XB_SPIN_CAP) { atomicAdd(&(bar)[XB_TMO], 1u); break; } } } } while (0)
struct XcdBarrier { unsigned* bar; unsigned x; volatile LAS unsigned* st; };
__device__ __forceinline__ XcdBarrier xcd_barrier_post(unsigned* bar, volatile LAS unsigned* st) {
    XcdBarrier b; b.bar = bar; b.x = xb_xcc_id(); b.st = st;
    if (threadIdx.x == 0) (void)xb_add(&bar[XB_XCNT(b.x)], 1u);
    return b;
}
__device__ __forceinline__ void xcd_barrier_complete(unsigned* bar, unsigned x, unsigned& nloc, unsigned& nx) {
    const unsigned G = gridDim.x * gridDim.y * gridDim.z;
    unsigned sum, cnt, mine, sp = 0u;
    for (;;) {
        sum = 0u; cnt = 0u; mine = 0u;
#pragma unroll
        for (unsigned j = 0; j < 16; ++j) { const unsigned c = xb_ld(&bar[XB_XCNT(j)]); sum += c; cnt += (c > 0u) ? 1u : 0u; mine = (j == x) ? c : mine; }
        if (sum == G) break;
        __builtin_amdgcn_s_sleep(1);
        if ((++sp & 255u) == 0u) { if (xb_ld(&bar[XB_TMO])) break; if (sp > XB_SPIN_CAP) { atomicAdd(&bar[XB_TMO], 1u); break; } }
    }
    nloc = mine > 0u ? mine : 1u; nx = cnt > 0u ? cnt : 1u;
}
__device__ __forceinline__ void xcd_barrier(const XcdBarrier& b) {
    asm volatile("s_waitcnt vmcnt(0)" ::: "memory");
    __syncthreads();
    if (threadIdx.x == 0) {
        unsigned* bar = b.bar;
        __builtin_amdgcn_s_waitcnt(0);
        unsigned nloc = b.st[0], nx = b.st[1];
        if (nloc == 0u) { xcd_barrier_complete(bar, b.x, nloc, nx); b.st[0] = nloc; b.st[1] = nx; }
        const unsigned old = xb_add(&bar[XB_XSUB(b.x)], 1u);
        const unsigned gen = old / nloc;
        if (old + 1u == (gen + 1u) * nloc) {
            __builtin_amdgcn_fence(__ATOMIC_RELEASE, "agent");
            asm volatile("s_waitcnt vmcnt(0)" ::: "memory");
            const unsigned og = xb_add(&bar[XB_TOP], 1u);
            const unsigned tg = og / nx;
            if (og + 1u == (tg + 1u) * nx) xb_add(&bar[XB_TOPGEN], 1u);
            else XB_SPIN(xb_ld(&bar[XB_TOPGEN]) == tg, bar);
            __builtin_amdgcn_fence(__ATOMIC_ACQUIRE, "agent");
            xb_add(&bar[XB_XGEN(b.x)], 1u);
            asm volatile("s_waitcnt vmcnt(0)" ::: "memory");
        } else {
            XB_SPIN(xb_ld(&bar[XB_XGEN(b.x)]) == gen, bar);
            __builtin_amdgcn_fence(__ATOMIC_ACQUIRE, "agent");
            asm volatile("s_waitcnt vmcnt(0)" ::: "memory");
        }
    }
    __syncthreads();
}

struct Args { const float* in[25]; float* out; unsigned char* ws; int ph_lo, ph_hi; };

__global__ void __launch_bounds__(512, 2) mega(Args a) {
    extern __shared__ __attribute__((aligned(16))) unsigned char lds[];
    float* sm = (float*)lds;
    unsigned char* ws = a.ws;
    bf16_t* Win_t = (bf16_t*)(ws + WS_WIN); bf16_t* Wglu_t = (bf16_t*)(ws + WS_WGLU); bf16_t* WoE_t = (bf16_t*)(ws + WS_WOE); bf16_t* Wqkv_t = (bf16_t*)(ws + WS_WQKV);
    bf16_t* WoO_t = (bf16_t*)(ws + WS_WOO); bf16_t* Wup_t = (bf16_t*)(ws + WS_WUP); bf16_t* Wdn_t = (bf16_t*)(ws + WS_WDN);
    bf16_t* XN = (bf16_t*)(ws + WS_XN); bf16_t* PROJ = (bf16_t*)(ws + WS_PROJ); bf16_t* YCAT = (bf16_t*)(ws + WS_YCAT); bf16_t* YS5 = (bf16_t*)(ws + WS_YS5); bf16_t* HID = (bf16_t*)(ws + WS_HID);
    bf16_t* HST = (bf16_t*)(ws + WS_HST); float* HDEC = (float*)(ws + WS_HDEC); float* S5F = (float*)(ws + WS_S5F); float* S5A = (float*)(ws + WS_S5A); float* S5B = (float*)(ws + WS_S5B); float* RS = (float*)(ws + WS_RS);
    const int G = gridDim.x, bid = blockIdx.x;
    if (threadIdx.x < 4) ((volatile LAS unsigned*)((LAS unsigned char*)lds + LDS_STAGE))[threadIdx.x] = 0u;
    __syncthreads();
    XcdBarrier xbar; xbar.bar = (unsigned*)(ws + WS_BAR); xbar.x = 0; xbar.st = nullptr;
    if (a.ph_hi - a.ph_lo > 1) xbar = xcd_barrier_post((unsigned*)(ws + WS_BAR), (volatile LAS unsigned*)((LAS unsigned char*)lds + LDS_STAGE));
    if (a.ph_lo > 1000) cg::this_grid().sync();

    for (int ph = a.ph_lo; ph < a.ph_hi; ++ph) {
      int nrep = 1;
      for (int rep = 0; rep < nrep; ++rep) {
        if (ph == 0) {
            if (REP_MASK & (1 << 11)) nrep = 2;
            {
                int off_ = 0;
#define PRO_TS(n_) ((((bid - off_) % G) + G) % G); off_ += (n_)
                for (int j = 0; j < 2; ++j) {
                    int ts;
                    ts = PRO_TS(640); transpose_cvt(a.in[2] + (size_t)j * 2048 * 5120, Win_t + (size_t)j * 5120 * 2048, 2048, 5120, sm, a.in[1] + (size_t)j * 2048, ts, G);
                    ts = PRO_TS(64);  transpose_cvt(a.in[11] + (size_t)j * 1024 * 1024, Wglu_t + (size_t)j * 1024 * 1024, 1024, 1024, sm, nullptr, ts, G);
                    ts = PRO_TS(256); transpose_cvt(a.in[15] + (size_t)j * 2048 * 2048, WoE_t + (size_t)j * 2048 * 2048, 2048, 2048, sm, nullptr, ts, G);
                    ts = PRO_TS(320); transpose_cvt(a.in[17] + (size_t)j * 2048 * 2560, Wqkv_t + (size_t)j * 2560 * 2048, 2048, 2560, sm, a.in[16] + (size_t)j * 2048, ts, G);
                    ts = PRO_TS(256); transpose_cvt(a.in[21] + (size_t)j * 2048 * 2048, WoO_t + (size_t)j * 2048 * 2048, 2048, 2048, sm, nullptr, ts, G);
                }
#undef PRO_TS
            }
            s5_params(a.in[3], a.in[4], a.in[5], a.in[6], a.in[7], S5A, S5B);
            x_stats_phase(a.in[0], XN, RS);
        } else {
            const int q = ph - 1, pair = q / 13, r = q % 13;
            const bool odd = r >= 8; const int layer = pair * 2 + (odd ? 1 : 0), j = pair; const int rr = odd ? r - 8 : r;
            int kind;
            if (!odd) kind = rr == 0 ? 1 : rr == 1 ? 2 : rr == 2 ? 3 : rr == 3 ? 4 : rr == 4 ? 5 : rr == 5 ? 6 : rr == 6 ? 8 : 9;
            else kind = rr == 0 ? 1 : rr == 1 ? 10 : rr == 2 ? 6 : rr == 3 ? 8 : 9;
            if ((REP_MASK >> kind) & 1) nrep = 2;
            switch (kind) {
            case 1: case 8: {
                pg8::Gemm g; pg8::EpiBf16 E; const float* rs;
                float* RL = (float*)(lds + 131072);
                if (kind == 8) { g = pg8::Gemm{XN, Wup_t + (size_t)layer * 8192 * 2048, T, 8192, 2048}; E = pg8::EpiBf16{HID, 8192, 1, RL}; rs = RS + (size_t)(2 * layer + 1) * T * 32; }
                else if (!odd) { g = pg8::Gemm{XN, Win_t + (size_t)j * 5120 * 2048, T, 5120, 2048}; E = pg8::EpiBf16{PROJ, 5120, 0, RL}; rs = RS + (size_t)(2 * layer) * T * 32; }
                else { g = pg8::Gemm{XN, Wqkv_t + (size_t)j * 2560 * 2048, T, 2560, 2048}; E = pg8::EpiBf16{PROJ, 2560, 0, RL}; rs = RS + (size_t)(2 * layer) * T * 32; }
                pg8::StaticOrder S; S.init(g.M, g.N, G, bid);
                { int tid = threadIdx.x; asm volatile("" : "+v"(tid));
#pragma unroll
                  for (int i0 = 0; i0 < 4; i0 += 2) { const int i = i0 + (tid >> 8); pg8::Unit u;
                      if (S.next(i, u)) { const float* rp = rs + (size_t)(u.pm * 256 + (tid & 255)) * 32; f32x4 t4 = *(const f32x4*)rp;
#pragma unroll
                          for (int q4 = 1; q4 < 8; ++q4) t4 = t4 + *(const f32x4*)(rp + 4 * q4);
                          RL[i * 256 + (tid & 255)] = rsqrtf(((t4[0] + t4[1]) + (t4[2] + t4[3])) * (1.0f / 2048.0f) + 1e-6f); } }
                  __syncthreads(); }
                pg8::gemm_phase<pg8::EpiBf16, true, GEMM_SP2>((LAS unsigned char*)lds, g, S, E);
                if (kind == 1 && rep == 0) {
                    const int nfull = S.nwg % G;
                    if (nfull != 0 && bid >= nfull) {
                        __syncthreads();
                        transpose_cvt(a.in[23] + (size_t)layer * 2048 * 8192, Wup_t + (size_t)layer * 8192 * 2048, 2048, 8192, sm, a.in[22] + (size_t)layer * 2048, bid - nfull, G - nfull);
                        if (odd) { const int ni = G - nfull; transpose_cvt(a.in[24] + (size_t)layer * 8192 * 2048, Wdn_t + (size_t)layer * 2048 * 8192, 8192, 2048, sm, nullptr, (((bid - nfull - 1024) % ni) + ni) % ni, ni); }
                    } else if (nfull == 0 && !odd) { __syncthreads(); transpose_cvt(a.in[23] + (size_t)layer * 2048 * 8192, Wup_t + (size_t)layer * 8192 * 2048, 2048, 8192, sm, a.in[22] + (size_t)layer * 2048, bid, G); }
                    else if (nfull == 0) { __syncthreads(); transpose_cvt(a.in[23] + (size_t)layer * 2048 * 8192, Wup_t + (size_t)layer * 8192 * 2048, 2048, 8192, sm, a.in[22] + (size_t)layer * 2048, bid, G);
                        transpose_cvt(a.in[24] + (size_t)layer * 8192 * 2048, Wdn_t + (size_t)layer * 2048 * 8192, 8192, 2048, sm, nullptr, bid, G); }
                }
            } break;
            case 5: {
                pg8::Gemm g{YS5, Wglu_t + (size_t)j * 1024 * 1024, T, 1024, 1024}; pg8::EpiGlu E{YS5, a.in[12] + (size_t)j * 1024, YCAT, 2048};
                pg8::StaticOrder S; S.init(g.M, g.N, G, bid);
                pg8::gemm_phase<pg8::EpiGlu, false, GEMM_SP2>((LAS unsigned char*)lds, g, S, E);
                if (rep == 0) { const int nfull = S.nwg < G ? S.nwg : 0;
                    __syncthreads();
                    if (nfull != 0) { if (bid >= nfull) transpose_cvt(a.in[24] + (size_t)layer * 8192 * 2048, Wdn_t + (size_t)layer * 2048 * 8192, 8192, 2048, sm, nullptr, bid - nfull, G - nfull); }
                    else transpose_cvt(a.in[24] + (size_t)layer * 8192 * 2048, Wdn_t + (size_t)layer * 2048 * 8192, 8192, 2048, sm, nullptr, bid, G); }
            } break;
            case 6: case 9: {
                pg8::Gemm g;
                if (kind == 9) g = pg8::Gemm{HID, Wdn_t + (size_t)layer * 2048 * 8192, T, 2048, 8192};
                else g = pg8::Gemm{YCAT, (odd ? WoO_t : WoE_t) + (size_t)j * 2048 * 2048, T, 2048, 2048};
                const int slot = kind == 9 ? 2 * layer + 2 : 2 * layer + 1;
                pg8::EpiResid E{XN, RS + (size_t)slot * T * 32, (kind == 9 && layer == 3) ? a.out : (float*)nullptr};
                pg8::StaticOrder S; S.init(g.M, g.N, G, bid);
                pg8::gemm_phase<pg8::EpiResid, false, GEMM_SP2>((LAS unsigned char*)lds, g, S, E);
            } break;
            case 2:
                for (int r2 = 0; r2 < ((REP2 & 8) ? 2 : 1); ++r2) for (int it = bid; it < 1024; it += G) hgrn_p1(it, PROJ, a.in[13], j, HST, HDEC, lds);
                if (G == 256) s5_wg<false>(bid, PROJ, S5A + (size_t)j * 8192, S5B + (size_t)j * 131072, S5F, nullptr, nullptr, nullptr, nullptr, lds);
                else for (int r2 = 0; r2 < ((REP2 & 16) ? 2 : 1); ++r2) for (int it = bid; it < 1024; it += G) s5_pass<false>(it, PROJ, S5A + (size_t)j * 8192, S5B + (size_t)j * 131072, S5F, nullptr, nullptr, nullptr, nullptr, lds);
                break;
            case 3: hgrn_p2(HST, HDEC); s5_carry(S5F, S5A + (size_t)j * 8192); break;
            case 4:
                for (int r2 = 0; r2 < ((REP2 & 1) ? 2 : 1); ++r2) for (int it = bid; it < 1024; it += G) hgrn_p3(it, PROJ, a.in[13], j, HST, a.in[14] + (size_t)j * 128, YCAT, lds);
                if (G == 256) s5_wg<true>(bid, PROJ, S5A + (size_t)j * 8192, S5B + (size_t)j * 131072, S5F, a.in[8] + (size_t)j * 65536, a.in[9] + (size_t)j * 65536, a.in[10] + (size_t)j * 1024, YS5, lds);
                else for (int r2 = 0; r2 < ((REP2 & 2) ? 2 : 1); ++r2) for (int it = bid; it < 1024; it += G) s5_pass<true>(it, PROJ, S5A + (size_t)j * 8192, S5B + (size_t)j * 131072, S5F, a.in[8] + (size_t)j * 65536, a.in[9] + (size_t)j * 65536, a.in[10] + (size_t)j * 1024, YS5, lds);
                break;
            case 10:
                for (int it = bid; it < 512; it += G) attn_item(it, PROJ, a.in[18] + (size_t)j * 64, a.in[19] + (size_t)j * 64, a.in[20] + (size_t)j * 32, YCAT, lds);
                break;
            default: break;
            }
        }
      }
        if (ph + 1 < a.ph_hi) { xcd_barrier(xbar); if (REP2 & 4) xcd_barrier(xbar); }
    }
}

extern "C" void kernel_launch(void* const* d_in, const int* in_sizes, int n_in, void* d_out, int out_size, void* d_ws, size_t ws_size, hipStream_t stream) {
    static int grid = 0;
    if (grid == 0) {
        if (n_in != 25 || ws_size < WS_END) { fprintf(stderr, "kernel_launch: need 25 inputs and %zu bytes of workspace; got %d, %zu\n", (size_t)WS_END, n_in, ws_size); grid = -1; return; }
        int dev = 0, cus = 0, per_cu = 0;
        hipGetDevice(&dev); hipDeviceGetAttribute(&cus, hipDeviceAttributeMultiprocessorCount, dev);
        if (hipFuncSetAttribute((const void*)mega, hipFuncAttributeMaxDynamicSharedMemorySize, LDS_BYTES) != hipSuccess) { fprintf(stderr, "kernel_launch: hipFuncSetAttribute failed\n"); grid = -1; return; }
        if (hipOccupancyMaxActiveBlocksPerMultiprocessor(&per_cu, (const void*)mega, 512, LDS_BYTES) != hipSuccess || per_cu < 1) { fprintf(stderr, "kernel_launch: occupancy query says %d\n", per_cu); per_cu = 1; }
        (void)hipGetLastError();
        grid = cus > 0 ? cus : 256;
    }
    if (grid < 0) return;
    Args a{};
    for (int i = 0; i < 25; ++i) a.in[i] = (const float*)d_in[i];
    a.out = (float*)d_out; a.ws = (unsigned char*)d_ws;
#if MK_ONE_LAUNCH
    a.ph_lo = 0; a.ph_hi = NPH;
    if (hipMemsetAsync((unsigned char*)d_ws + WS_BAR, 0, (size_t)XCD_BAR_WORDS_C * 4, stream) != hipSuccess) { fprintf(stderr, "kernel_launch: memset failed\n"); return; }
    void* args[] = {&a};
    hipError_t e = hipLaunchCooperativeKernel((const void*)mega, dim3(grid), dim3(512), args, LDS_BYTES, stream);
    if (e != hipSuccess) fprintf(stderr, "kernel_launch: cooperative launch failed: %s (grid %d)\n", hipGetErrorString(e), grid);
#else
    for (int ph = 0; ph < NPH; ++ph) { a.ph_lo = ph; a.ph_hi = ph + 1; hipLaunchKernelGGL(mega, dim3(grid), dim3(512), LDS_BYTES, stream, a); }
#endif
}
```

```cpp
#include <hip/hip_runtime.h>
#include <hip/hip_cooperative_groups.h>
#include <cstdio>
namespace cg = cooperative_groups;

#ifndef REP_MASK
#define REP_MASK 0
#endif
#ifndef H3REP
#define H3REP 0
#endif
#ifndef REP2
#define REP2 0
#endif
#ifndef GEMM_SP2
#define GEMM_SP2 true
#endif
#ifndef MK_ONE_LAUNCH
#define MK_ONE_LAUNCH 1
#endif

#define LAS __attribute__((address_space(3)))
typedef unsigned short bf16_t;
typedef short bf16x8 __attribute__((ext_vector_type(8)));
typedef float f32x4 __attribute__((ext_vector_type(4)));
typedef float f32x2 __attribute__((ext_vector_type(2)));
typedef unsigned u32x4 __attribute__((ext_vector_type(4)));
typedef unsigned u32x2 __attribute__((ext_vector_type(2)));

constexpr int T = 8192, SEQ = 4096;
constexpr int NPH = 27;
constexpr int LDS_STAGE = 135168;
constexpr int LDS_BYTES = LDS_STAGE + 16;
constexpr int XCD_BAR_WORDS_C = 3456;
constexpr float LOG2E = 1.4426950408889634f;

constexpr size_t SZ_WIN = (size_t)5120 * 2048 * 2, SZ_WGLU = (size_t)1024 * 1024 * 2, SZ_WSQ = (size_t)2048 * 2048 * 2, SZ_WQKV = (size_t)2560 * 2048 * 2, SZ_WUP = (size_t)8192 * 2048 * 2;
constexpr size_t WS_WIN = 0;
constexpr size_t WS_WGLU = WS_WIN + 2 * SZ_WIN;
constexpr size_t WS_WOE = WS_WGLU + 2 * SZ_WGLU;
constexpr size_t WS_WQKV = WS_WOE + 2 * SZ_WSQ;
constexpr size_t WS_WOO = WS_WQKV + 2 * SZ_WQKV;
constexpr size_t WS_WUP = WS_WOO + 2 * SZ_WSQ;
constexpr size_t WS_WDN = WS_WUP + 4 * SZ_WUP;
constexpr size_t WS_XN = WS_WDN + 4 * SZ_WUP;
constexpr size_t WS_PROJ = WS_XN + (size_t)T * 2048 * 2;
constexpr size_t WS_YCAT = WS_PROJ + (size_t)T * 5120 * 2;
constexpr size_t WS_YS5 = WS_YCAT + (size_t)T * 2048 * 2;
constexpr size_t WS_HID = WS_YS5 + (size_t)T * 1024 * 2;
constexpr size_t WS_HST = WS_HID + (size_t)T * 8192 * 2;
constexpr size_t WS_HDEC = WS_HST + (size_t)16 * 64 * 16384 * 4;
constexpr size_t WS_S5F = WS_HDEC + (size_t)16 * 64 * 128 * 4;
constexpr size_t WS_S5A = WS_S5F + (size_t)128 * 64 * 64 * 2 * 4;
constexpr size_t WS_S5B = WS_S5A + (size_t)2 * 64 * 64 * 2 * 4;
constexpr size_t WS_RS = WS_S5B + (size_t)2 * 64 * 64 * 32 * 4;
constexpr size_t WS_BAR = WS_RS + (size_t)9 * T * 32 * 4;
constexpr size_t WS_END = WS_BAR + (size_t)XCD_BAR_WORDS_C * 4;


__device__ __forceinline__ unsigned cvt_pk_bf16(float lo, float hi) { unsigned r; asm volatile("v_cvt_pk_bf16_f32 %0, %1, %2" : "=v"(r) : "v"(lo), "v"(hi)); return r; }
__device__ __forceinline__ unsigned short f2bf(float f) { unsigned u = __builtin_bit_cast(unsigned, f); return (unsigned short)((u + 0x7fffu + ((u >> 16) & 1u)) >> 16); }
__device__ __forceinline__ float bflo(unsigned w) { return __builtin_bit_cast(float, w << 16); }
__device__ __forceinline__ float bfhi(unsigned w) { return __builtin_bit_cast(float, w & 0xffff0000u); }
__device__ __forceinline__ void unpack8(u32x4 w, float (&f)[8]) {
    f[0] = bflo(w.x); f[1] = bfhi(w.x); f[2] = bflo(w.y); f[3] = bfhi(w.y); f[4] = bflo(w.z); f[5] = bfhi(w.z); f[6] = bflo(w.w); f[7] = bfhi(w.w);
}
__device__ __forceinline__ float wave_sum(float v) {
#pragma unroll
    for (int o = 32; o > 0; o >>= 1) v += __shfl_xor(v, o);
    return v;
}
__device__ __forceinline__ float sigmoidf_(float x) { return __builtin_amdgcn_rcpf(1.0f + __expf(-x)); }
__device__ __forceinline__ float ex2(float x) { return __builtin_amdgcn_exp2f(x); }

namespace pg8 {
constexpr int BM = 256, BK = 64, HALF = 128, HTB = HALF * BK * 2, STAGE_BYTES = 8 * HTB, NXCD = 8, WGM = 8;
__device__ __forceinline__ int lds_byte(int r, int c) { const int st = (r >> 4) * 2 + (c >> 5), rr = r & 15, cc = c & 31, ob = rr * 64 + cc * 2; return st * 1024 + (ob ^ (((ob >> 9) & 1) << 5)); }
__device__ __forceinline__ void stage_rc(int b, int& R, int& C) { const int st = b / 1024, sb = b % 1024, swz = sb ^ (((sb >> 9) & 1) << 5); R = (st >> 1) * 16 + swz / 64; C = (st & 1) * 32 + (swz % 64) / 2; }
__device__ __forceinline__ int perm32(int rho) { const int n = rho >> 4, i = rho & 15; return 8 * (i >> 2) + 4 * n + (i & 3); }

struct Unit { int pm, pn; };
struct Gemm { const bf16_t* A; const bf16_t* Bt; int M, N, K; };

struct StaticOrder {
    int nM, nN, nwg, G, c;
    __device__ void init(int M, int N, int G_, int c_) { nM = M / BM; nN = N / BM; nwg = nM * nN; G = G_; c = c_; }
    __device__ bool next(int i, Unit& u) const {
        const long L = (long)i * G + c; if (L >= nwg) return false;
        int wgid = (int)L; { const int q = nwg / NXCD, r = nwg % NXCD, xcd = wgid % NXCD, off = wgid / NXCD; wgid = (xcd < r ? xcd * (q + 1) : r * (q + 1) + (xcd - r) * q) + off; }
        const int nig = WGM * nN, gid = wgid / nig, fm = gid * WGM, gsz = (nM - fm) < WGM ? (nM - fm) : WGM;
        u.pm = fm + ((wgid % nig) % gsz); u.pn = (wgid % nig) / gsz; return true;
    }
};

struct EpiBf16 {
    static constexpr bool PERM = true;
    bf16_t* O; int ldc; int act; const float* rl;
    __device__ __forceinline__ void operator()(const f32x4 (&acc)[2][2][4][2], const Unit& u, int ui, int wr, int wc, int fr, int fq) const {
        const int row0 = u.pm * BM + wr * 64 + fr, col0 = u.pn * BM + wc * 32 + 8 * fq;
#pragma unroll
        for (int ai = 0; ai < 2; ++ai)
#pragma unroll
            for (int m = 0; m < 4; ++m) { const int row = row0 + ai * HALF + m * 16; bf16_t* rowp = O + (size_t)row * ldc + col0;
                const float r = rl[ui * 256 + wr * 64 + fr + ai * HALF + m * 16];
#pragma unroll
                for (int bj = 0; bj < 2; ++bj) { f32x4 v0 = acc[ai][bj][m][0] * r, v1 = acc[ai][bj][m][1] * r;
                    if (act) {
#pragma unroll
                        for (int j = 0; j < 4; ++j) { float a = fmaxf(v0[j], 0.f), b = fmaxf(v1[j], 0.f); v0[j] = a * a; v1[j] = b * b; } }
                    u32x4 w; w.x = cvt_pk_bf16(v0[0], v0[1]); w.y = cvt_pk_bf16(v0[2], v0[3]); w.z = cvt_pk_bf16(v1[0], v1[1]); w.w = cvt_pk_bf16(v1[2], v1[3]);
                    *(u32x4*)(rowp + bj * HALF) = w; } }
    }
};
struct EpiGlu {
    static constexpr bool PERM = true;
    const bf16_t* Y; const float* bias; bf16_t* O; int ldo;
    __device__ __forceinline__ void operator()(const f32x4 (&acc)[2][2][4][2], const Unit& u, int ui, int wr, int wc, int fr, int fq) const {
        const int row0 = u.pm * BM + wr * 64 + fr, col0 = u.pn * BM + wc * 32 + 8 * fq;
        f32x4 bb[2][2];
#pragma unroll
        for (int bj = 0; bj < 2; ++bj) { bb[bj][0] = *(const f32x4*)(bias + col0 + bj * HALF); bb[bj][1] = *(const f32x4*)(bias + col0 + bj * HALF + 4); }
#pragma unroll
        for (int ai = 0; ai < 2; ++ai) { u32x4 yw[4][2];
#pragma unroll
            for (int m = 0; m < 4; ++m)
#pragma unroll
                for (int bj = 0; bj < 2; ++bj) yw[m][bj] = *(const u32x4*)(Y + (size_t)(row0 + ai * HALF + m * 16) * 1024 + col0 + bj * HALF);
#pragma unroll
            for (int m = 0; m < 4; ++m) { const int row = row0 + ai * HALF + m * 16;
#pragma unroll
                for (int bj = 0; bj < 2; ++bj) { const int col = col0 + bj * HALF; float y[8]; unpack8(yw[m][bj], y);
                    const f32x4 v0 = acc[ai][bj][m][0] + bb[bj][0], v1 = acc[ai][bj][m][1] + bb[bj][1]; float o[8];
#pragma unroll
                    for (int j = 0; j < 4; ++j) { o[j] = y[j] * sigmoidf_(v0[j]); o[4 + j] = y[4 + j] * sigmoidf_(v1[j]); }
                    u32x4 w; w.x = cvt_pk_bf16(o[0], o[1]); w.y = cvt_pk_bf16(o[2], o[3]); w.z = cvt_pk_bf16(o[4], o[5]); w.w = cvt_pk_bf16(o[6], o[7]);
                    *(u32x4*)(O + (size_t)row * ldo + col) = w; } } }
    }
};
struct EpiResid {
    static constexpr bool PERM = true;
    bf16_t* hb; float* rs; float* outf;
    __device__ __forceinline__ void operator()(const f32x4 (&acc)[2][2][4][2], const Unit& u, int ui, int wr, int wc, int fr, int fq) const {
        const int row0 = u.pm * BM + wr * 64 + fr, col0 = u.pn * BM + wc * 32 + 8 * fq;
#pragma unroll
        for (int ai = 0; ai < 2; ++ai) { u32x4 bv[4][2];
#pragma unroll
            for (int m = 0; m < 4; ++m)
#pragma unroll
                for (int bj = 0; bj < 2; ++bj) bv[m][bj] = *(const u32x4*)(hb + (size_t)(row0 + ai * HALF + m * 16) * 2048 + col0 + bj * HALF);
#pragma unroll
            for (int m = 0; m < 4; ++m) { const int row = row0 + ai * HALF + m * 16; const size_t ro = (size_t)row * 2048 + col0; float ss = 0.f;
#pragma unroll
                for (int bj = 0; bj < 2; ++bj) { const size_t o = ro + bj * HALF; float f[8]; unpack8(bv[m][bj], f);
                    const f32x4 v0 = (f32x4){f[0], f[1], f[2], f[3]} + acc[ai][bj][m][0], v1 = (f32x4){f[4], f[5], f[6], f[7]} + acc[ai][bj][m][1];
                    if (outf) { *(f32x4*)(outf + o) = v0; *(f32x4*)(outf + o + 4) = v1; }
                    else { u32x4 w; w.x = cvt_pk_bf16(v0[0], v0[1]); w.y = cvt_pk_bf16(v0[2], v0[3]); w.z = cvt_pk_bf16(v1[0], v1[1]); w.w = cvt_pk_bf16(v1[2], v1[3]); *(u32x4*)(hb + o) = w;
                        float r[8]; unpack8(w, r);
#pragma unroll
                        for (int q = 0; q < 8; ++q) ss += r[q] * r[q]; } }
                if (!outf) { ss += __shfl_xor(ss, 16); ss += __shfl_xor(ss, 32); if (fq == 0) rs[(size_t)row * 32 + u.pn * 4 + wc] = ss; } } }
    }
};

template <class Epi, bool ALIGN_EPI, bool SP2>
__device__ __forceinline__ void gemm_phase(LAS unsigned char* lds, const Gemm g, const StaticOrder& S, const Epi& E) {
    int tid = threadIdx.x; asm volatile("" : "+v"(tid));
    const int wid = __builtin_amdgcn_readfirstlane(tid >> 6), lane = tid & 63, wr = wid >> 2, wc = wid & 3, fr = lane & 15, fq = lane >> 4;
    const int K = g.K, nt = K / BK;
    unsigned voffA[2], voffB[2];
#pragma unroll
    for (int i = 0; i < 2; ++i) { int R, C; stage_rc(tid * 16 + i * 8192, R, C); const int Rb = Epi::PERM ? ((R & ~31) + perm32(R & 31)) : R;
        voffA[i] = (unsigned)(R * K + C) * 2u; voffB[i] = (unsigned)(Rb * K + C) * 2u; }
    const size_t kstep = (size_t)(BK * 2);
    const size_t hstep = (size_t)HALF * K * 2;
    const size_t tstep = 2 * hstep;
    const unsigned ldsw = (unsigned)wid * 1024u;
    const int aoff = lds_byte(wr * 64 + fr, fq * 8), boff = lds_byte(wc * 32 + fr, fq * 8);
#define PG8_SA(b, h) (((b) * 2 + (h)) * HTB)
#define PG8_SB(b, h) ((4 + (b) * 2 + (h)) * HTB)
#define PG8_STAGE(bufoff, gbase, voff) do { _Pragma("unroll") for (int _i = 0; _i < 2; ++_i) \
        __builtin_amdgcn_global_load_lds((const unsigned*)((const char*)(gbase) + (voff)[_i]), (LAS unsigned*)(lds + (bufoff) + ldsw + _i * 8192), 16, 0, 0); } while (0)
#define PG8_LDA(dst, b, h) do { _Pragma("unroll") for (int m = 0; m < 4; ++m) _Pragma("unroll") for (int k = 0; k < 2; ++k) dst[m][k] = *(const LAS bf16x8*)(lds + PG8_SA(b, h) + aoff + m * 2048 + k * 1024); } while (0)
#define PG8_LDB(dst, b, h) do { _Pragma("unroll") for (int n = 0; n < 2; ++n) _Pragma("unroll") for (int k = 0; k < 2; ++k) dst[n][k] = *(const LAS bf16x8*)(lds + PG8_SB(b, h) + boff + n * 2048 + k * 1024); } while (0)
#define PG8_MMA(ai, bj, At, Bt) do { __builtin_amdgcn_s_setprio(1); _Pragma("unroll") for (int m = 0; m < 4; ++m) _Pragma("unroll") for (int n = 0; n < 2; ++n) _Pragma("unroll") for (int k = 0; k < 2; ++k) \
        acc[ai][bj][m][n] = __builtin_amdgcn_mfma_f32_16x16x32_bf16(Bt[n][k], At[m][k], acc[ai][bj][m][n], 0, 0, 0); __builtin_amdgcn_s_setprio(0); } while (0)
#define PG8_WAIT_V(n) asm volatile("s_waitcnt vmcnt(" #n ")" ::: "memory")
#define PG8_WAIT_L(n) asm volatile("s_waitcnt lgkmcnt(" #n ")" ::: "memory")
#define PG8_BAR __builtin_amdgcn_s_barrier()
#define PG8_SCHED __builtin_amdgcn_sched_barrier(0)
    Unit cur, nxt; int ui = 0;
    if (!S.next(0, cur)) return;
    f32x4 acc[2][2][4][2];
#pragma unroll
    for (int a = 0; a < 2; ++a)
#pragma unroll
        for (int b = 0; b < 2; ++b)
#pragma unroll
            for (int m = 0; m < 4; ++m)
#pragma unroll
                for (int n = 0; n < 2; ++n) acc[a][b][m][n] = (f32x4){0.f, 0.f, 0.f, 0.f};
    bf16x8 At[4][2], B0[2][2], B1[2][2];
    const char* cA = (const char*)g.A + (size_t)cur.pm * tstep; const char* cB = (const char*)g.Bt + (size_t)cur.pn * tstep;
    if constexpr (SP2) {
        PG8_STAGE(PG8_SB(0, 0), cB, voffB); PG8_STAGE(PG8_SB(0, 1), cB + hstep, voffB); PG8_STAGE(PG8_SA(0, 0), cA, voffA); PG8_STAGE(PG8_SA(0, 1), cA + hstep, voffA);
        if (wr == 1) PG8_BAR;
        PG8_WAIT_V(2); PG8_BAR;
        PG8_STAGE(PG8_SB(1, 0), cB + kstep, voffB); PG8_STAGE(PG8_SA(1, 0), cA + kstep, voffA); PG8_STAGE(PG8_SB(1, 1), cB + hstep + kstep, voffB);
        PG8_WAIT_V(6); PG8_BAR;
    } else {
    PG8_STAGE(PG8_SB(0, 0), cB, voffB); PG8_STAGE(PG8_SA(0, 0), cA, voffA); PG8_STAGE(PG8_SB(0, 1), cB + hstep, voffB); PG8_STAGE(PG8_SA(0, 1), cA + hstep, voffA);
    if (wr == 1) PG8_BAR;
    PG8_WAIT_V(4); PG8_BAR;
    PG8_STAGE(PG8_SB(1, 0), cB + kstep, voffB); PG8_STAGE(PG8_SA(1, 0), cA + kstep, voffA); PG8_STAGE(PG8_SB(1, 1), cB + hstep + kstep, voffB);
    PG8_WAIT_V(6); PG8_BAR;
    }
    for (;;) {
        const bool has_next = S.next(ui + 1, nxt);
        const char* nA = has_next ? (const char*)g.A + (size_t)nxt.pm * tstep : cA; const char* nB = has_next ? (const char*)g.Bt + (size_t)nxt.pn * tstep : cB;
        for (int t = 0; t < nt; t += 2) {
            const bool last = (t == nt - 2);
            const char* a1 = cA + (size_t)(t + 1) * kstep;
            const char* a2 = last ? nA : cA + (size_t)(t + 2) * kstep; const char* b2 = last ? nB : cB + (size_t)(t + 2) * kstep;
            const char* a3 = a2 + kstep; const char* b3 = b2 + kstep;
            if constexpr (SP2) {
            PG8_LDB(B0, 0, 0); PG8_LDB(B1, 0, 1); PG8_SCHED; PG8_LDA(At, 0, 0); PG8_STAGE(PG8_SA(1, 1), a1 + hstep, voffA);
            PG8_WAIT_V(8); PG8_WAIT_L(0); PG8_BAR; PG8_MMA(0, 0, At, B0); PG8_MMA(0, 1, At, B1); PG8_BAR; PG8_SCHED;
            PG8_LDA(At, 0, 1); PG8_STAGE(PG8_SB(0, 0), b2, voffB); PG8_STAGE(PG8_SB(0, 1), b2 + hstep, voffB); PG8_STAGE(PG8_SA(0, 0), a2, voffA);
            PG8_WAIT_V(8); PG8_WAIT_L(0); PG8_BAR; PG8_MMA(1, 0, At, B0); PG8_MMA(1, 1, At, B1); PG8_BAR; PG8_SCHED;
            PG8_LDB(B0, 1, 0); PG8_LDB(B1, 1, 1); PG8_SCHED; PG8_LDA(At, 1, 0); PG8_STAGE(PG8_SA(0, 1), a2 + hstep, voffA);
            PG8_WAIT_V(8); PG8_WAIT_L(0); PG8_BAR; PG8_MMA(0, 0, At, B0); PG8_MMA(0, 1, At, B1); PG8_BAR; PG8_SCHED;
            PG8_LDA(At, 1, 1); PG8_STAGE(PG8_SB(1, 0), b3, voffB); PG8_STAGE(PG8_SB(1, 1), b3 + hstep, voffB); PG8_STAGE(PG8_SA(1, 0), a3, voffA);
            PG8_WAIT_V(8); PG8_WAIT_L(0); PG8_BAR; PG8_MMA(1, 0, At, B0); PG8_MMA(1, 1, At, B1); PG8_BAR; PG8_SCHED;
            } else {
            PG8_LDB(B0, 0, 0); PG8_SCHED; PG8_LDA(At, 0, 0); PG8_STAGE(PG8_SA(1, 1), a1 + hstep, voffA);
            PG8_WAIT_L(8); PG8_BAR; PG8_WAIT_L(0); PG8_MMA(0, 0, At, B0); PG8_BAR; PG8_SCHED;
            PG8_LDB(B1, 0, 1); PG8_STAGE(PG8_SB(0, 0), b2, voffB);
            PG8_BAR; PG8_WAIT_L(0); PG8_MMA(0, 1, At, B1); PG8_BAR;
            PG8_LDA(At, 0, 1); PG8_STAGE(PG8_SA(0, 0), a2, voffA);
            PG8_BAR; PG8_WAIT_L(0); PG8_MMA(1, 0, At, B0); PG8_BAR; PG8_SCHED;
            PG8_STAGE(PG8_SB(0, 1), b2 + hstep, voffB);
            PG8_WAIT_V(6); PG8_BAR; PG8_MMA(1, 1, At, B1); PG8_BAR;
            PG8_LDB(B0, 1, 0); PG8_SCHED; PG8_LDA(At, 1, 0); PG8_STAGE(PG8_SA(0, 1), a2 + hstep, voffA);
            PG8_WAIT_L(8); PG8_BAR; PG8_WAIT_L(0); PG8_MMA(0, 0, At, B0); PG8_BAR; PG8_SCHED;
            PG8_LDB(B1, 1, 1); PG8_STAGE(PG8_SB(1, 0), b3, voffB);
            PG8_BAR; PG8_WAIT_L(0); PG8_MMA(0, 1, At, B1); PG8_BAR;
            PG8_LDA(At, 1, 1); PG8_STAGE(PG8_SA(1, 0), a3, voffA);
            PG8_BAR; PG8_WAIT_L(0); PG8_MMA(1, 0, At, B0); PG8_BAR; PG8_SCHED;
            PG8_STAGE(PG8_SB(1, 1), b3 + hstep, voffB);
            PG8_WAIT_V(6); PG8_BAR; PG8_MMA(1, 1, At, B1); PG8_BAR;
            }
        }
        if constexpr (ALIGN_EPI) { if (wr == 0) PG8_BAR; }
        E(acc, cur, ui, wr, wc, fr, fq);
        if (!has_next) break;
#pragma unroll
        for (int a = 0; a < 2; ++a)
#pragma unroll
            for (int b = 0; b < 2; ++b)
#pragma unroll
                for (int m = 0; m < 4; ++m)
#pragma unroll
                    for (int n = 0; n < 2; ++n) acc[a][b][m][n] = (f32x4){0.f, 0.f, 0.f, 0.f};
        cur = nxt; cA = nA; cB = nB; ++ui;
        if constexpr (ALIGN_EPI) { if (wr == 1) PG8_BAR; }
    }
    PG8_WAIT_V(0);
    if constexpr (!ALIGN_EPI) { if (wr == 0) PG8_BAR; }
    PG8_BAR;
#undef PG8_SA
#undef PG8_SB
#undef PG8_STAGE
#undef PG8_LDA
#undef PG8_LDB
#undef PG8_MMA
#undef PG8_WAIT_V
#undef PG8_WAIT_L
#undef PG8_BAR
#undef PG8_SCHED
}
}

__device__ __forceinline__ void transpose_cvt(const float* __restrict__ W, bf16_t* __restrict__ Wt, int K, int N, float* sm, const float* __restrict__ gain, int tstart, int tstride) {
    int tid = threadIdx.x; asm volatile("" : "+v"(tid));
    const int tn = N >> 8, ntile = tn * (K >> 6);
    for (int tile = tstart; tile < ntile; tile += tstride) {
        const int k0 = (tile / tn) << 6, n0 = (tile % tn) << 8;
        f32x4 v[8];
#pragma unroll
        for (int i = 0; i < 8; ++i) { const int idx = tid + i * 512; const int rest = idx >> 6; const int r = ((rest >> 3) << 3) + (idx & 7), c4 = ((rest & 7) << 3) + ((idx >> 3) & 7);
            v[i] = __builtin_nontemporal_load((const f32x4*)(W + (size_t)(k0 + r) * N + n0 + c4 * 4)); if (gain) v[i] = v[i] * gain[k0 + r]; }
#pragma unroll
        for (int i = 0; i < 8; ++i) { const int idx = tid + i * 512; const int rest = idx >> 6; const int r = ((rest >> 3) << 3) + (idx & 7), c4 = ((rest & 7) << 3) + ((idx >> 3) & 7);
            float* d = sm + r * 257 + c4 * 4; d[0] = v[i][0]; d[1] = v[i][1]; d[2] = v[i][2]; d[3] = v[i][3]; }
        __syncthreads();
        const int ks = tid & 7;
#pragma unroll
        for (int i = 0; i < 4; ++i) { const int n = (tid >> 3) + 64 * i; float f[8];
#pragma unroll
            for (int j = 0; j < 8; ++j) f[j] = sm[(ks * 8 + j) * 257 + n];
            u32x4 w; w.x = cvt_pk_bf16(f[0], f[1]); w.y = cvt_pk_bf16(f[2], f[3]); w.z = cvt_pk_bf16(f[4], f[5]); w.w = cvt_pk_bf16(f[6], f[7]);
            *(u32x4*)(Wt + (size_t)(n0 + n) * K + k0 + ks * 8) = w; }
        __syncthreads();
    }
}

__device__ __forceinline__ void s5_params(const float* lam_re, const float* lam_im, const float* log_dt, const float* b_re, const float* b_im, float* S5A, float* S5B) {
    int tid = threadIdx.x; asm volatile("" : "+v"(tid));
    for (int idx = blockIdx.x * 512 + tid; idx < 8192; idx += gridDim.x * 512) {
        const float lr = fminf(lam_re[idx], -1e-4f), li = lam_im[idx], dt = expf(log_dt[idx >> 6]);
        const float mag = expf(lr * dt), th = li * dt;
        const float ar = mag * cosf(th), ai = mag * sinf(th);
        const float den = lr * lr + li * li;
        const float zr = ((ar - 1.0f) * lr + ai * li) / den, zi = (ai * lr - (ar - 1.0f) * li) / den;
        S5A[idx * 2] = ar; S5A[idx * 2 + 1] = ai;
#pragma unroll
        for (int c = 0; c < 16; ++c) { const float br = b_re[(size_t)idx * 16 + c], bi = b_im[(size_t)idx * 16 + c];
            S5B[(size_t)idx * 32 + c] = zr * br - zi * bi; S5B[(size_t)idx * 32 + 16 + c] = zr * bi + zi * br; }
    }
}

__device__ __forceinline__ void x_stats_phase(const float* __restrict__ h, bf16_t* __restrict__ hb, float* __restrict__ rs) {
    int tid = threadIdx.x; asm volatile("" : "+v"(tid));
    const int lane = tid & 63, wave = tid >> 6;
    for (int row = blockIdx.x * 8 + wave; row < T; row += gridDim.x * 8) {
        const float* p = h + (size_t)row * 2048 + lane * 8;
        f32x4 v[8]; float ss = 0.f;
#pragma unroll
        for (int i = 0; i < 4; ++i) { v[2 * i] = *(const f32x4*)(p + i * 512); v[2 * i + 1] = *(const f32x4*)(p + i * 512 + 4); }
#pragma unroll
        for (int i = 0; i < 8; ++i) ss += v[i][0] * v[i][0] + v[i][1] * v[i][1] + v[i][2] * v[i][2] + v[i][3] * v[i][3];
        ss = wave_sum(ss);
        if (lane < 32) rs[(size_t)row * 32 + lane] = lane == 0 ? ss : 0.f;
#pragma unroll
        for (int i = 0; i < 4; ++i) { u32x4 w; w.x = cvt_pk_bf16(v[2 * i][0], v[2 * i][1]); w.y = cvt_pk_bf16(v[2 * i][2], v[2 * i][3]); w.z = cvt_pk_bf16(v[2 * i + 1][0], v[2 * i + 1][1]); w.w = cvt_pk_bf16(v[2 * i + 1][2], v[2 * i + 1][3]);
            *(u32x4*)(hb + (size_t)row * 2048 + i * 512 + lane * 8) = w; }
    }
}

__device__ __forceinline__ float hgrn_lb(const float* lbp, int j, int ch) { return j == 0 ? 0.f : sigmoidf_(lbp[1024 + ch] - lbp[ch]); }

__device__ __forceinline__ void hgrn_cumsum(float* base, int st_t, int st_k, int tid) {
    const int k = tid & 127, qd = tid >> 7;
    float* p = base + k * st_k + (16 * qd) * st_t;
    float run = 0.f;
#pragma unroll
    for (int t = 0; t < 16; ++t) { run += p[t * st_t]; p[t * st_t] = run; }
    __syncthreads();
    float off = 0.f;
#pragma unroll
    for (int q = 0; q < 3; ++q) if (q < qd) off += base[k * st_k + (16 * q + 15) * st_t];
    __syncthreads();
    if (qd > 0) {
#pragma unroll
        for (int t = 0; t < 16; ++t) p[t * st_t] += off; }
    __syncthreads();
}

__device__ __forceinline__ void hgrn_p1(int item, const bf16_t* __restrict__ proj, const float* __restrict__ lbp, int j, bf16_t* __restrict__ HST, float* __restrict__ HDEC, unsigned char* smb) {
    int tid = threadIdx.x; asm volatile("" : "+v"(tid));
    const int wave = tid >> 6, lane = tid & 63, fr = lane & 15, fq = lane >> 4;
    const int c = item & 63, h = (item >> 6) & 7, b = item >> 9;
    const size_t tok0 = (size_t)b * SEQ + c * 64;
    float* BT = (float*)smb; float* KT = BT + 8704;
    unsigned char* KH = smb + 2 * 34816; unsigned char* Vt = KH + 18432;
    {
        const int t = lane;
#pragma unroll
        for (int i = 0; i < 2; ++i) { const int kg = wave + 8 * i;
            const bf16_t* rowp = proj + (tok0 + t) * 5120 + h * 128 + kg * 8;
            const u32x4 fw = *(const u32x4*)(rowp + 2048), vw = *(const u32x4*)(rowp + 3072);
            float f[8]; unpack8(fw, f);
#pragma unroll
            for (int jj = 0; jj < 8; ++jj) { const int k = kg * 8 + jj; const float lb = hgrn_lb(lbp, j, h * 128 + k); const float fg = lb + (1.0f - lb) * sigmoidf_(f[jj]);
                BT[k * 65 + t] = __log2f(fg); KT[k * 65 + t] = 1.0f - fg; }
            unsigned short* vcol = (unsigned short*)(Vt + (kg * 8) * 144 + t * 2);
            vcol[0 * 72] = (unsigned short)(vw.x & 0xffffu); vcol[1 * 72] = (unsigned short)(vw.x >> 16); vcol[2 * 72] = (unsigned short)(vw.y & 0xffffu); vcol[3 * 72] = (unsigned short)(vw.y >> 16);
            vcol[4 * 72] = (unsigned short)(vw.z & 0xffffu); vcol[5 * 72] = (unsigned short)(vw.z >> 16); vcol[6 * 72] = (unsigned short)(vw.w & 0xffffu); vcol[7 * 72] = (unsigned short)(vw.w >> 16); }
    }
    __syncthreads();
    hgrn_cumsum(BT, 1, 65, tid);
#pragma unroll
    for (int i = 0; i < 16; ++i) { const int e = tid + i * 512; const int k = e >> 6, s = e & 63;
        *(unsigned short*)(KH + k * 144 + s * 2) = f2bf(KT[k * 65 + s] * ex2(BT[k * 65 + 63] - BT[k * 65 + s])); }
    if (tid < 128) HDEC[(size_t)item * 128 + tid] = ex2(BT[tid * 65 + 63]);
    __syncthreads();
    {
        bf16x8 bfr[2];
#pragma unroll
        for (int ks = 0; ks < 2; ++ks) bfr[ks] = *(const bf16x8*)(KH + (16 * wave + fr) * 144 + ks * 64 + fq * 16);
        bf16_t* dst = HST + (size_t)item * 16384 + fr * 128 + 16 * wave + 4 * fq;
#pragma unroll
        for (int mt = 0; mt < 8; ++mt) { f32x4 acc = (f32x4){0.f, 0.f, 0.f, 0.f};
#pragma unroll
            for (int ks = 0; ks < 2; ++ks) { const bf16x8 af = *(const bf16x8*)(Vt + (16 * mt + fr) * 144 + ks * 64 + fq * 16); acc = __builtin_amdgcn_mfma_f32_16x16x32_bf16(bfr[ks], af, acc, 0, 0, 0); }
            { u32x2 w2; w2.x = (unsigned)f2bf(acc[0]) | ((unsigned)f2bf(acc[1]) << 16); w2.y = (unsigned)f2bf(acc[2]) | ((unsigned)f2bf(acc[3]) << 16);
              *(u32x2*)(dst + (size_t)(16 * mt) * 128) = w2; } }
    }
    __syncthreads();
}

__device__ __forceinline__ void hgrn_p2(bf16_t* __restrict__ HST, const float* __restrict__ HDEC) {
    int tid = threadIdx.x; asm volatile("" : "+v"(tid));
    for (int gid = blockIdx.x * 512 + tid; gid < 131072; gid += gridDim.x * 512) {
        const int bh = gid >> 13, off = (gid & 8191) * 2, k = off & 127;
        f32x2 st = (f32x2){0.f, 0.f};
        bf16_t* hp = HST + (size_t)bh * 64 * 16384 + off; const float* dp = HDEC + (size_t)bh * 64 * 128 + k;
#pragma unroll 1
        for (int c0 = 0; c0 < 64; c0 += 16) {
            f32x2 d[16]; unsigned kv[16];
#pragma unroll
            for (int u = 0; u < 16; ++u) { d[u] = *(const f32x2*)(dp + (size_t)(c0 + u) * 128); kv[u] = *(const unsigned*)(hp + (size_t)(c0 + u) * 16384); }
#pragma unroll
            for (int u = 0; u < 16; ++u) { st = st * d[u] + (f32x2){bflo(kv[u]), bfhi(kv[u])}; kv[u] = cvt_pk_bf16(st[0], st[1]); }
#pragma unroll
            for (int u = 0; u < 16; ++u) *(unsigned*)(hp + (size_t)(c0 + u) * 16384) = kv[u];
        }
    }
}

__device__ __forceinline__ void hgrn_p3(int item, const bf16_t* __restrict__ proj, const float* __restrict__ lbp, int j, const bf16_t* __restrict__ HST, const float* __restrict__ ogain, bf16_t* __restrict__ ycat, unsigned char* smb) {
    int tid = threadIdx.x; asm volatile("" : "+v"(tid));
    const int wave = tid >> 6, lane = tid & 63, fr = lane & 15, fq = lane >> 4;
    const int c = item & 63, h = (item >> 6) & 7, b = item >> 9;
    const size_t tok0 = (size_t)b * SEQ + c * 64;
    float* FB = (float*)smb; float* FQ = FB + 8704; float* FK = FQ + 8704;
    unsigned char* SC = smb + 3 * 34816; unsigned char* Vt = SC + 9216; float* RED = (float*)(Vt + 18432);
    unsigned char* Pt = (unsigned char*)FK; unsigned char* QEb = (unsigned char*)FB;
    u32x4 pre[4];
#pragma unroll
    for (int i = 0; i < 4; ++i) pre[i] = (u32x4){0u, 0u, 0u, 0u};
    u32x2 graw[4];
#pragma unroll
    for (int mt = 0; mt < 4; ++mt) graw[mt] = *(const u32x2*)(proj + (tok0 + 16 * mt + fr) * 5120 + 4096 + h * 128 + 16 * wave + 4 * fq);
    if (c > 0) { const bf16_t* P = HST + (size_t)(item - 1) * 16384;
#pragma unroll
        for (int i = 0; i < 4; ++i) pre[i] = __builtin_nontemporal_load((const u32x4*)(P + (size_t)(tid + i * 512) * 8)); }
    for (int ra = 0; ra < ((H3REP & 1) ? 3 : 1); ++ra) {
    {
        const int kg = tid & 15;
#pragma unroll
        for (int i = 0; i < 2; ++i) { const int t = (tid + i * 512) >> 4;
            const bf16_t* rowp = proj + (tok0 + t) * 5120 + h * 128 + kg * 8;
            const u32x4 qw = *(const u32x4*)(rowp + 1024), fw = *(const u32x4*)(rowp + 2048), vw = *(const u32x4*)(rowp + 3072);
            float q[8], f[8]; unpack8(qw, q); unpack8(fw, f);
            float lg[8], kk[8], qs[8];
#pragma unroll
            for (int jj = 0; jj < 8; ++jj) { const float lb = hgrn_lb(lbp, j, h * 128 + kg * 8 + jj); const float fg = lb + (1.0f - lb) * sigmoidf_(f[jj]);
                lg[jj] = __log2f(fg); kk[jj] = 1.0f - fg; qs[jj] = q[jj] * sigmoidf_(q[jj]); }
            *(f32x4*)(FB + t * 132 + kg * 8) = (f32x4){lg[0], lg[1], lg[2], lg[3]}; *(f32x4*)(FB + t * 132 + kg * 8 + 4) = (f32x4){lg[4], lg[5], lg[6], lg[7]};
            *(f32x4*)(FQ + t * 132 + kg * 8) = (f32x4){qs[0], qs[1], qs[2], qs[3]}; *(f32x4*)(FQ + t * 132 + kg * 8 + 4) = (f32x4){qs[4], qs[5], qs[6], qs[7]};
            *(f32x4*)(FK + t * 132 + kg * 8) = (f32x4){kk[0], kk[1], kk[2], kk[3]}; *(f32x4*)(FK + t * 132 + kg * 8 + 4) = (f32x4){kk[4], kk[5], kk[6], kk[7]};
            unsigned short* vcol = (unsigned short*)(Vt + (kg * 8) * 144 + t * 2);
            vcol[0 * 72] = (unsigned short)(vw.x & 0xffffu); vcol[1 * 72] = (unsigned short)(vw.x >> 16); vcol[2 * 72] = (unsigned short)(vw.y & 0xffffu); vcol[3 * 72] = (unsigned short)(vw.y >> 16);
            vcol[4 * 72] = (unsigned short)(vw.z & 0xffffu); vcol[5 * 72] = (unsigned short)(vw.z >> 16); vcol[6 * 72] = (unsigned short)(vw.w & 0xffffu); vcol[7 * 72] = (unsigned short)(vw.w >> 16); }
    }
    __syncthreads();
    hgrn_cumsum(FB, 132, 1, tid);
    }
    for (int rb = 0; rb < ((H3REP & 2) ? 3 : 1); ++rb) {
    if (wave < 6) {
        const int I = wave < 1 ? 1 : wave < 3 ? 2 : 3, J = wave < 1 ? 0 : wave < 3 ? wave - 1 : wave - 3;
        const float* bt = FB + (16 * I + fr) * 132, *qt = FQ + (16 * I + fr) * 132, *be = FB + (16 * J + 15) * 132, *bs = FB + (16 * J + fr) * 132, *ks_ = FK + (16 * J + fr) * 132;
        f32x4 acc = (f32x4){0.f, 0.f, 0.f, 0.f};
#pragma unroll
        for (int ks = 0; ks < 4; ++ks) { const int k0 = ks * 32 + fq * 8; float av[8], bv[8];
#pragma unroll
            for (int hh = 0; hh < 2; ++hh) { const f32x4 b4 = *(const f32x4*)(bt + k0 + 4 * hh), q4 = *(const f32x4*)(qt + k0 + 4 * hh), e4 = *(const f32x4*)(be + k0 + 4 * hh), s4 = *(const f32x4*)(bs + k0 + 4 * hh), k4 = *(const f32x4*)(ks_ + k0 + 4 * hh);
#pragma unroll
                for (int e = 0; e < 4; ++e) { av[4 * hh + e] = q4[e] * ex2(b4[e] - e4[e]); bv[4 * hh + e] = k4[e] * ex2(e4[e] - s4[e]); } }
            u32x4 aw, bw; aw.x = cvt_pk_bf16(av[0], av[1]); aw.y = cvt_pk_bf16(av[2], av[3]); aw.z = cvt_pk_bf16(av[4], av[5]); aw.w = cvt_pk_bf16(av[6], av[7]);
            bw.x = cvt_pk_bf16(bv[0], bv[1]); bw.y = cvt_pk_bf16(bv[2], bv[3]); bw.z = cvt_pk_bf16(bv[4], bv[5]); bw.w = cvt_pk_bf16(bv[6], bv[7]);
            acc = __builtin_amdgcn_mfma_f32_16x16x32_bf16(__builtin_bit_cast(bf16x8, aw), __builtin_bit_cast(bf16x8, bw), acc, 0, 0, 0); }
#pragma unroll
        for (int e = 0; e < 4; ++e) *(unsigned short*)(SC + (16 * I + 4 * fq + e) * 144 + (16 * J + fr) * 2) = f2bf(acc[e]);
    } else {
#pragma unroll
        for (int u = 0; u < 3; ++u) { const int id = (wave - 6) * 3 + u; const int I = id < 3 ? 0 : id < 5 ? 1 : 2, J = id < 3 ? id + 1 : id < 5 ? id - 1 : 3;
#pragma unroll
            for (int e = 0; e < 4; ++e) *(unsigned short*)(SC + (16 * I + 4 * fq + e) * 144 + (16 * J + fr) * 2) = (unsigned short)0; }
    }
    {
        const int I = lane >> 4, ks16 = lane & 15;
#pragma unroll
        for (int half = 0; half < 2; ++half) { const int tl = half == 0 ? wave : 15 - wave; const int t = 16 * I + tl;
            const float* qrow = FQ + t * 132 + 8 * ks16;
            const f32x4 q0v = *(const f32x4*)qrow, q1v = *(const f32x4*)(qrow + 4);
            float part[16]; f32x4 w0 = (f32x4){1.f, 1.f, 1.f, 1.f}, w1 = w0;
#pragma unroll
            for (int sl = 15; sl >= 0; --sl) { part[sl] = 0.f;
                if (sl <= tl) { const float* krow = FK + (16 * I + sl) * 132 + 8 * ks16;
                    const f32x4 k0 = *(const f32x4*)krow, k1 = *(const f32x4*)(krow + 4);
                    float av = 0.f;
#pragma unroll
                    for (int e = 0; e < 4; ++e) { av += q0v[e] * k0[e] * w0[e]; av += q1v[e] * k1[e] * w1[e]; w0[e] *= 1.0f - k0[e]; w1[e] *= 1.0f - k1[e]; }
                    part[sl] = av; } }
#pragma unroll
            for (int i = 0; i < 8; ++i) { const bool hi = (ks16 & 8) != 0; const float send = hi ? part[i] : part[i + 8], keep = hi ? part[i + 8] : part[i]; part[i] = keep + __shfl_xor(send, 8); }
#pragma unroll
            for (int i = 0; i < 4; ++i) { const bool hi = (ks16 & 4) != 0; const float send = hi ? part[i] : part[i + 4], keep = hi ? part[i + 4] : part[i]; part[i] = keep + __shfl_xor(send, 4); }
#pragma unroll
            for (int i = 0; i < 2; ++i) { const bool hi = (ks16 & 2) != 0; const float send = hi ? part[i] : part[i + 2], keep = hi ? part[i + 2] : part[i]; part[i] = keep + __shfl_xor(send, 2); }
            { const bool hi = (ks16 & 1) != 0; const float send = hi ? part[0] : part[1], keep = hi ? part[1] : part[0]; part[0] = keep + __shfl_xor(send, 1); }
            *(unsigned short*)(SC + t * 144 + (16 * I + ks16) * 2) = f2bf(part[0]); }
    }
    __syncthreads();
    }
    for (int rc = 0; rc < ((H3REP & 4) ? 3 : 1); ++rc) {
    u32x4 qe[2];
    { const int kg = tid & 15;
#pragma unroll
      for (int i = 0; i < 2; ++i) { const int t = (tid + i * 512) >> 4; const float* bp = FB + t * 132 + kg * 8, *qp = FQ + t * 132 + kg * 8;
          const f32x4 b0 = *(const f32x4*)bp, b1 = *(const f32x4*)(bp + 4), q0 = *(const f32x4*)qp, q1 = *(const f32x4*)(qp + 4);
          qe[i].x = cvt_pk_bf16(q0[0] * ex2(b0[0]), q0[1] * ex2(b0[1])); qe[i].y = cvt_pk_bf16(q0[2] * ex2(b0[2]), q0[3] * ex2(b0[3]));
          qe[i].z = cvt_pk_bf16(q1[0] * ex2(b1[0]), q1[1] * ex2(b1[1])); qe[i].w = cvt_pk_bf16(q1[2] * ex2(b1[2]), q1[3] * ex2(b1[3])); } }
    __syncthreads();
#pragma unroll
    for (int i = 0; i < 4; ++i) { const int idx = tid + i * 512; const int v = idx >> 4, k8 = idx & 15; *(u32x4*)(Pt + v * 272 + k8 * 16) = pre[i]; }
    { const int kg = tid & 15;
#pragma unroll
      for (int i = 0; i < 2; ++i) { const int t = (tid + i * 512) >> 4; *(u32x4*)(QEb + t * 272 + kg * 16) = qe[i]; } }
    __syncthreads();
    f32x4 o[4];
    {
        bf16x8 bv[2], bp[4];
#pragma unroll
        for (int ks = 0; ks < 2; ++ks) bv[ks] = *(const bf16x8*)(Vt + (16 * wave + fr) * 144 + ks * 64 + fq * 16);
#pragma unroll
        for (int ks = 0; ks < 4; ++ks) bp[ks] = *(const bf16x8*)(Pt + (16 * wave + fr) * 272 + ks * 64 + fq * 16);
#pragma unroll
        for (int mt = 0; mt < 4; ++mt) { f32x4 acc = (f32x4){0.f, 0.f, 0.f, 0.f};
#pragma unroll
            for (int ks = 0; ks < 2; ++ks) { const bf16x8 af = *(const bf16x8*)(SC + (16 * mt + fr) * 144 + ks * 64 + fq * 16); acc = __builtin_amdgcn_mfma_f32_16x16x32_bf16(bv[ks], af, acc, 0, 0, 0); }
#pragma unroll
            for (int ks = 0; ks < 4; ++ks) { const bf16x8 af = *(const bf16x8*)(QEb + (16 * mt + fr) * 272 + ks * 64 + fq * 16); acc = __builtin_amdgcn_mfma_f32_16x16x32_bf16(bp[ks], af, acc, 0, 0, 0); }
            o[mt] = acc;
            float ssq = acc[0] * acc[0] + acc[1] * acc[1] + acc[2] * acc[2] + acc[3] * acc[3]; ssq += __shfl_xor(ssq, 16); ssq += __shfl_xor(ssq, 32);
            if (fq == 0) RED[wave * 64 + 16 * mt + fr] = ssq; }
    }
    __syncthreads();
    {
        const int v0 = 16 * wave + 4 * fq; const f32x4 gn = *(const f32x4*)(ogain + v0);
#pragma unroll
        for (int mt = 0; mt < 4; ++mt) { const int t = 16 * mt + fr; float tot = 0.f;
#pragma unroll
            for (int w = 0; w < 8; ++w) tot += RED[w * 64 + t];
            const float r = rsqrtf(tot * (1.0f / 128.0f) + 1e-6f);
            const size_t tok = tok0 + t;
            const float g0 = bflo(graw[mt].x), g1 = bfhi(graw[mt].x), g2 = bflo(graw[mt].y), g3 = bfhi(graw[mt].y);
            u32x2 w2; w2.x = cvt_pk_bf16(o[mt][0] * r * gn[0] * g0 * sigmoidf_(g0), o[mt][1] * r * gn[1] * g1 * sigmoidf_(g1));
            w2.y = cvt_pk_bf16(o[mt][2] * r * gn[2] * g2 * sigmoidf_(g2), o[mt][3] * r * gn[3] * g3 * sigmoidf_(g3));
            *(u32x2*)(ycat + tok * 2048 + 1024 + h * 128 + v0) = w2; }
    }
    __syncthreads();
    }
    __syncthreads();
}

__device__ __forceinline__ float gelu_tanh(float y) { const float z = 0.7978845608028654f * (y + 0.044715f * y * y * y); const float e = __expf(2.0f * z); return y * (1.0f - __builtin_amdgcn_rcpf(1.0f + e)); }
__device__ __forceinline__ bf16x8 pack8(const f32x4 a, const f32x4 b, float sgn) {
    u32x4 w; w.x = cvt_pk_bf16(a[0] * sgn, a[1] * sgn); w.y = cvt_pk_bf16(a[2] * sgn, a[3] * sgn); w.z = cvt_pk_bf16(b[0] * sgn, b[1] * sgn); w.w = cvt_pk_bf16(b[2] * sgn, b[3] * sgn); return __builtin_bit_cast(bf16x8, w);
}
template <bool FINAL>
__device__ __forceinline__ void s5_pass(int item, const bf16_t* __restrict__ proj, const float* __restrict__ S5A, const float* __restrict__ S5B, float* __restrict__ S5F,
                                        const float* __restrict__ c_re, const float* __restrict__ c_im, const float* __restrict__ dsk, bf16_t* __restrict__ ys5, unsigned char* smb) {
    int tid = threadIdx.x; asm volatile("" : "+v"(tid));
    const int wave = tid >> 6, lane = tid & 63, fr = lane & 15, fq = lane >> 4;
    const int sg = item & 7, g = (item >> 3) & 63, b = item >> 9;
    const int seg = sg * 8 + wave; const size_t tok0 = (size_t)b * SEQ + seg * 64;
    float* Bu = (float*)(smb + wave * 12800);
    unsigned char* X = smb + wave * 12800 + 8448;
    const bf16x8 zero8 = __builtin_bit_cast(bf16x8, (u32x4){0u, 0u, 0u, 0u});
    bf16x8 af[8], uf[4];
#pragma unroll
    for (int mt = 0; mt < 8; ++mt) { af[mt] = zero8;
        if (fq < 2) { const int pp = 16 * mt + fr; const float* src = S5B + (size_t)(g * 64 + (pp & 63)) * 32 + (pp >> 6) * 16 + fq * 8; af[mt] = pack8(*(const f32x4*)src, *(const f32x4*)(src + 4), 1.0f); } }
#pragma unroll
    for (int blk = 0; blk < 4; ++blk) { uf[blk] = zero8;
        if (fq < 2) uf[blk] = *(const bf16x8*)(proj + (tok0 + 16 * blk + fr) * 5120 + g * 16 + fq * 8); }
    const float ar = S5A[(g * 64 + lane) * 2], ai = S5A[(g * 64 + lane) * 2 + 1];
    float xr = 0.f, xi = 0.f;
    bf16x8 cf[4]; float dv = 0.f; unsigned short uraw[16];
    if (FINAL) {
#pragma unroll
        for (int q = 0; q < 16; ++q) uraw[q] = proj[(tok0 + 16 * (q >> 2) + 4 * fq + (q & 3)) * 5120 + g * 16 + fr];
        const f32x2 cin = *(const f32x2*)(S5F + ((size_t)((b * 64 + g) * 64 + seg) * 64 + lane) * 2); xr = cin[0]; xi = cin[1];
#pragma unroll
        for (int ks = 0; ks < 4; ++ks) { const float* src = (ks < 2 ? c_re : c_im) + (size_t)g * 1024 + fr * 64 + ((ks & 1) * 32 + fq * 8); cf[ks] = pack8(*(const f32x4*)src, *(const f32x4*)(src + 4), ks < 2 ? 1.0f : -1.0f); }
        dv = dsk[g * 16 + fr];
    }
#pragma unroll
    for (int blk = 0; blk < 4; ++blk) {
#pragma unroll
        for (int mt = 0; mt < 8; ++mt) { const f32x4 acc = __builtin_amdgcn_mfma_f32_16x16x32_bf16(af[mt], uf[blk], (f32x4){0.f, 0.f, 0.f, 0.f}, 0, 0, 0); *(f32x4*)(Bu + fr * 132 + 16 * mt + 4 * fq) = acc; }
        __syncthreads();
#pragma unroll
        for (int t = 0; t < 16; ++t) { const float bur = Bu[t * 132 + lane], bui = Bu[t * 132 + 64 + lane];
            const float nxr = ar * xr - ai * xi + bur, nxi = ar * xi + ai * xr + bui; xr = nxr; xi = nxi;
            if (FINAL) { *(unsigned short*)(X + t * 272 + lane * 2) = f2bf(xr); *(unsigned short*)(X + t * 272 + 128 + lane * 2) = f2bf(xi); } }
        __syncthreads();
        if (FINAL) {
            f32x4 acc = (f32x4){0.f, 0.f, 0.f, 0.f};
#pragma unroll
            for (int ks = 0; ks < 4; ++ks) { const bf16x8 a = *(const bf16x8*)(X + fr * 272 + ks * 64 + fq * 16); acc = __builtin_amdgcn_mfma_f32_16x16x32_bf16(a, cf[ks], acc, 0, 0, 0); }
#pragma unroll
            for (int e = 0; e < 4; ++e) { const size_t tok = tok0 + 16 * blk + 4 * fq + e; const float u = bflo((unsigned)uraw[blk * 4 + e]);
                ys5[tok * 1024 + g * 16 + fr] = f2bf(gelu_tanh(acc[e] + dv * u)); }
        }
    }
    if (!FINAL) *(f32x2*)(S5F + ((size_t)((b * 64 + g) * 64 + seg) * 64 + lane) * 2) = (f32x2){xr, xi};
    __syncthreads();
}

#define WAVE_LDS_SYNC() do { asm volatile("s_waitcnt lgkmcnt(0)" ::: "memory"); __builtin_amdgcn_s_barrier(); asm volatile("" ::: "memory"); } while (0)
template <bool FINAL>
__device__ __forceinline__ void s5_wg(int bid, const bf16_t* __restrict__ proj, const float* __restrict__ S5A, const float* __restrict__ S5B, float* __restrict__ S5F,
                                      const float* __restrict__ c_re, const float* __restrict__ c_im, const float* __restrict__ dsk, bf16_t* __restrict__ ys5, unsigned char* smb) {
    int tid = threadIdx.x; asm volatile("" : "+v"(tid));
    const int wave = tid >> 6, lane = tid & 63, fr = lane & 15, fq = lane >> 4;
    const int g = bid >> 2, r0 = (bid & 3) * 4;
    float* Bu = (float*)(smb + wave * 12800);
    unsigned char* X = smb + wave * 12800 + 8448;
    const bf16x8 zero8 = __builtin_bit_cast(bf16x8, (u32x4){0u, 0u, 0u, 0u});
    bf16x8 af[8];
#pragma unroll
    for (int mt = 0; mt < 8; ++mt) { af[mt] = zero8;
        if (fq < 2) { const int pp = 16 * mt + fr; const float* src = S5B + (size_t)(g * 64 + (pp & 63)) * 32 + (pp >> 6) * 16 + fq * 8; af[mt] = pack8(*(const f32x4*)src, *(const f32x4*)(src + 4), 1.0f); } }
    const float ar = S5A[(g * 64 + lane) * 2], ai = S5A[(g * 64 + lane) * 2 + 1];
    bf16x8 cf[4]; f32x4 dv4 = (f32x4){0.f, 0.f, 0.f, 0.f};
    if (FINAL) {
#pragma unroll
        for (int ks = 0; ks < 4; ++ks) { const float* src = (ks < 2 ? c_re : c_im) + (size_t)g * 1024 + fr * 64 + ((ks & 1) * 32 + fq * 8); cf[ks] = pack8(*(const f32x4*)src, *(const f32x4*)(src + 4), ks < 2 ? 1.0f : -1.0f); }
        dv4 = *(const f32x4*)(dsk + g * 16 + 4 * fq);
    }
    bf16x8 ufb[2][4]; u32x2 urb[2][4]; f32x2 cinb[2];
#define S5_FETCH(k_, slot_) do { const int r_ = r0 + (k_); const int b_ = r_ >> 3, seg_ = (r_ & 7) * 8 + wave; const size_t tk_ = (size_t)b_ * SEQ + seg_ * 64; \
        _Pragma("unroll") for (int blk_ = 0; blk_ < 4; ++blk_) { ufb[slot_][blk_] = zero8; if (fq < 2) ufb[slot_][blk_] = *(const bf16x8*)(proj + (tk_ + 16 * blk_ + fr) * 5120 + g * 16 + fq * 8); } \
        if (FINAL) { _Pragma("unroll") for (int q_ = 0; q_ < 4; ++q_) urb[slot_][q_] = *(const u32x2*)(proj + (tk_ + 16 * q_ + fr) * 5120 + g * 16 + 4 * fq); \
            cinb[slot_] = *(const f32x2*)(S5F + ((size_t)((b_ * 64 + g) * 64 + seg_) * 64 + lane) * 2); } } while (0)
    S5_FETCH(0, 0);
#pragma unroll
    for (int k = 0; k < 4; ++k) {
        const int cur = k & 1;
        if (k < 3) S5_FETCH(k + 1, cur ^ 1);
        const int r = r0 + k; const int b = r >> 3, seg = (r & 7) * 8 + wave; const size_t tok0 = (size_t)b * SEQ + seg * 64;
        float xr = 0.f, xi = 0.f;
        if (FINAL) { xr = cinb[cur][0]; xi = cinb[cur][1]; }
#pragma unroll
        for (int blk = 0; blk < 4; ++blk) {
#pragma unroll
            for (int mt = 0; mt < 8; ++mt) { const f32x4 acc = __builtin_amdgcn_mfma_f32_16x16x32_bf16(af[mt], ufb[cur][blk], (f32x4){0.f, 0.f, 0.f, 0.f}, 0, 0, 0); *(f32x4*)(Bu + fr * 132 + 16 * mt + 4 * fq) = acc; }
            WAVE_LDS_SYNC();
#pragma unroll
            for (int t = 0; t < 16; ++t) { const float bur = Bu[t * 132 + lane], bui = Bu[t * 132 + 64 + lane];
                const float nxr = ar * xr - ai * xi + bur, nxi = ar * xi + ai * xr + bui; xr = nxr; xi = nxi;
                if (FINAL) { *(unsigned short*)(X + t * 272 + lane * 2) = f2bf(xr); *(unsigned short*)(X + t * 272 + 128 + lane * 2) = f2bf(xi); } }
            WAVE_LDS_SYNC();
            if (FINAL) {
                f32x4 acc = (f32x4){0.f, 0.f, 0.f, 0.f};
#pragma unroll
                for (int ks = 0; ks < 4; ++ks) { const bf16x8 a = *(const bf16x8*)(X + fr * 272 + ks * 64 + fq * 16); acc = __builtin_amdgcn_mfma_f32_16x16x32_bf16(cf[ks], a, acc, 0, 0, 0); }
                { const size_t tok = tok0 + 16 * blk + fr; const u32x2 uw = urb[cur][blk];
                  u32x2 w2; w2.x = cvt_pk_bf16(gelu_tanh(acc[0] + dv4[0] * bflo(uw.x)), gelu_tanh(acc[1] + dv4[1] * bfhi(uw.x)));
                  w2.y = cvt_pk_bf16(gelu_tanh(acc[2] + dv4[2] * bflo(uw.y)), gelu_tanh(acc[3] + dv4[3] * bfhi(uw.y)));
                  *(u32x2*)(ys5 + tok * 1024 + g * 16 + 4 * fq) = w2; }
                WAVE_LDS_SYNC();
            }
        }
        if (!FINAL) *(f32x2*)(S5F + ((size_t)((b * 64 + g) * 64 + seg) * 64 + lane) * 2) = (f32x2){xr, xi};
    }
#undef S5_FETCH
    __syncthreads();
}

__device__ __forceinline__ void s5_carry(float* __restrict__ S5F, const float* __restrict__ S5A) {
    int tid = threadIdx.x; asm volatile("" : "+v"(tid));
    for (int gid = blockIdx.x * 512 + tid; gid < 8192; gid += gridDim.x * 512) {
        const int p = gid & 63, bg = gid >> 6, g = bg & 63;
        float pr = S5A[(g * 64 + p) * 2], pi = S5A[(g * 64 + p) * 2 + 1];
#pragma unroll
        for (int q = 0; q < 6; ++q) { const float nr = pr * pr - pi * pi, ni = 2.0f * pr * pi; pr = nr; pi = ni; }
        float xr = 0.f, xi = 0.f;
        f32x2* F = (f32x2*)(S5F + ((size_t)bg * 64 * 64 + p) * 2);
#pragma unroll 1
        for (int s0 = 0; s0 < 64; s0 += 16) { f32x2 f[16];
#pragma unroll
            for (int u = 0; u < 16; ++u) f[u] = F[(size_t)(s0 + u) * 64];
#pragma unroll
            for (int u = 0; u < 16; ++u) { const f32x2 fin = f[u]; f[u] = (f32x2){xr, xi}; const float nr = pr * xr - pi * xi + fin[0], ni = pr * xi + pi * xr + fin[1]; xr = nr; xi = ni; }
#pragma unroll
            for (int u = 0; u < 16; ++u) F[(size_t)(s0 + u) * 64] = f[u];
        }
    }
}

__device__ __forceinline__ void attn_item(int item, const bf16_t* __restrict__ qkv, const float* __restrict__ qg, const float* __restrict__ kg, const float* __restrict__ sinks, bf16_t* __restrict__ ycat, unsigned char* smb) {
    int tid = threadIdx.x; asm volatile("" : "+v"(tid));
    const int wave = tid >> 6, lane = tid & 63, fr = lane & 15, fq = lane >> 4;
    const int qb = item & 63, kvh = (item >> 6) & 3, b = item >> 8;
    const int q0 = qb * 64; const size_t tokb = (size_t)b * SEQ;
    unsigned char* Ks = smb;
    unsigned char* Vt = smb + 192 * 144;
    const int hq = kvh * 8 + wave;
    u32x4 qraw[4][2];
#pragma unroll
    for (int i = 0; i < 4; ++i) { const bf16_t* qp = qkv + (tokb + q0 + 16 * i + fr) * 2560 + hq * 64 + fq * 8; qraw[i][0] = *(const u32x4*)qp; qraw[i][1] = *(const u32x4*)(qp + 32); }
#pragma unroll
    for (int i = 0; i < 3; ++i) { const int idx = tid + i * 512; const int kidx = idx >> 3, dg = idx & 7; const int s = q0 - 127 + kidx; const bool ok = (s >= 0) && (kidx < 191);
        u32x4 kw = (u32x4){0u, 0u, 0u, 0u}, vw = kw;
        if (ok) { const bf16_t* rp = qkv + (tokb + s) * 2560 + kvh * 64 + dg * 8; kw = *(const u32x4*)(rp + 2048); vw = *(const u32x4*)(rp + 2304); }
        float k[8]; unpack8(kw, k);
        float ss = 0.f;
#pragma unroll
        for (int jj = 0; jj < 8; ++jj) ss += k[jj] * k[jj];
        ss += __shfl_xor(ss, 1); ss += __shfl_xor(ss, 2); ss += __shfl_xor(ss, 4);
        const float r = rsqrtf(ss * (1.0f / 64.0f) + 1e-6f);
        const f32x4 g0 = *(const f32x4*)(kg + dg * 8), g1 = *(const f32x4*)(kg + dg * 8 + 4);
        u32x4 w; w.x = cvt_pk_bf16(k[0] * r * g0[0], k[1] * r * g0[1]); w.y = cvt_pk_bf16(k[2] * r * g0[2], k[3] * r * g0[3]); w.z = cvt_pk_bf16(k[4] * r * g1[0], k[5] * r * g1[1]); w.w = cvt_pk_bf16(k[6] * r * g1[2], k[7] * r * g1[3]);
        *(u32x4*)(Ks + kidx * 144 + dg * 16) = w;
        unsigned short* vcol = (unsigned short*)(Vt + (dg * 8) * 392 + kidx * 2);
        vcol[0 * 196] = (unsigned short)(vw.x & 0xffffu); vcol[1 * 196] = (unsigned short)(vw.x >> 16); vcol[2 * 196] = (unsigned short)(vw.y & 0xffffu); vcol[3 * 196] = (unsigned short)(vw.y >> 16);
        vcol[4 * 196] = (unsigned short)(vw.z & 0xffffu); vcol[5 * 196] = (unsigned short)(vw.z >> 16); vcol[6 * 196] = (unsigned short)(vw.w & 0xffffu); vcol[7 * 196] = (unsigned short)(vw.w >> 16); }
    const float slope2 = exp2f(-0.25f * (float)(hq + 1)) * LOG2E, sink2 = sinks[hq] * LOG2E;
    __syncthreads();
#pragma unroll
    for (int i = 0; i < 4; ++i) {
        bf16x8 qf[2];
        { const u32x4 w0 = qraw[i][0], w1 = qraw[i][1]; float f0[8], f1[8]; unpack8(w0, f0); unpack8(w1, f1);
          float ss = 0.f;
#pragma unroll
          for (int jj = 0; jj < 8; ++jj) ss += f0[jj] * f0[jj] + f1[jj] * f1[jj];
          ss += __shfl_xor(ss, 16); ss += __shfl_xor(ss, 32);
          const float r = rsqrtf(ss * (1.0f / 64.0f) + 1e-6f) * 0.125f * LOG2E;
          const f32x4 ga = *(const f32x4*)(qg + fq * 8), gb = *(const f32x4*)(qg + fq * 8 + 4), gc = *(const f32x4*)(qg + 32 + fq * 8), gd = *(const f32x4*)(qg + 32 + fq * 8 + 4);
          u32x4 a, c;
          a.x = cvt_pk_bf16(f0[0] * r * ga[0], f0[1] * r * ga[1]); a.y = cvt_pk_bf16(f0[2] * r * ga[2], f0[3] * r * ga[3]); a.z = cvt_pk_bf16(f0[4] * r * gb[0], f0[5] * r * gb[1]); a.w = cvt_pk_bf16(f0[6] * r * gb[2], f0[7] * r * gb[3]);
          c.x = cvt_pk_bf16(f1[0] * r * gc[0], f1[1] * r * gc[1]); c.y = cvt_pk_bf16(f1[2] * r * gc[2], f1[3] * r * gc[3]); c.z = cvt_pk_bf16(f1[4] * r * gd[0], f1[5] * r * gd[1]); c.w = cvt_pk_bf16(f1[6] * r * gd[2], f1[7] * r * gd[3]);
          qf[0] = __builtin_bit_cast(bf16x8, a); qf[1] = __builtin_bit_cast(bf16x8, c); }
        f32x4 sc[9];
#pragma unroll
        for (int jr = 0; jr < 9; ++jr) { const unsigned char* kp = Ks + (16 * (i + jr) + fr) * 144 + fq * 16;
            const bf16x8 k0 = *(const bf16x8*)kp, k1 = *(const bf16x8*)(kp + 64);
            f32x4 acc = (f32x4){0.f, 0.f, 0.f, 0.f};
            acc = __builtin_amdgcn_mfma_f32_16x16x32_bf16(k0, qf[0], acc, 0, 0, 0);
            acc = __builtin_amdgcn_mfma_f32_16x16x32_bf16(k1, qf[1], acc, 0, 0, 0);
            sc[jr] = acc; }
        float m = sink2;
        const float nb = -slope2 * (float)(fr + 127 - 4 * fq); const bool head = q0 < 128;
#pragma unroll
        for (int jr = 0; jr < 9; ++jr)
#pragma unroll
            for (int e = 0; e < 4; ++e) { const int dist = fr + 127 - 16 * jr - 4 * fq - e; const int kidx = 16 * (i + jr) + 4 * fq + e;
                bool valid = true;
                if (jr == 0) valid = dist < 128;
                if (jr == 8) valid = dist >= 0;
                if (head) valid = valid && (q0 - 127 + kidx >= 0);
                const float v = valid ? fmaf(slope2, (float)(16 * jr + e), sc[jr][e]) + nb : -1e30f; sc[jr][e] = v; m = fmaxf(m, v); }
        m = fmaxf(m, __shfl_xor(m, 16)); m = fmaxf(m, __shfl_xor(m, 32));
        float l = 0.f;
#pragma unroll
        for (int jr = 0; jr < 9; ++jr)
#pragma unroll
            for (int e = 0; e < 4; ++e) { const float pv = ex2(sc[jr][e] - m); sc[jr][e] = pv; l += pv; }
        l += __shfl_xor(l, 16); l += __shfl_xor(l, 32);
        l += ex2(sink2 - m);
        const float inv = 1.0f / l;
        bf16x8 pf[5];
#pragma unroll
        for (int pp = 0; pp < 5; ++pp) { u32x4 w; w.x = cvt_pk_bf16(sc[2 * pp][0], sc[2 * pp][1]); w.y = cvt_pk_bf16(sc[2 * pp][2], sc[2 * pp][3]);
            if (pp < 4) { w.z = cvt_pk_bf16(sc[2 * pp + 1][0], sc[2 * pp + 1][1]); w.w = cvt_pk_bf16(sc[2 * pp + 1][2], sc[2 * pp + 1][3]); } else { w.z = 0u; w.w = 0u; }
            pf[pp] = __builtin_bit_cast(bf16x8, w); }
#pragma unroll
        for (int nt = 0; nt < 4; ++nt) { f32x4 o = (f32x4){0.f, 0.f, 0.f, 0.f};
            const unsigned char* vp = Vt + (nt * 16 + fr) * 392 + (16 * i + 4 * fq) * 2;
#pragma unroll
            for (int pp = 0; pp < 5; ++pp) { u32x4 w; const u32x2 lo = *(const u32x2*)(vp + (2 * pp) * 32); w.x = lo.x; w.y = lo.y;
                if (pp < 4) { const u32x2 hi = *(const u32x2*)(vp + (2 * pp + 1) * 32); w.z = hi.x; w.w = hi.y; } else { w.z = 0u; w.w = 0u; }
                o = __builtin_amdgcn_mfma_f32_16x16x32_bf16(__builtin_bit_cast(bf16x8, w), pf[pp], o, 0, 0, 0); }
            u32x2 w2; w2.x = cvt_pk_bf16(o[0] * inv, o[1] * inv); w2.y = cvt_pk_bf16(o[2] * inv, o[3] * inv);
            *(u32x2*)(ycat + (tokb + q0 + 16 * i + fr) * 2048 + hq * 64 + nt * 16 + 4 * fq) = w2; }
    }
    __syncthreads();
}

#define XB_TMO      128
#define XB_XCNT(j)  (256  + 64 * (j))
#define XB_XSUB(j)  (1280 + 64 * (j))
#define XB_XGEN(j)  (2304 + 64 * (j))
#define XB_TOP      3328
#define XB_TOPGEN   3392
#define XCD_BAR_WORDS 3456
#define XB_SPIN_CAP (1u << 18)
__device__ __forceinline__ unsigned xb_ld(unsigned* p)              { return __hip_atomic_load(p, __ATOMIC_RELAXED, __HIP_MEMORY_SCOPE_AGENT); }
__device__ __forceinline__ unsigned xb_add(unsigned* p, unsigned v) { return __hip_atomic_fetch_add(p, v, __ATOMIC_RELAXED, __HIP_MEMORY_SCOPE_AGENT); }
__device__ __forceinline__ unsigned xb_xcc_id() { return (unsigned)__builtin_amdgcn_s_getreg((3 << 11) | 20) & 0xFu; }
#define XB_SPIN(cond, bar) do { unsigned _sp = 0; while (cond) { __builtin_amdgcn_s_sleep(1); \
    if ((++_sp & 255u) == 0u) { if (xb_ld(&(bar)[XB_TMO])) break; if (_sp > XB_SPIN_CAP) { atomicAdd(&(bar)[XB_TMO], 1u); break; } } } } while (0)
struct XcdBarrier { unsigned* bar; unsigned x; volatile LAS unsigned* st; };
__device__ __forceinline__ XcdBarrier xcd_barrier_post(unsigned* bar, volatile LAS unsigned* st) {
    XcdBarrier b; b.bar = bar; b.x = xb_xcc_id(); b.st = st;
    if (threadIdx.x == 0) (void)xb_add(&bar[XB_XCNT(b.x)], 1u);
    return b;
}
__device__ __forceinline__ void xcd_barrier_complete(unsigned* bar, unsigned x, unsigned& nloc, unsigned& nx) {
    const unsigned G = gridDim.x * gridDim.y * gridDim.z;
    unsigned sum, cnt, mine, sp = 0u;
    for (;;) {
        sum = 0u; cnt = 0u; mine = 0u;
#pragma unroll
        for (unsigned j = 0; j < 16; ++j) { const unsigned c = xb_ld(&bar[XB_XCNT(j)]); sum += c; cnt += (c > 0u) ? 1u : 0u; mine = (j == x) ? c : mine; }
        if (sum == G) break;
        __builtin_amdgcn_s_sleep(1);
        if ((++sp & 255u) == 0u) { if (xb_ld(&bar[XB_TMO])) break; if (sp > XB_SPIN_CAP) { atomicAdd(&bar[XB_TMO], 1u); break; } }
    }
    nloc = mine > 0u ? mine : 1u; nx = cnt > 0u ? cnt : 1u;
}
__device__ __forceinline__ void xcd_barrier(const XcdBarrier& b) {
    asm volatile("s_waitcnt vmcnt(0)" ::: "memory");
    __syncthreads();
    if (threadIdx.x == 0) {
        unsigned* bar = b.bar;
        __builtin_amdgcn_s_waitcnt(0);
        unsigned nloc = b.st[0], nx = b.st[1];
        if (nloc == 0u) { xcd_barrier_complete(bar, b.x, nloc, nx); b.st[0] = nloc; b.st[1] = nx; }
        const unsigned old = xb_add(&bar[XB_XSUB(b.x)], 1u);
        const unsigned gen = old / nloc;
        if (old + 1u == (gen + 1u) * nloc) {
            __builtin_amdgcn_fence(__ATOMIC_RELEASE, "agent");
            asm volatile("s_waitcnt vmcnt(0)" ::: "memory");
            const unsigned og = xb_add(&bar[XB_TOP], 1u);
            const unsigned tg = og / nx;
            if (og + 1u == (tg + 1u) * nx) xb_add(&bar[XB_TOPGEN], 1u);
            else XB_SPIN(xb_ld(&bar[XB_TOPGEN]) == tg, bar);
            __builtin_amdgcn_fence(__ATOMIC_ACQUIRE, "agent");
            xb_add(&bar[XB_XGEN(b.x)], 1u);
            asm volatile("s_waitcnt vmcnt(0)" ::: "memory");
        } else {
            XB_SPIN(xb_ld(&bar[XB_XGEN(b.x)]) == gen, bar);
            __builtin_amdgcn_fence(__ATOMIC_ACQUIRE, "agent");
            asm volatile("s_waitcnt vmcnt(0)" ::: "memory");
        }
    }
    __syncthreads();
}

struct Args { const float* in[25]; float* out; unsigned char* ws; int ph_lo, ph_hi; };

__global__ void __launch_bounds__(512, 2) mega(Args a) {
    extern __shared__ __attribute__((aligned(16))) unsigned char lds[];
    float* sm = (float*)lds;
    unsigned char* ws = a.ws;
    bf16_t* Win_t = (bf16_t*)(ws + WS_WIN); bf16_t* Wglu_t = (bf16_t*)(ws + WS_WGLU); bf16_t* WoE_t = (bf16_t*)(ws + WS_WOE); bf16_t* Wqkv_t = (bf16_t*)(ws + WS_WQKV);
    bf16_t* WoO_t = (bf16_t*)(ws + WS_WOO); bf16_t* Wup_t = (bf16_t*)(ws + WS_WUP); bf16_t* Wdn_t = (bf16_t*)(ws + WS_WDN);
    bf16_t* XN = (bf16_t*)(ws + WS_XN); bf16_t* PROJ = (bf16_t*)(ws + WS_PROJ); bf16_t* YCAT = (bf16_t*)(ws + WS_YCAT); bf16_t* YS5 = (bf16_t*)(ws + WS_YS5); bf16_t* HID = (bf16_t*)(ws + WS_HID);
    bf16_t* HST = (bf16_t*)(ws + WS_HST); float* HDEC = (float*)(ws + WS_HDEC); float* S5F = (float*)(ws + WS_S5F); float* S5A = (float*)(ws + WS_S5A); float* S5B = (float*)(ws + WS_S5B); float* RS = (float*)(ws + WS_RS);
    const int G = gridDim.x, bid = blockIdx.x;
    if (threadIdx.x < 4) ((volatile LAS unsigned*)((LAS unsigned char*)lds + LDS_STAGE))[threadIdx.x] = 0u;
    __syncthreads();
    XcdBarrier xbar; xbar.bar = (unsigned*)(ws + WS_BAR); xbar.x = 0; xbar.st = nullptr;
    if (a.ph_hi - a.ph_lo > 1) xbar = xcd_barrier_post((unsigned*)(ws + WS_BAR), (volatile LAS unsigned*)((LAS unsigned char*)lds + LDS_STAGE));
    if (a.ph_lo > 1000) cg::this_grid().sync();

    for (int ph = a.ph_lo; ph < a.ph_hi; ++ph) {
      int nrep = 1;
      for (int rep = 0; rep < nrep; ++rep) {
        if (ph == 0) {
            if (REP_MASK & (1 << 11)) nrep = 2;
            for (int j = 0; j < 2; ++j) {
                transpose_cvt(a.in[2] + (size_t)j * 2048 * 5120, Win_t + (size_t)j * 5120 * 2048, 2048, 5120, sm, a.in[1] + (size_t)j * 2048, bid, G);
                transpose_cvt(a.in[11] + (size_t)j * 1024 * 1024, Wglu_t + (size_t)j * 1024 * 1024, 1024, 1024, sm, nullptr, bid, G);
                transpose_cvt(a.in[15] + (size_t)j * 2048 * 2048, WoE_t + (size_t)j * 2048 * 2048, 2048, 2048, sm, nullptr, bid, G);
                transpose_cvt(a.in[17] + (size_t)j * 2048 * 2560, Wqkv_t + (size_t)j * 2560 * 2048, 2048, 2560, sm, a.in[16] + (size_t)j * 2048, bid, G);
                transpose_cvt(a.in[21] + (size_t)j * 2048 * 2048, WoO_t + (size_t)j * 2048 * 2048, 2048, 2048, sm, nullptr, bid, G);
            }
            s5_params(a.in[3], a.in[4], a.in[5], a.in[6], a.in[7], S5A, S5B);
            x_stats_phase(a.in[0], XN, RS);
        } else {
            const int q = ph - 1, pair = q / 13, r = q % 13;
            const bool odd = r >= 8; const int layer = pair * 2 + (odd ? 1 : 0), j = pair; const int rr = odd ? r - 8 : r;
            int kind;
            if (!odd) kind = rr == 0 ? 1 : rr == 1 ? 2 : rr == 2 ? 3 : rr == 3 ? 4 : rr == 4 ? 5 : rr == 5 ? 6 : rr == 6 ? 8 : 9;
            else kind = rr == 0 ? 1 : rr == 1 ? 10 : rr == 2 ? 6 : rr == 3 ? 8 : 9;
            if ((REP_MASK >> kind) & 1) nrep = 2;
            switch (kind) {
            case 1: case 8: {
                pg8::Gemm g; pg8::EpiBf16 E; const float* rs;
                float* RL = (float*)(lds + 131072);
                if (kind == 8) { g = pg8::Gemm{XN, Wup_t + (size_t)layer * 8192 * 2048, T, 8192, 2048}; E = pg8::EpiBf16{HID, 8192, 1, RL}; rs = RS + (size_t)(2 * layer + 1) * T * 32; }
                else if (!odd) { g = pg8::Gemm{XN, Win_t + (size_t)j * 5120 * 2048, T, 5120, 2048}; E = pg8::EpiBf16{PROJ, 5120, 0, RL}; rs = RS + (size_t)(2 * layer) * T * 32; }
                else { g = pg8::Gemm{XN, Wqkv_t + (size_t)j * 2560 * 2048, T, 2560, 2048}; E = pg8::EpiBf16{PROJ, 2560, 0, RL}; rs = RS + (size_t)(2 * layer) * T * 32; }
                pg8::StaticOrder S; S.init(g.M, g.N, G, bid);
                { int tid = threadIdx.x; asm volatile("" : "+v"(tid));
#pragma unroll
                  for (int i0 = 0; i0 < 4; i0 += 2) { const int i = i0 + (tid >> 8); pg8::Unit u;
                      if (S.next(i, u)) { const float* rp = rs + (size_t)(u.pm * 256 + (tid & 255)) * 32; f32x4 t4 = *(const f32x4*)rp;
#pragma unroll
                          for (int q4 = 1; q4 < 8; ++q4) t4 = t4 + *(const f32x4*)(rp + 4 * q4);
                          RL[i * 256 + (tid & 255)] = rsqrtf(((t4[0] + t4[1]) + (t4[2] + t4[3])) * (1.0f / 2048.0f) + 1e-6f); } }
                  __syncthreads(); }
                pg8::gemm_phase<pg8::EpiBf16, true, GEMM_SP2>((LAS unsigned char*)lds, g, S, E);
                if (kind == 1 && rep == 0) {
                    const int nfull = S.nwg % G;
                    if (nfull != 0 && bid >= nfull) {
                        __syncthreads();
                        transpose_cvt(a.in[23] + (size_t)layer * 2048 * 8192, Wup_t + (size_t)layer * 8192 * 2048, 2048, 8192, sm, a.in[22] + (size_t)layer * 2048, bid - nfull, G - nfull);
                        if (odd) transpose_cvt(a.in[24] + (size_t)layer * 8192 * 2048, Wdn_t + (size_t)layer * 2048 * 8192, 8192, 2048, sm, nullptr, bid - nfull, G - nfull);
                    } else if (nfull == 0 && !odd) { __syncthreads(); transpose_cvt(a.in[23] + (size_t)layer * 2048 * 8192, Wup_t + (size_t)layer * 8192 * 2048, 2048, 8192, sm, a.in[22] + (size_t)layer * 2048, bid, G); }
                    else if (nfull == 0) { __syncthreads(); transpose_cvt(a.in[23] + (size_t)layer * 2048 * 8192, Wup_t + (size_t)layer * 8192 * 2048, 2048, 8192, sm, a.in[22] + (size_t)layer * 2048, bid, G);
                        transpose_cvt(a.in[24] + (size_t)layer * 8192 * 2048, Wdn_t + (size_t)layer * 2048 * 8192, 8192, 2048, sm, nullptr, bid, G); }
                }
            } break;
            case 5: {
                pg8::Gemm g{YS5, Wglu_t + (size_t)j * 1024 * 1024, T, 1024, 1024}; pg8::EpiGlu E{YS5, a.in[12] + (size_t)j * 1024, YCAT, 2048};
                pg8::StaticOrder S; S.init(g.M, g.N, G, bid);
                pg8::gemm_phase<pg8::EpiGlu, false, GEMM_SP2>((LAS unsigned char*)lds, g, S, E);
                if (rep == 0) { const int nfull = S.nwg < G ? S.nwg : 0;
                    __syncthreads();
                    if (nfull != 0) { if (bid >= nfull) transpose_cvt(a.in[24] + (size_t)layer * 8192 * 2048, Wdn_t + (size_t)layer * 2048 * 8192, 8192, 2048, sm, nullptr, bid - nfull, G - nfull); }
                    else transpose_cvt(a.in[24] + (size_t)layer * 8192 * 2048, Wdn_t + (size_t)layer * 2048 * 8192, 8192, 2048, sm, nullptr, bid, G); }
            } break;
            case 6: case 9: {
                pg8::Gemm g;
                if (kind == 9) g = pg8::Gemm{HID, Wdn_t + (size_t)layer * 2048 * 8192, T, 2048, 8192};
                else g = pg8::Gemm{YCAT, (odd ? WoO_t : WoE_t) + (size_t)j * 2048 * 2048, T, 2048, 2048};
                const int slot = kind == 9 ? 2 * layer + 2 : 2 * layer + 1;
                pg8::EpiResid E{XN, RS + (size_t)slot * T * 32, (kind == 9 && layer == 3) ? a.out : (float*)nullptr};
                pg8::StaticOrder S; S.init(g.M, g.N, G, bid);
                pg8::gemm_phase<pg8::EpiResid, false, GEMM_SP2>((LAS unsigned char*)lds, g, S, E);
            } break;
            case 2:
                for (int r2 = 0; r2 < ((REP2 & 8) ? 2 : 1); ++r2) for (int it = bid; it < 1024; it += G) hgrn_p1(it, PROJ, a.in[13], j, HST, HDEC, lds);
                if (G == 256) s5_wg<false>(bid, PROJ, S5A + (size_t)j * 8192, S5B + (size_t)j * 131072, S5F, nullptr, nullptr, nullptr, nullptr, lds);
                else for (int r2 = 0; r2 < ((REP2 & 16) ? 2 : 1); ++r2) for (int it = bid; it < 1024; it += G) s5_pass<false>(it, PROJ, S5A + (size_t)j * 8192, S5B + (size_t)j * 131072, S5F, nullptr, nullptr, nullptr, nullptr, lds);
                break;
            case 3: hgrn_p2(HST, HDEC); s5_carry(S5F, S5A + (size_t)j * 8192); break;
            case 4:
                for (int r2 = 0; r2 < ((REP2 & 1) ? 2 : 1); ++r2) for (int it = bid; it < 1024; it += G) hgrn_p3(it, PROJ, a.in[13], j, HST, a.in[14] + (size_t)j * 128, YCAT, lds);
                if (G == 256) s5_wg<true>(bid, PROJ, S5A + (size_t)j * 8192, S5B + (size_t)j * 131072, S5F, a.in[8] + (size_t)j * 65536, a.in[9] + (size_t)j * 65536, a.in[10] + (size_t)j * 1024, YS5, lds);
                else for (int r2 = 0; r2 < ((REP2 & 2) ? 2 : 1); ++r2) for (int it = bid; it < 1024; it += G) s5_pass<true>(it, PROJ, S5A + (size_t)j * 8192, S5B + (size_t)j * 131072, S5F, a.in[8] + (size_t)j * 65536, a.in[9] + (size_t)j * 65536, a.in[10] + (size_t)j * 1024, YS5, lds);
                break;
            case 10:
                for (int it = bid; it < 512; it += G) attn_item(it, PROJ, a.in[18] + (size_t)j * 64, a.in[19] + (size_t)j * 64, a.in[20] + (size_t)j * 32, YCAT, lds);
                break;
            default: break;
            }
        }
      }
        if (ph + 1 < a.ph_hi) { xcd_barrier(xbar); if (REP2 & 4) xcd_barrier(xbar); }
    }
}

extern "C" void kernel_launch(void* const* d_in, const int* in_sizes, int n_in, void* d_out, int out_size, void* d_ws, size_t ws_size, hipStream_t stream) {
    static int grid = 0;
    if (grid == 0) {
        if (n_in != 25 || ws_size < WS_END) { fprintf(stderr, "kernel_launch: need 25 inputs and %zu bytes of workspace; got %d, %zu\n", (size_t)WS_END, n_in, ws_size); grid = -1; return; }
        int dev = 0, cus = 0, per_cu = 0;
        hipGetDevice(&dev); hipDeviceGetAttribute(&cus, hipDeviceAttributeMultiprocessorCount, dev);
        if (hipFuncSetAttribute((const void*)mega, hipFuncAttributeMaxDynamicSharedMemorySize, LDS_BYTES) != hipSuccess) { fprintf(stderr, "kernel_launch: hipFuncSetAttribute failed\n"); grid = -1; return; }
        if (hipOccupancyMaxActiveBlocksPerMultiprocessor(&per_cu, (const void*)mega, 512, LDS_BYTES) != hipSuccess || per_cu < 1) { fprintf(stderr, "kernel_launch: occupancy query says %d\n", per_cu); per_cu = 1; }
        (void)hipGetLastError();
        grid = cus > 0 ? cus : 256;
    }
    if (grid < 0) return;
    Args a{};
    for (int i = 0; i < 25; ++i) a.in[i] = (const float*)d_in[i];
    a.out = (float*)d_out; a.ws = (unsigned char*)d_ws;
#if MK_ONE_LAUNCH
    a.ph_lo = 0; a.ph_hi = NPH;
    if (hipMemsetAsync((unsigned char*)d_ws + WS_BAR, 0, (size_t)XCD_BAR_WORDS_C * 4, stream) != hipSuccess) { fprintf(stderr, "kernel_launch: memset failed\n"); return; }
    void* args[] = {&a};
    hipError_t e = hipLaunchCooperativeKernel((const void*)mega, dim3(grid), dim3(512), args, LDS_BYTES, stream);
    if (e != hipSuccess) fprintf(stderr, "kernel_launch: cooperative launch failed: %s (grid %d)\n", hipGetErrorString(e), grid);
#else
    for (int ph = 0; ph < NPH; ++ph) { a.ph_lo = ph; a.ph_hi = ph + 1; hipLaunchKernelGGL(mega, dim3(grid), dim3(512), LDS_BYTES, stream, a); }
#endif
}
```

```cpp
#include <hip/hip_runtime.h>
#include <hip/hip_cooperative_groups.h>
#include <cstdio>
namespace cg = cooperative_groups;

#ifndef REP_MASK
#define REP_MASK 0
#endif
#ifndef H3REP
#define H3REP 0
#endif
#ifndef REP2
#define REP2 0
#endif
#ifndef GEMM_SP2
#define GEMM_SP2 true
#endif
#ifndef MK_ONE_LAUNCH
#define MK_ONE_LAUNCH 1
#endif

#define LAS __attribute__((address_space(3)))
typedef unsigned short bf16_t;
typedef short bf16x8 __attribute__((ext_vector_type(8)));
typedef float f32x4 __attribute__((ext_vector_type(4)));
typedef float f32x2 __attribute__((ext_vector_type(2)));
typedef unsigned u32x4 __attribute__((ext_vector_type(4)));
typedef unsigned u32x2 __attribute__((ext_vector_type(2)));

constexpr int T = 8192, SEQ = 4096;
constexpr int NPH = 27;
constexpr int LDS_STAGE = 135168;
constexpr int LDS_BYTES = LDS_STAGE + 16;
constexpr int XCD_BAR_WORDS_C = 3456;
constexpr float LOG2E = 1.4426950408889634f;

constexpr size_t SZ_WIN = (size_t)5120 * 2048 * 2, SZ_WGLU = (size_t)1024 * 1024 * 2, SZ_WSQ = (size_t)2048 * 2048 * 2, SZ_WQKV = (size_t)2560 * 2048 * 2, SZ_WUP = (size_t)8192 * 2048 * 2;
constexpr size_t WS_WIN = 0;
constexpr size_t WS_WGLU = WS_WIN + 2 * SZ_WIN;
constexpr size_t WS_WOE = WS_WGLU + 2 * SZ_WGLU;
constexpr size_t WS_WQKV = WS_WOE + 2 * SZ_WSQ;
constexpr size_t WS_WOO = WS_WQKV + 2 * SZ_WQKV;
constexpr size_t WS_WUP = WS_WOO + 2 * SZ_WSQ;
constexpr size_t WS_WDN = WS_WUP + 4 * SZ_WUP;
constexpr size_t WS_XN = WS_WDN + 4 * SZ_WUP;
constexpr size_t WS_PROJ = WS_XN + (size_t)T * 2048 * 2;
constexpr size_t WS_YCAT = WS_PROJ + (size_t)T * 5120 * 2;
constexpr size_t WS_YS5 = WS_YCAT + (size_t)T * 2048 * 2;
constexpr size_t WS_HID = WS_YS5 + (size_t)T * 1024 * 2;
constexpr size_t WS_HST = WS_HID + (size_t)T * 8192 * 2;
constexpr size_t WS_HDEC = WS_HST + (size_t)16 * 64 * 16384 * 4;
constexpr size_t WS_S5F = WS_HDEC + (size_t)16 * 64 * 128 * 4;
constexpr size_t WS_S5A = WS_S5F + (size_t)128 * 64 * 64 * 2 * 4;
constexpr size_t WS_S5B = WS_S5A + (size_t)2 * 64 * 64 * 2 * 4;
constexpr size_t WS_RS = WS_S5B + (size_t)2 * 64 * 64 * 32 * 4;
constexpr size_t WS_BAR = WS_RS + (size_t)9 * T * 32 * 4;
constexpr size_t WS_END = WS_BAR + (size_t)XCD_BAR_WORDS_C * 4;


__device__ __forceinline__ unsigned cvt_pk_bf16(float lo, float hi) { unsigned r; asm volatile("v_cvt_pk_bf16_f32 %0, %1, %2" : "=v"(r) : "v"(lo), "v"(hi)); return r; }
__device__ __forceinline__ unsigned short f2bf(float f) { unsigned u = __builtin_bit_cast(unsigned, f); return (unsigned short)((u + 0x7fffu + ((u >> 16) & 1u)) >> 16); }
__device__ __forceinline__ float bflo(unsigned w) { return __builtin_bit_cast(float, w << 16); }
__device__ __forceinline__ float bfhi(unsigned w) { return __builtin_bit_cast(float, w & 0xffff0000u); }
__device__ __forceinline__ void unpack8(u32x4 w, float (&f)[8]) {
    f[0] = bflo(w.x); f[1] = bfhi(w.x); f[2] = bflo(w.y); f[3] = bfhi(w.y); f[4] = bflo(w.z); f[5] = bfhi(w.z); f[6] = bflo(w.w); f[7] = bfhi(w.w);
}
__device__ __forceinline__ float wave_sum(float v) {
#pragma unroll
    for (int o = 32; o > 0; o >>= 1) v += __shfl_xor(v, o);
    return v;
}
__device__ __forceinline__ float sigmoidf_(float x) { return __builtin_amdgcn_rcpf(1.0f + __expf(-x)); }
__device__ __forceinline__ float ex2(float x) { return __builtin_amdgcn_exp2f(x); }

namespace pg8 {
constexpr int BM = 256, BK = 64, HALF = 128, HTB = HALF * BK * 2, STAGE_BYTES = 8 * HTB, NXCD = 8, WGM = 8;
__device__ __forceinline__ int lds_byte(int r, int c) { const int st = (r >> 4) * 2 + (c >> 5), rr = r & 15, cc = c & 31, ob = rr * 64 + cc * 2; return st * 1024 + (ob ^ (((ob >> 9) & 1) << 5)); }
__device__ __forceinline__ void stage_rc(int b, int& R, int& C) { const int st = b / 1024, sb = b % 1024, swz = sb ^ (((sb >> 9) & 1) << 5); R = (st >> 1) * 16 + swz / 64; C = (st & 1) * 32 + (swz % 64) / 2; }
__device__ __forceinline__ int perm32(int rho) { const int n = rho >> 4, i = rho & 15; return 8 * (i >> 2) + 4 * n + (i & 3); }

struct Unit { int pm, pn; };
struct Gemm { const bf16_t* A; const bf16_t* Bt; int M, N, K; };

struct StaticOrder {
    int nM, nN, nwg, G, c;
    __device__ void init(int M, int N, int G_, int c_) { nM = M / BM; nN = N / BM; nwg = nM * nN; G = G_; c = c_; }
    __device__ bool next(int i, Unit& u) const {
        const long L = (long)i * G + c; if (L >= nwg) return false;
        int wgid = (int)L; { const int q = nwg / NXCD, r = nwg % NXCD, xcd = wgid % NXCD, off = wgid / NXCD; wgid = (xcd < r ? xcd * (q + 1) : r * (q + 1) + (xcd - r) * q) + off; }
        const int nig = WGM * nN, gid = wgid / nig, fm = gid * WGM, gsz = (nM - fm) < WGM ? (nM - fm) : WGM;
        u.pm = fm + ((wgid % nig) % gsz); u.pn = (wgid % nig) / gsz; return true;
    }
};

struct EpiBf16 {
    static constexpr bool PERM = true;
    bf16_t* O; int ldc; int act; const float* rl;
    __device__ __forceinline__ void operator()(const f32x4 (&acc)[2][2][4][2], const Unit& u, int ui, int wr, int wc, int fr, int fq) const {
        const int row0 = u.pm * BM + wr * 64 + fr, col0 = u.pn * BM + wc * 32 + 8 * fq;
#pragma unroll
        for (int ai = 0; ai < 2; ++ai)
#pragma unroll
            for (int m = 0; m < 4; ++m) { const int row = row0 + ai * HALF + m * 16; bf16_t* rowp = O + (size_t)row * ldc + col0;
                const float r = rl[ui * 256 + wr * 64 + fr + ai * HALF + m * 16];
#pragma unroll
                for (int bj = 0; bj < 2; ++bj) { f32x4 v0 = acc[ai][bj][m][0] * r, v1 = acc[ai][bj][m][1] * r;
                    if (act) {
#pragma unroll
                        for (int j = 0; j < 4; ++j) { float a = fmaxf(v0[j], 0.f), b = fmaxf(v1[j], 0.f); v0[j] = a * a; v1[j] = b * b; } }
                    u32x4 w; w.x = cvt_pk_bf16(v0[0], v0[1]); w.y = cvt_pk_bf16(v0[2], v0[3]); w.z = cvt_pk_bf16(v1[0], v1[1]); w.w = cvt_pk_bf16(v1[2], v1[3]);
                    *(u32x4*)(rowp + bj * HALF) = w; } }
    }
};
struct EpiGlu {
    static constexpr bool PERM = true;
    const bf16_t* Y; const float* bias; bf16_t* O; int ldo;
    __device__ __forceinline__ void operator()(const f32x4 (&acc)[2][2][4][2], const Unit& u, int ui, int wr, int wc, int fr, int fq) const {
        const int row0 = u.pm * BM + wr * 64 + fr, col0 = u.pn * BM + wc * 32 + 8 * fq;
        f32x4 bb[2][2];
#pragma unroll
        for (int bj = 0; bj < 2; ++bj) { bb[bj][0] = *(const f32x4*)(bias + col0 + bj * HALF); bb[bj][1] = *(const f32x4*)(bias + col0 + bj * HALF + 4); }
#pragma unroll
        for (int ai = 0; ai < 2; ++ai) { u32x4 yw[4][2];
#pragma unroll
            for (int m = 0; m < 4; ++m)
#pragma unroll
                for (int bj = 0; bj < 2; ++bj) yw[m][bj] = *(const u32x4*)(Y + (size_t)(row0 + ai * HALF + m * 16) * 1024 + col0 + bj * HALF);
#pragma unroll
            for (int m = 0; m < 4; ++m) { const int row = row0 + ai * HALF + m * 16;
#pragma unroll
                for (int bj = 0; bj < 2; ++bj) { const int col = col0 + bj * HALF; float y[8]; unpack8(yw[m][bj], y);
                    const f32x4 v0 = acc[ai][bj][m][0] + bb[bj][0], v1 = acc[ai][bj][m][1] + bb[bj][1]; float o[8];
#pragma unroll
                    for (int j = 0; j < 4; ++j) { o[j] = y[j] * sigmoidf_(v0[j]); o[4 + j] = y[4 + j] * sigmoidf_(v1[j]); }
                    u32x4 w; w.x = cvt_pk_bf16(o[0], o[1]); w.y = cvt_pk_bf16(o[2], o[3]); w.z = cvt_pk_bf16(o[4], o[5]); w.w = cvt_pk_bf16(o[6], o[7]);
                    *(u32x4*)(O + (size_t)row * ldo + col) = w; } } }
    }
};
struct EpiResid {
    static constexpr bool PERM = true;
    bf16_t* hb; float* rs; float* outf;
    __device__ __forceinline__ void operator()(const f32x4 (&acc)[2][2][4][2], const Unit& u, int ui, int wr, int wc, int fr, int fq) const {
        const int row0 = u.pm * BM + wr * 64 + fr, col0 = u.pn * BM + wc * 32 + 8 * fq;
#pragma unroll
        for (int ai = 0; ai < 2; ++ai) { u32x4 bv[4][2];
#pragma unroll
            for (int m = 0; m < 4; ++m)
#pragma unroll
                for (int bj = 0; bj < 2; ++bj) bv[m][bj] = *(const u32x4*)(hb + (size_t)(row0 + ai * HALF + m * 16) * 2048 + col0 + bj * HALF);
#pragma unroll
            for (int m = 0; m < 4; ++m) { const int row = row0 + ai * HALF + m * 16; const size_t ro = (size_t)row * 2048 + col0; float ss = 0.f;
#pragma unroll
                for (int bj = 0; bj < 2; ++bj) { const size_t o = ro + bj * HALF; float f[8]; unpack8(bv[m][bj], f);
                    const f32x4 v0 = (f32x4){f[0], f[1], f[2], f[3]} + acc[ai][bj][m][0], v1 = (f32x4){f[4], f[5], f[6], f[7]} + acc[ai][bj][m][1];
                    if (outf) { *(f32x4*)(outf + o) = v0; *(f32x4*)(outf + o + 4) = v1; }
                    else { u32x4 w; w.x = cvt_pk_bf16(v0[0], v0[1]); w.y = cvt_pk_bf16(v0[2], v0[3]); w.z = cvt_pk_bf16(v1[0], v1[1]); w.w = cvt_pk_bf16(v1[2], v1[3]); *(u32x4*)(hb + o) = w;
                        float r[8]; unpack8(w, r);
#pragma unroll
                        for (int q = 0; q < 8; ++q) ss += r[q] * r[q]; } }
                if (!outf) { ss += __shfl_xor(ss, 16); ss += __shfl_xor(ss, 32); if (fq == 0) rs[(size_t)row * 32 + u.pn * 4 + wc] = ss; } } }
    }
};

template <class Epi, bool ALIGN_EPI, bool SP2>
__device__ __forceinline__ void gemm_phase(LAS unsigned char* lds, const Gemm g, const StaticOrder& S, const Epi& E) {
    int tid = threadIdx.x; asm volatile("" : "+v"(tid));
    const int wid = __builtin_amdgcn_readfirstlane(tid >> 6), lane = tid & 63, wr = wid >> 2, wc = wid & 3, fr = lane & 15, fq = lane >> 4;
    const int K = g.K, nt = K / BK;
    unsigned voffA[2], voffB[2];
#pragma unroll
    for (int i = 0; i < 2; ++i) { int R, C; stage_rc(tid * 16 + i * 8192, R, C); const int Rb = Epi::PERM ? ((R & ~31) + perm32(R & 31)) : R;
        voffA[i] = (unsigned)(R * K + C) * 2u; voffB[i] = (unsigned)(Rb * K + C) * 2u; }
    const size_t kstep = (size_t)(BK * 2);
    const size_t hstep = (size_t)HALF * K * 2;
    const size_t tstep = 2 * hstep;
    const unsigned ldsw = (unsigned)wid * 1024u;
    const int aoff = lds_byte(wr * 64 + fr, fq * 8), boff = lds_byte(wc * 32 + fr, fq * 8);
#define PG8_SA(b, h) (((b) * 2 + (h)) * HTB)
#define PG8_SB(b, h) ((4 + (b) * 2 + (h)) * HTB)
#define PG8_STAGE(bufoff, gbase, voff) do { _Pragma("unroll") for (int _i = 0; _i < 2; ++_i) \
        __builtin_amdgcn_global_load_lds((const unsigned*)((const char*)(gbase) + (voff)[_i]), (LAS unsigned*)(lds + (bufoff) + ldsw + _i * 8192), 16, 0, 0); } while (0)
#define PG8_LDA(dst, b, h) do { _Pragma("unroll") for (int m = 0; m < 4; ++m) _Pragma("unroll") for (int k = 0; k < 2; ++k) dst[m][k] = *(const LAS bf16x8*)(lds + PG8_SA(b, h) + aoff + m * 2048 + k * 1024); } while (0)
#define PG8_LDB(dst, b, h) do { _Pragma("unroll") for (int n = 0; n < 2; ++n) _Pragma("unroll") for (int k = 0; k < 2; ++k) dst[n][k] = *(const LAS bf16x8*)(lds + PG8_SB(b, h) + boff + n * 2048 + k * 1024); } while (0)
#define PG8_MMA(ai, bj, At, Bt) do { __builtin_amdgcn_s_setprio(1); _Pragma("unroll") for (int m = 0; m < 4; ++m) _Pragma("unroll") for (int n = 0; n < 2; ++n) _Pragma("unroll") for (int k = 0; k < 2; ++k) \
        acc[ai][bj][m][n] = __builtin_amdgcn_mfma_f32_16x16x32_bf16(Bt[n][k], At[m][k], acc[ai][bj][m][n], 0, 0, 0); __builtin_amdgcn_s_setprio(0); } while (0)
#define PG8_WAIT_V(n) asm volatile("s_waitcnt vmcnt(" #n ")" ::: "memory")
#define PG8_WAIT_L(n) asm volatile("s_waitcnt lgkmcnt(" #n ")" ::: "memory")
#define PG8_BAR __builtin_amdgcn_s_barrier()
#define PG8_SCHED __builtin_amdgcn_sched_barrier(0)
    Unit cur, nxt; int ui = 0;
    if (!S.next(0, cur)) return;
    f32x4 acc[2][2][4][2];
#pragma unroll
    for (int a = 0; a < 2; ++a)
#pragma unroll
        for (int b = 0; b < 2; ++b)
#pragma unroll
            for (int m = 0; m < 4; ++m)
#pragma unroll
                for (int n = 0; n < 2; ++n) acc[a][b][m][n] = (f32x4){0.f, 0.f, 0.f, 0.f};
    bf16x8 At[4][2], B0[2][2], B1[2][2];
    const char* cA = (const char*)g.A + (size_t)cur.pm * tstep; const char* cB = (const char*)g.Bt + (size_t)cur.pn * tstep;
    if constexpr (SP2) {
        PG8_STAGE(PG8_SB(0, 0), cB, voffB); PG8_STAGE(PG8_SB(0, 1), cB + hstep, voffB); PG8_STAGE(PG8_SA(0, 0), cA, voffA); PG8_STAGE(PG8_SA(0, 1), cA + hstep, voffA);
        if (wr == 1) PG8_BAR;
        PG8_WAIT_V(2); PG8_BAR;
        PG8_STAGE(PG8_SB(1, 0), cB + kstep, voffB); PG8_STAGE(PG8_SA(1, 0), cA + kstep, voffA); PG8_STAGE(PG8_SB(1, 1), cB + hstep + kstep, voffB);
        PG8_WAIT_V(6); PG8_BAR;
    } else {
    PG8_STAGE(PG8_SB(0, 0), cB, voffB); PG8_STAGE(PG8_SA(0, 0), cA, voffA); PG8_STAGE(PG8_SB(0, 1), cB + hstep, voffB); PG8_STAGE(PG8_SA(0, 1), cA + hstep, voffA);
    if (wr == 1) PG8_BAR;
    PG8_WAIT_V(4); PG8_BAR;
    PG8_STAGE(PG8_SB(1, 0), cB + kstep, voffB); PG8_STAGE(PG8_SA(1, 0), cA + kstep, voffA); PG8_STAGE(PG8_SB(1, 1), cB + hstep + kstep, voffB);
    PG8_WAIT_V(6); PG8_BAR;
    }
    for (;;) {
        const bool has_next = S.next(ui + 1, nxt);
        const char* nA = has_next ? (const char*)g.A + (size_t)nxt.pm * tstep : cA; const char* nB = has_next ? (const char*)g.Bt + (size_t)nxt.pn * tstep : cB;
        for (int t = 0; t < nt; t += 2) {
            const bool last = (t == nt - 2);
            const char* a1 = cA + (size_t)(t + 1) * kstep;
            const char* a2 = last ? nA : cA + (size_t)(t + 2) * kstep; const char* b2 = last ? nB : cB + (size_t)(t + 2) * kstep;
            const char* a3 = a2 + kstep; const char* b3 = b2 + kstep;
            if constexpr (SP2) {
            PG8_LDB(B0, 0, 0); PG8_LDB(B1, 0, 1); PG8_SCHED; PG8_LDA(At, 0, 0); PG8_STAGE(PG8_SA(1, 1), a1 + hstep, voffA);
            PG8_WAIT_V(8); PG8_WAIT_L(0); PG8_BAR; PG8_MMA(0, 0, At, B0); PG8_MMA(0, 1, At, B1); PG8_BAR; PG8_SCHED;
            PG8_LDA(At, 0, 1); PG8_STAGE(PG8_SB(0, 0), b2, voffB); PG8_STAGE(PG8_SB(0, 1), b2 + hstep, voffB); PG8_STAGE(PG8_SA(0, 0), a2, voffA);
            PG8_WAIT_V(8); PG8_WAIT_L(0); PG8_BAR; PG8_MMA(1, 0, At, B0); PG8_MMA(1, 1, At, B1); PG8_BAR; PG8_SCHED;
            PG8_LDB(B0, 1, 0); PG8_LDB(B1, 1, 1); PG8_SCHED; PG8_LDA(At, 1, 0); PG8_STAGE(PG8_SA(0, 1), a2 + hstep, voffA);
            PG8_WAIT_V(8); PG8_WAIT_L(0); PG8_BAR; PG8_MMA(0, 0, At, B0); PG8_MMA(0, 1, At, B1); PG8_BAR; PG8_SCHED;
            PG8_LDA(At, 1, 1); PG8_STAGE(PG8_SB(1, 0), b3, voffB); PG8_STAGE(PG8_SB(1, 1), b3 + hstep, voffB); PG8_STAGE(PG8_SA(1, 0), a3, voffA);
            PG8_WAIT_V(8); PG8_WAIT_L(0); PG8_BAR; PG8_MMA(1, 0, At, B0); PG8_MMA(1, 1, At, B1); PG8_BAR; PG8_SCHED;
            } else {
            PG8_LDB(B0, 0, 0); PG8_SCHED; PG8_LDA(At, 0, 0); PG8_STAGE(PG8_SA(1, 1), a1 + hstep, voffA);
            PG8_WAIT_L(8); PG8_BAR; PG8_WAIT_L(0); PG8_MMA(0, 0, At, B0); PG8_BAR; PG8_SCHED;
            PG8_LDB(B1, 0, 1); PG8_STAGE(PG8_SB(0, 0), b2, voffB);
            PG8_BAR; PG8_WAIT_L(0); PG8_MMA(0, 1, At, B1); PG8_BAR;
            PG8_LDA(At, 0, 1); PG8_STAGE(PG8_SA(0, 0), a2, voffA);
            PG8_BAR; PG8_WAIT_L(0); PG8_MMA(1, 0, At, B0); PG8_BAR; PG8_SCHED;
            PG8_STAGE(PG8_SB(0, 1), b2 + hstep, voffB);
            PG8_WAIT_V(6); PG8_BAR; PG8_MMA(1, 1, At, B1); PG8_BAR;
            PG8_LDB(B0, 1, 0); PG8_SCHED; PG8_LDA(At, 1, 0); PG8_STAGE(PG8_SA(0, 1), a2 + hstep, voffA);
            PG8_WAIT_L(8); PG8_BAR; PG8_WAIT_L(0); PG8_MMA(0, 0, At, B0); PG8_BAR; PG8_SCHED;
            PG8_LDB(B1, 1, 1); PG8_STAGE(PG8_SB(1, 0), b3, voffB);
            PG8_BAR; PG8_WAIT_L(0); PG8_MMA(0, 1, At, B1); PG8_BAR;
            PG8_LDA(At, 1, 1); PG8_STAGE(PG8_SA(1, 0), a3, voffA);
            PG8_BAR; PG8_WAIT_L(0); PG8_MMA(1, 0, At, B0); PG8_BAR; PG8_SCHED;
            PG8_STAGE(PG8_SB(1, 1), b3 + hstep, voffB);
            PG8_WAIT_V(6); PG8_BAR; PG8_MMA(1, 1, At, B1); PG8_BAR;
            }
        }
        if constexpr (ALIGN_EPI) { if (wr == 0) PG8_BAR; }
        E(acc, cur, ui, wr, wc, fr, fq);
        if (!has_next) break;
#pragma unroll
        for (int a = 0; a < 2; ++a)
#pragma unroll
            for (int b = 0; b < 2; ++b)
#pragma unroll
                for (int m = 0; m < 4; ++m)
#pragma unroll
                    for (int n = 0; n < 2; ++n) acc[a][b][m][n] = (f32x4){0.f, 0.f, 0.f, 0.f};
        cur = nxt; cA = nA; cB = nB; ++ui;
        if constexpr (ALIGN_EPI) { if (wr == 1) PG8_BAR; }
    }
    PG8_WAIT_V(0);
    if constexpr (!ALIGN_EPI) { if (wr == 0) PG8_BAR; }
    PG8_BAR;
#undef PG8_SA
#undef PG8_SB
#undef PG8_STAGE
#undef PG8_LDA
#undef PG8_LDB
#undef PG8_MMA
#undef PG8_WAIT_V
#undef PG8_WAIT_L
#undef PG8_BAR
#undef PG8_SCHED
}
}

__device__ __forceinline__ void transpose_cvt(const float* __restrict__ W, bf16_t* __restrict__ Wt, int K, int N, float* sm, const float* __restrict__ gain, int tstart, int tstride) {
    int tid = threadIdx.x; asm volatile("" : "+v"(tid));
    const int tn = N >> 8, ntile = tn * (K >> 6);
    for (int tile = tstart; tile < ntile; tile += tstride) {
        const int k0 = (tile / tn) << 6, n0 = (tile % tn) << 8;
        f32x4 v[8];
#pragma unroll
        for (int i = 0; i < 8; ++i) { const int idx = tid + i * 512; const int rest = idx >> 6; const int r = ((rest >> 3) << 3) + (idx & 7), c4 = ((rest & 7) << 3) + ((idx >> 3) & 7);
            v[i] = __builtin_nontemporal_load((const f32x4*)(W + (size_t)(k0 + r) * N + n0 + c4 * 4)); if (gain) v[i] = v[i] * gain[k0 + r]; }
#pragma unroll
        for (int i = 0; i < 8; ++i) { const int idx = tid + i * 512; const int rest = idx >> 6; const int r = ((rest >> 3) << 3) + (idx & 7), c4 = ((rest & 7) << 3) + ((idx >> 3) & 7);
            float* d = sm + r * 257 + c4 * 4; d[0] = v[i][0]; d[1] = v[i][1]; d[2] = v[i][2]; d[3] = v[i][3]; }
        __syncthreads();
        const int ks = tid & 7;
#pragma unroll
        for (int i = 0; i < 4; ++i) { const int n = (tid >> 3) + 64 * i; float f[8];
#pragma unroll
            for (int j = 0; j < 8; ++j) f[j] = sm[(ks * 8 + j) * 257 + n];
            u32x4 w; w.x = cvt_pk_bf16(f[0], f[1]); w.y = cvt_pk_bf16(f[2], f[3]); w.z = cvt_pk_bf16(f[4], f[5]); w.w = cvt_pk_bf16(f[6], f[7]);
            *(u32x4*)(Wt + (size_t)(n0 + n) * K + k0 + ks * 8) = w; }
        __syncthreads();
    }
}

__device__ __forceinline__ void s5_params(const float* lam_re, const float* lam_im, const float* log_dt, const float* b_re, const float* b_im, float* S5A, float* S5B) {
    int tid = threadIdx.x; asm volatile("" : "+v"(tid));
    for (int idx = blockIdx.x * 512 + tid; idx < 8192; idx += gridDim.x * 512) {
        const float lr = fminf(lam_re[idx], -1e-4f), li = lam_im[idx], dt = expf(log_dt[idx >> 6]);
        const float mag = expf(lr * dt), th = li * dt;
        const float ar = mag * cosf(th), ai = mag * sinf(th);
        const float den = lr * lr + li * li;
        const float zr = ((ar - 1.0f) * lr + ai * li) / den, zi = (ai * lr - (ar - 1.0f) * li) / den;
        S5A[idx * 2] = ar; S5A[idx * 2 + 1] = ai;
#pragma unroll
        for (int c = 0; c < 16; ++c) { const float br = b_re[(size_t)idx * 16 + c], bi = b_im[(size_t)idx * 16 + c];
            S5B[(size_t)idx * 32 + c] = zr * br - zi * bi; S5B[(size_t)idx * 32 + 16 + c] = zr * bi + zi * br; }
    }
}

__device__ __forceinline__ void x_stats_phase(const float* __restrict__ h, bf16_t* __restrict__ hb, float* __restrict__ rs) {
    int tid = threadIdx.x; asm volatile("" : "+v"(tid));
    const int lane = tid & 63, wave = tid >> 6;
    for (int row = blockIdx.x * 8 + wave; row < T; row += gridDim.x * 8) {
        const float* p = h + (size_t)row * 2048 + lane * 8;
        f32x4 v[8]; float ss = 0.f;
#pragma unroll
        for (int i = 0; i < 4; ++i) { v[2 * i] = *(const f32x4*)(p + i * 512); v[2 * i + 1] = *(const f32x4*)(p + i * 512 + 4); }
#pragma unroll
        for (int i = 0; i < 8; ++i) ss += v[i][0] * v[i][0] + v[i][1] * v[i][1] + v[i][2] * v[i][2] + v[i][3] * v[i][3];
        ss = wave_sum(ss);
        if (lane < 32) rs[(size_t)row * 32 + lane] = lane == 0 ? ss : 0.f;
#pragma unroll
        for (int i = 0; i < 4; ++i) { u32x4 w; w.x = cvt_pk_bf16(v[2 * i][0], v[2 * i][1]); w.y = cvt_pk_bf16(v[2 * i][2], v[2 * i][3]); w.z = cvt_pk_bf16(v[2 * i + 1][0], v[2 * i + 1][1]); w.w = cvt_pk_bf16(v[2 * i + 1][2], v[2 * i + 1][3]);
            *(u32x4*)(hb + (size_t)row * 2048 + i * 512 + lane * 8) = w; }
    }
}

__device__ __forceinline__ float hgrn_lb(const float* lbp, int j, int ch) { return j == 0 ? 0.f : sigmoidf_(lbp[1024 + ch] - lbp[ch]); }

__device__ __forceinline__ void hgrn_cumsum(float* base, int st_t, int st_k, int tid) {
    const int k = tid & 127, qd = tid >> 7;
    float* p = base + k * st_k + (16 * qd) * st_t;
    float run = 0.f;
#pragma unroll
    for (int t = 0; t < 16; ++t) { run += p[t * st_t]; p[t * st_t] = run; }
    __syncthreads();
    float off = 0.f;
#pragma unroll
    for (int q = 0; q < 3; ++q) if (q < qd) off += base[k * st_k + (16 * q + 15) * st_t];
    __syncthreads();
    if (qd > 0) {
#pragma unroll
        for (int t = 0; t < 16; ++t) p[t * st_t] += off; }
    __syncthreads();
}

__device__ __forceinline__ void hgrn_p1(int item, const bf16_t* __restrict__ proj, const float* __restrict__ lbp, int j, bf16_t* __restrict__ HST, float* __restrict__ HDEC, unsigned char* smb) {
    int tid = threadIdx.x; asm volatile("" : "+v"(tid));
    const int wave = tid >> 6, lane = tid & 63, fr = lane & 15, fq = lane >> 4;
    const int c = item & 63, h = (item >> 6) & 7, b = item >> 9;
    const size_t tok0 = (size_t)b * SEQ + c * 64;
    float* BT = (float*)smb; float* KT = BT + 8704;
    unsigned char* KH = smb + 2 * 34816; unsigned char* Vt = KH + 18432;
    {
        const int t = lane;
#pragma unroll
        for (int i = 0; i < 2; ++i) { const int kg = wave + 8 * i;
            const bf16_t* rowp = proj + (tok0 + t) * 5120 + h * 128 + kg * 8;
            const u32x4 fw = *(const u32x4*)(rowp + 2048), vw = *(const u32x4*)(rowp + 3072);
            float f[8]; unpack8(fw, f);
#pragma unroll
            for (int jj = 0; jj < 8; ++jj) { const int k = kg * 8 + jj; const float lb = hgrn_lb(lbp, j, h * 128 + k); const float fg = lb + (1.0f - lb) * sigmoidf_(f[jj]);
                BT[k * 65 + t] = __log2f(fg); KT[k * 65 + t] = 1.0f - fg; }
            unsigned short* vcol = (unsigned short*)(Vt + (kg * 8) * 144 + t * 2);
            vcol[0 * 72] = (unsigned short)(vw.x & 0xffffu); vcol[1 * 72] = (unsigned short)(vw.x >> 16); vcol[2 * 72] = (unsigned short)(vw.y & 0xffffu); vcol[3 * 72] = (unsigned short)(vw.y >> 16);
            vcol[4 * 72] = (unsigned short)(vw.z & 0xffffu); vcol[5 * 72] = (unsigned short)(vw.z >> 16); vcol[6 * 72] = (unsigned short)(vw.w & 0xffffu); vcol[7 * 72] = (unsigned short)(vw.w >> 16); }
    }
    __syncthreads();
    hgrn_cumsum(BT, 1, 65, tid);
#pragma unroll
    for (int i = 0; i < 16; ++i) { const int e = tid + i * 512; const int k = e >> 6, s = e & 63;
        *(unsigned short*)(KH + k * 144 + s * 2) = f2bf(KT[k * 65 + s] * ex2(BT[k * 65 + 63] - BT[k * 65 + s])); }
    if (tid < 128) HDEC[(size_t)item * 128 + tid] = ex2(BT[tid * 65 + 63]);
    __syncthreads();
    {
        bf16x8 bfr[2];
#pragma unroll
        for (int ks = 0; ks < 2; ++ks) bfr[ks] = *(const bf16x8*)(KH + (16 * wave + fr) * 144 + ks * 64 + fq * 16);
        bf16_t* dst = HST + (size_t)item * 16384 + fr * 128 + 16 * wave + 4 * fq;
#pragma unroll
        for (int mt = 0; mt < 8; ++mt) { f32x4 acc = (f32x4){0.f, 0.f, 0.f, 0.f};
#pragma unroll
            for (int ks = 0; ks < 2; ++ks) { const bf16x8 af = *(const bf16x8*)(Vt + (16 * mt + fr) * 144 + ks * 64 + fq * 16); acc = __builtin_amdgcn_mfma_f32_16x16x32_bf16(bfr[ks], af, acc, 0, 0, 0); }
            { u32x2 w2; w2.x = (unsigned)f2bf(acc[0]) | ((unsigned)f2bf(acc[1]) << 16); w2.y = (unsigned)f2bf(acc[2]) | ((unsigned)f2bf(acc[3]) << 16);
              *(u32x2*)(dst + (size_t)(16 * mt) * 128) = w2; } }
    }
    __syncthreads();
}

__device__ __forceinline__ void hgrn_p2(bf16_t* __restrict__ HST, const float* __restrict__ HDEC) {
    int tid = threadIdx.x; asm volatile("" : "+v"(tid));
    for (int gid = blockIdx.x * 512 + tid; gid < 131072; gid += gridDim.x * 512) {
        const int bh = gid >> 13, off = (gid & 8191) * 2, k = off & 127;
        f32x2 st = (f32x2){0.f, 0.f};
        bf16_t* hp = HST + (size_t)bh * 64 * 16384 + off; const float* dp = HDEC + (size_t)bh * 64 * 128 + k;
#pragma unroll 1
        for (int c0 = 0; c0 < 64; c0 += 16) {
            f32x2 d[16]; unsigned kv[16];
#pragma unroll
            for (int u = 0; u < 16; ++u) { d[u] = *(const f32x2*)(dp + (size_t)(c0 + u) * 128); kv[u] = *(const unsigned*)(hp + (size_t)(c0 + u) * 16384); }
#pragma unroll
            for (int u = 0; u < 16; ++u) { st = st * d[u] + (f32x2){bflo(kv[u]), bfhi(kv[u])}; kv[u] = cvt_pk_bf16(st[0], st[1]); }
#pragma unroll
            for (int u = 0; u < 16; ++u) *(unsigned*)(hp + (size_t)(c0 + u) * 16384) = kv[u];
        }
    }
}

__device__ __forceinline__ void hgrn_p3(int item, const bf16_t* __restrict__ proj, const float* __restrict__ lbp, int j, const bf16_t* __restrict__ HST, const float* __restrict__ ogain, bf16_t* __restrict__ ycat, unsigned char* smb) {
    int tid = threadIdx.x; asm volatile("" : "+v"(tid));
    const int wave = tid >> 6, lane = tid & 63, fr = lane & 15, fq = lane >> 4;
    const int c = item & 63, h = (item >> 6) & 7, b = item >> 9;
    const size_t tok0 = (size_t)b * SEQ + c * 64;
    float* FB = (float*)smb; float* FQ = FB + 8704; float* FK = FQ + 8704;
    unsigned char* SC = smb + 3 * 34816; unsigned char* Vt = SC + 9216; float* RED = (float*)(Vt + 18432);
    unsigned char* Pt = (unsigned char*)FK; unsigned char* QEb = (unsigned char*)FB;
    u32x4 pre[4];
#pragma unroll
    for (int i = 0; i < 4; ++i) pre[i] = (u32x4){0u, 0u, 0u, 0u};
    u32x2 graw[4];
#pragma unroll
    for (int mt = 0; mt < 4; ++mt) graw[mt] = *(const u32x2*)(proj + (tok0 + 16 * mt + fr) * 5120 + 4096 + h * 128 + 16 * wave + 4 * fq);
    if (c > 0) { const bf16_t* P = HST + (size_t)(item - 1) * 16384;
#pragma unroll
        for (int i = 0; i < 4; ++i) pre[i] = __builtin_nontemporal_load((const u32x4*)(P + (size_t)(tid + i * 512) * 8)); }
    for (int ra = 0; ra < ((H3REP & 1) ? 3 : 1); ++ra) {
    {
        const int kg = tid & 15;
#pragma unroll
        for (int i = 0; i < 2; ++i) { const int t = (tid + i * 512) >> 4;
            const bf16_t* rowp = proj + (tok0 + t) * 5120 + h * 128 + kg * 8;
            const u32x4 qw = __builtin_nontemporal_load((const u32x4*)(rowp + 1024)), fw = __builtin_nontemporal_load((const u32x4*)(rowp + 2048)), vw = __builtin_nontemporal_load((const u32x4*)(rowp + 3072));
            float q[8], f[8]; unpack8(qw, q); unpack8(fw, f);
            float lg[8], kk[8], qs[8];
#pragma unroll
            for (int jj = 0; jj < 8; ++jj) { const float lb = hgrn_lb(lbp, j, h * 128 + kg * 8 + jj); const float fg = lb + (1.0f - lb) * sigmoidf_(f[jj]);
                lg[jj] = __log2f(fg); kk[jj] = 1.0f - fg; qs[jj] = q[jj] * sigmoidf_(q[jj]); }
            *(f32x4*)(FB + t * 132 + kg * 8) = (f32x4){lg[0], lg[1], lg[2], lg[3]}; *(f32x4*)(FB + t * 132 + kg * 8 + 4) = (f32x4){lg[4], lg[5], lg[6], lg[7]};
            *(f32x4*)(FQ + t * 132 + kg * 8) = (f32x4){qs[0], qs[1], qs[2], qs[3]}; *(f32x4*)(FQ + t * 132 + kg * 8 + 4) = (f32x4){qs[4], qs[5], qs[6], qs[7]};
            *(f32x4*)(FK + t * 132 + kg * 8) = (f32x4){kk[0], kk[1], kk[2], kk[3]}; *(f32x4*)(FK + t * 132 + kg * 8 + 4) = (f32x4){kk[4], kk[5], kk[6], kk[7]};
            unsigned short* vcol = (unsigned short*)(Vt + (kg * 8) * 144 + t * 2);
            vcol[0 * 72] = (unsigned short)(vw.x & 0xffffu); vcol[1 * 72] = (unsigned short)(vw.x >> 16); vcol[2 * 72] = (unsigned short)(vw.y & 0xffffu); vcol[3 * 72] = (unsigned short)(vw.y >> 16);
            vcol[4 * 72] = (unsigned short)(vw.z & 0xffffu); vcol[5 * 72] = (unsigned short)(vw.z >> 16); vcol[6 * 72] = (unsigned short)(vw.w & 0xffffu); vcol[7 * 72] = (unsigned short)(vw.w >> 16); }
    }
    __syncthreads();
    hgrn_cumsum(FB, 132, 1, tid);
    }
    for (int rb = 0; rb < ((H3REP & 2) ? 3 : 1); ++rb) {
    if (wave < 6) {
        const int I = wave < 1 ? 1 : wave < 3 ? 2 : 3, J = wave < 1 ? 0 : wave < 3 ? wave - 1 : wave - 3;
        const float* bt = FB + (16 * I + fr) * 132, *qt = FQ + (16 * I + fr) * 132, *be = FB + (16 * J + 15) * 132, *bs = FB + (16 * J + fr) * 132, *ks_ = FK + (16 * J + fr) * 132;
        f32x4 acc = (f32x4){0.f, 0.f, 0.f, 0.f};
#pragma unroll
        for (int ks = 0; ks < 4; ++ks) { const int k0 = ks * 32 + fq * 8; float av[8], bv[8];
#pragma unroll
            for (int hh = 0; hh < 2; ++hh) { const f32x4 b4 = *(const f32x4*)(bt + k0 + 4 * hh), q4 = *(const f32x4*)(qt + k0 + 4 * hh), e4 = *(const f32x4*)(be + k0 + 4 * hh), s4 = *(const f32x4*)(bs + k0 + 4 * hh), k4 = *(const f32x4*)(ks_ + k0 + 4 * hh);
#pragma unroll
                for (int e = 0; e < 4; ++e) { av[4 * hh + e] = q4[e] * ex2(b4[e] - e4[e]); bv[4 * hh + e] = k4[e] * ex2(e4[e] - s4[e]); } }
            u32x4 aw, bw; aw.x = cvt_pk_bf16(av[0], av[1]); aw.y = cvt_pk_bf16(av[2], av[3]); aw.z = cvt_pk_bf16(av[4], av[5]); aw.w = cvt_pk_bf16(av[6], av[7]);
            bw.x = cvt_pk_bf16(bv[0], bv[1]); bw.y = cvt_pk_bf16(bv[2], bv[3]); bw.z = cvt_pk_bf16(bv[4], bv[5]); bw.w = cvt_pk_bf16(bv[6], bv[7]);
            acc = __builtin_amdgcn_mfma_f32_16x16x32_bf16(__builtin_bit_cast(bf16x8, aw), __builtin_bit_cast(bf16x8, bw), acc, 0, 0, 0); }
#pragma unroll
        for (int e = 0; e < 4; ++e) *(unsigned short*)(SC + (16 * I + 4 * fq + e) * 144 + (16 * J + fr) * 2) = f2bf(acc[e]);
    } else {
#pragma unroll
        for (int u = 0; u < 3; ++u) { const int id = (wave - 6) * 3 + u; const int I = id < 3 ? 0 : id < 5 ? 1 : 2, J = id < 3 ? id + 1 : id < 5 ? id - 1 : 3;
#pragma unroll
            for (int e = 0; e < 4; ++e) *(unsigned short*)(SC + (16 * I + 4 * fq + e) * 144 + (16 * J + fr) * 2) = (unsigned short)0; }
    }
    {
        const int I = lane >> 4, ks16 = lane & 15;
#pragma unroll
        for (int half = 0; half < 2; ++half) { const int tl = half == 0 ? wave : 15 - wave; const int t = 16 * I + tl;
            const float* qrow = FQ + t * 132 + 8 * ks16;
            const f32x4 q0v = *(const f32x4*)qrow, q1v = *(const f32x4*)(qrow + 4);
            float part[16]; f32x4 w0 = (f32x4){1.f, 1.f, 1.f, 1.f}, w1 = w0;
#pragma unroll
            for (int sl = 15; sl >= 0; --sl) { part[sl] = 0.f;
                if (sl <= tl) { const float* krow = FK + (16 * I + sl) * 132 + 8 * ks16;
                    const f32x4 k0 = *(const f32x4*)krow, k1 = *(const f32x4*)(krow + 4);
                    float av = 0.f;
#pragma unroll
                    for (int e = 0; e < 4; ++e) { av += q0v[e] * k0[e] * w0[e]; av += q1v[e] * k1[e] * w1[e]; w0[e] *= 1.0f - k0[e]; w1[e] *= 1.0f - k1[e]; }
                    part[sl] = av; } }
#pragma unroll
            for (int i = 0; i < 8; ++i) { const bool hi = (ks16 & 8) != 0; const float send = hi ? part[i] : part[i + 8], keep = hi ? part[i + 8] : part[i]; part[i] = keep + __shfl_xor(send, 8); }
#pragma unroll
            for (int i = 0; i < 4; ++i) { const bool hi = (ks16 & 4) != 0; const float send = hi ? part[i] : part[i + 4], keep = hi ? part[i + 4] : part[i]; part[i] = keep + __shfl_xor(send, 4); }
#pragma unroll
            for (int i = 0; i < 2; ++i) { const bool hi = (ks16 & 2) != 0; const float send = hi ? part[i] : part[i + 2], keep = hi ? part[i + 2] : part[i]; part[i] = keep + __shfl_xor(send, 2); }
            { const bool hi = (ks16 & 1) != 0; const float send = hi ? part[0] : part[1], keep = hi ? part[1] : part[0]; part[0] = keep + __shfl_xor(send, 1); }
            *(unsigned short*)(SC + t * 144 + (16 * I + ks16) * 2) = f2bf(part[0]); }
    }
    __syncthreads();
    }
    for (int rc = 0; rc < ((H3REP & 4) ? 3 : 1); ++rc) {
    u32x4 qe[2];
    { const int kg = tid & 15;
#pragma unroll
      for (int i = 0; i < 2; ++i) { const int t = (tid + i * 512) >> 4; const float* bp = FB + t * 132 + kg * 8, *qp = FQ + t * 132 + kg * 8;
          const f32x4 b0 = *(const f32x4*)bp, b1 = *(const f32x4*)(bp + 4), q0 = *(const f32x4*)qp, q1 = *(const f32x4*)(qp + 4);
          qe[i].x = cvt_pk_bf16(q0[0] * ex2(b0[0]), q0[1] * ex2(b0[1])); qe[i].y = cvt_pk_bf16(q0[2] * ex2(b0[2]), q0[3] * ex2(b0[3]));
          qe[i].z = cvt_pk_bf16(q1[0] * ex2(b1[0]), q1[1] * ex2(b1[1])); qe[i].w = cvt_pk_bf16(q1[2] * ex2(b1[2]), q1[3] * ex2(b1[3])); } }
    __syncthreads();
#pragma unroll
    for (int i = 0; i < 4; ++i) { const int idx = tid + i * 512; const int v = idx >> 4, k8 = idx & 15; *(u32x4*)(Pt + v * 272 + k8 * 16) = pre[i]; }
    { const int kg = tid & 15;
#pragma unroll
      for (int i = 0; i < 2; ++i) { const int t = (tid + i * 512) >> 4; *(u32x4*)(QEb + t * 272 + kg * 16) = qe[i]; } }
    __syncthreads();
    f32x4 o[4];
    {
        bf16x8 bv[2], bp[4];
#pragma unroll
        for (int ks = 0; ks < 2; ++ks) bv[ks] = *(const bf16x8*)(Vt + (16 * wave + fr) * 144 + ks * 64 + fq * 16);
#pragma unroll
        for (int ks = 0; ks < 4; ++ks) bp[ks] = *(const bf16x8*)(Pt + (16 * wave + fr) * 272 + ks * 64 + fq * 16);
#pragma unroll
        for (int mt = 0; mt < 4; ++mt) { f32x4 acc = (f32x4){0.f, 0.f, 0.f, 0.f};
#pragma unroll
            for (int ks = 0; ks < 2; ++ks) { const bf16x8 af = *(const bf16x8*)(SC + (16 * mt + fr) * 144 + ks * 64 + fq * 16); acc = __builtin_amdgcn_mfma_f32_16x16x32_bf16(bv[ks], af, acc, 0, 0, 0); }
#pragma unroll
            for (int ks = 0; ks < 4; ++ks) { const bf16x8 af = *(const bf16x8*)(QEb + (16 * mt + fr) * 272 + ks * 64 + fq * 16); acc = __builtin_amdgcn_mfma_f32_16x16x32_bf16(bp[ks], af, acc, 0, 0, 0); }
            o[mt] = acc;
            float ssq = acc[0] * acc[0] + acc[1] * acc[1] + acc[2] * acc[2] + acc[3] * acc[3]; ssq += __shfl_xor(ssq, 16); ssq += __shfl_xor(ssq, 32);
            if (fq == 0) RED[wave * 64 + 16 * mt + fr] = ssq; }
    }
    __syncthreads();
    {
        const int v0 = 16 * wave + 4 * fq; const f32x4 gn = *(const f32x4*)(ogain + v0);
#pragma unroll
        for (int mt = 0; mt < 4; ++mt) { const int t = 16 * mt + fr; float tot = 0.f;
#pragma unroll
            for (int w = 0; w < 8; ++w) tot += RED[w * 64 + t];
            const float r = rsqrtf(tot * (1.0f / 128.0f) + 1e-6f);
            const size_t tok = tok0 + t;
            const float g0 = bflo(graw[mt].x), g1 = bfhi(graw[mt].x), g2 = bflo(graw[mt].y), g3 = bfhi(graw[mt].y);
            u32x2 w2; w2.x = cvt_pk_bf16(o[mt][0] * r * gn[0] * g0 * sigmoidf_(g0), o[mt][1] * r * gn[1] * g1 * sigmoidf_(g1));
            w2.y = cvt_pk_bf16(o[mt][2] * r * gn[2] * g2 * sigmoidf_(g2), o[mt][3] * r * gn[3] * g3 * sigmoidf_(g3));
            *(u32x2*)(ycat + tok * 2048 + 1024 + h * 128 + v0) = w2; }
    }
    __syncthreads();
    }
    __syncthreads();
}

__device__ __forceinline__ float gelu_tanh(float y) { const float z = 0.7978845608028654f * (y + 0.044715f * y * y * y); const float e = __expf(2.0f * z); return y * (1.0f - __builtin_amdgcn_rcpf(1.0f + e)); }
__device__ __forceinline__ bf16x8 pack8(const f32x4 a, const f32x4 b, float sgn) {
    u32x4 w; w.x = cvt_pk_bf16(a[0] * sgn, a[1] * sgn); w.y = cvt_pk_bf16(a[2] * sgn, a[3] * sgn); w.z = cvt_pk_bf16(b[0] * sgn, b[1] * sgn); w.w = cvt_pk_bf16(b[2] * sgn, b[3] * sgn); return __builtin_bit_cast(bf16x8, w);
}
template <bool FINAL>
__device__ __forceinline__ void s5_pass(int item, const bf16_t* __restrict__ proj, const float* __restrict__ S5A, const float* __restrict__ S5B, float* __restrict__ S5F,
                                        const float* __restrict__ c_re, const float* __restrict__ c_im, const float* __restrict__ dsk, bf16_t* __restrict__ ys5, unsigned char* smb) {
    int tid = threadIdx.x; asm volatile("" : "+v"(tid));
    const int wave = tid >> 6, lane = tid & 63, fr = lane & 15, fq = lane >> 4;
    const int sg = item & 7, g = (item >> 3) & 63, b = item >> 9;
    const int seg = sg * 8 + wave; const size_t tok0 = (size_t)b * SEQ + seg * 64;
    float* Bu = (float*)(smb + wave * 12800);
    unsigned char* X = smb + wave * 12800 + 8448;
    const bf16x8 zero8 = __builtin_bit_cast(bf16x8, (u32x4){0u, 0u, 0u, 0u});
    bf16x8 af[8], uf[4];
#pragma unroll
    for (int mt = 0; mt < 8; ++mt) { af[mt] = zero8;
        if (fq < 2) { const int pp = 16 * mt + fr; const float* src = S5B + (size_t)(g * 64 + (pp & 63)) * 32 + (pp >> 6) * 16 + fq * 8; af[mt] = pack8(*(const f32x4*)src, *(const f32x4*)(src + 4), 1.0f); } }
#pragma unroll
    for (int blk = 0; blk < 4; ++blk) { uf[blk] = zero8;
        if (fq < 2) uf[blk] = *(const bf16x8*)(proj + (tok0 + 16 * blk + fr) * 5120 + g * 16 + fq * 8); }
    const float ar = S5A[(g * 64 + lane) * 2], ai = S5A[(g * 64 + lane) * 2 + 1];
    float xr = 0.f, xi = 0.f;
    bf16x8 cf[4]; float dv = 0.f; unsigned short uraw[16];
    if (FINAL) {
#pragma unroll
        for (int q = 0; q < 16; ++q) uraw[q] = proj[(tok0 + 16 * (q >> 2) + 4 * fq + (q & 3)) * 5120 + g * 16 + fr];
        const f32x2 cin = *(const f32x2*)(S5F + ((size_t)((b * 64 + g) * 64 + seg) * 64 + lane) * 2); xr = cin[0]; xi = cin[1];
#pragma unroll
        for (int ks = 0; ks < 4; ++ks) { const float* src = (ks < 2 ? c_re : c_im) + (size_t)g * 1024 + fr * 64 + ((ks & 1) * 32 + fq * 8); cf[ks] = pack8(*(const f32x4*)src, *(const f32x4*)(src + 4), ks < 2 ? 1.0f : -1.0f); }
        dv = dsk[g * 16 + fr];
    }
#pragma unroll
    for (int blk = 0; blk < 4; ++blk) {
#pragma unroll
        for (int mt = 0; mt < 8; ++mt) { const f32x4 acc = __builtin_amdgcn_mfma_f32_16x16x32_bf16(af[mt], uf[blk], (f32x4){0.f, 0.f, 0.f, 0.f}, 0, 0, 0); *(f32x4*)(Bu + fr * 132 + 16 * mt + 4 * fq) = acc; }
        __syncthreads();
#pragma unroll
        for (int t = 0; t < 16; ++t) { const float bur = Bu[t * 132 + lane], bui = Bu[t * 132 + 64 + lane];
            const float nxr = ar * xr - ai * xi + bur, nxi = ar * xi + ai * xr + bui; xr = nxr; xi = nxi;
            if (FINAL) { *(unsigned short*)(X + t * 272 + lane * 2) = f2bf(xr); *(unsigned short*)(X + t * 272 + 128 + lane * 2) = f2bf(xi); } }
        __syncthreads();
        if (FINAL) {
            f32x4 acc = (f32x4){0.f, 0.f, 0.f, 0.f};
#pragma unroll
            for (int ks = 0; ks < 4; ++ks) { const bf16x8 a = *(const bf16x8*)(X + fr * 272 + ks * 64 + fq * 16); acc = __builtin_amdgcn_mfma_f32_16x16x32_bf16(a, cf[ks], acc, 0, 0, 0); }
#pragma unroll
            for (int e = 0; e < 4; ++e) { const size_t tok = tok0 + 16 * blk + 4 * fq + e; const float u = bflo((unsigned)uraw[blk * 4 + e]);
                ys5[tok * 1024 + g * 16 + fr] = f2bf(gelu_tanh(acc[e] + dv * u)); }
        }
    }
    if (!FINAL) *(f32x2*)(S5F + ((size_t)((b * 64 + g) * 64 + seg) * 64 + lane) * 2) = (f32x2){xr, xi};
    __syncthreads();
}

#define WAVE_LDS_SYNC() do { asm volatile("s_waitcnt lgkmcnt(0)" ::: "memory"); __builtin_amdgcn_s_barrier(); asm volatile("" ::: "memory"); } while (0)
template <bool FINAL>
__device__ __forceinline__ void s5_wg(int bid, const bf16_t* __restrict__ proj, const float* __restrict__ S5A, const float* __restrict__ S5B, float* __restrict__ S5F,
                                      const float* __restrict__ c_re, const float* __restrict__ c_im, const float* __restrict__ dsk, bf16_t* __restrict__ ys5, unsigned char* smb) {
    int tid = threadIdx.x; asm volatile("" : "+v"(tid));
    const int wave = tid >> 6, lane = tid & 63, fr = lane & 15, fq = lane >> 4;
    const int g = bid >> 2, r0 = (bid & 3) * 4;
    float* Bu = (float*)(smb + wave * 12800);
    unsigned char* X = smb + wave * 12800 + 8448;
    const bf16x8 zero8 = __builtin_bit_cast(bf16x8, (u32x4){0u, 0u, 0u, 0u});
    bf16x8 af[8];
#pragma unroll
    for (int mt = 0; mt < 8; ++mt) { af[mt] = zero8;
        if (fq < 2) { const int pp = 16 * mt + fr; const float* src = S5B + (size_t)(g * 64 + (pp & 63)) * 32 + (pp >> 6) * 16 + fq * 8; af[mt] = pack8(*(const f32x4*)src, *(const f32x4*)(src + 4), 1.0f); } }
    const float ar = S5A[(g * 64 + lane) * 2], ai = S5A[(g * 64 + lane) * 2 + 1];
    bf16x8 cf[4]; f32x4 dv4 = (f32x4){0.f, 0.f, 0.f, 0.f};
    if (FINAL) {
#pragma unroll
        for (int ks = 0; ks < 4; ++ks) { const float* src = (ks < 2 ? c_re : c_im) + (size_t)g * 1024 + fr * 64 + ((ks & 1) * 32 + fq * 8); cf[ks] = pack8(*(const f32x4*)src, *(const f32x4*)(src + 4), ks < 2 ? 1.0f : -1.0f); }
        dv4 = *(const f32x4*)(dsk + g * 16 + 4 * fq);
    }
    bf16x8 ufb[2][4]; u32x2 urb[2][4]; f32x2 cinb[2];
#define S5_FETCH(k_, slot_) do { const int r_ = r0 + (k_); const int b_ = r_ >> 3, seg_ = (r_ & 7) * 8 + wave; const size_t tk_ = (size_t)b_ * SEQ + seg_ * 64; \
        _Pragma("unroll") for (int blk_ = 0; blk_ < 4; ++blk_) { ufb[slot_][blk_] = zero8; if (fq < 2) ufb[slot_][blk_] = *(const bf16x8*)(proj + (tk_ + 16 * blk_ + fr) * 5120 + g * 16 + fq * 8); } \
        if (FINAL) { _Pragma("unroll") for (int q_ = 0; q_ < 4; ++q_) urb[slot_][q_] = *(const u32x2*)(proj + (tk_ + 16 * q_ + fr) * 5120 + g * 16 + 4 * fq); \
            cinb[slot_] = *(const f32x2*)(S5F + ((size_t)((b_ * 64 + g) * 64 + seg_) * 64 + lane) * 2); } } while (0)
    S5_FETCH(0, 0);
#pragma unroll
    for (int k = 0; k < 4; ++k) {
        const int cur = k & 1;
        if (k < 3) S5_FETCH(k + 1, cur ^ 1);
        const int r = r0 + k; const int b = r >> 3, seg = (r & 7) * 8 + wave; const size_t tok0 = (size_t)b * SEQ + seg * 64;
        float xr = 0.f, xi = 0.f;
        if (FINAL) { xr = cinb[cur][0]; xi = cinb[cur][1]; }
#pragma unroll
        for (int blk = 0; blk < 4; ++blk) {
#pragma unroll
            for (int mt = 0; mt < 8; ++mt) { const f32x4 acc = __builtin_amdgcn_mfma_f32_16x16x32_bf16(af[mt], ufb[cur][blk], (f32x4){0.f, 0.f, 0.f, 0.f}, 0, 0, 0); *(f32x4*)(Bu + fr * 132 + 16 * mt + 4 * fq) = acc; }
            WAVE_LDS_SYNC();
#pragma unroll
            for (int t = 0; t < 16; ++t) { const float bur = Bu[t * 132 + lane], bui = Bu[t * 132 + 64 + lane];
                const float nxr = ar * xr - ai * xi + bur, nxi = ar * xi + ai * xr + bui; xr = nxr; xi = nxi;
                if (FINAL) { *(unsigned short*)(X + t * 272 + lane * 2) = f2bf(xr); *(unsigned short*)(X + t * 272 + 128 + lane * 2) = f2bf(xi); } }
            WAVE_LDS_SYNC();
            if (FINAL) {
                f32x4 acc = (f32x4){0.f, 0.f, 0.f, 0.f};
#pragma unroll
                for (int ks = 0; ks < 4; ++ks) { const bf16x8 a = *(const bf16x8*)(X + fr * 272 + ks * 64 + fq * 16); acc = __builtin_amdgcn_mfma_f32_16x16x32_bf16(cf[ks], a, acc, 0, 0, 0); }
                { const size_t tok = tok0 + 16 * blk + fr; const u32x2 uw = urb[cur][blk];
                  u32x2 w2; w2.x = cvt_pk_bf16(gelu_tanh(acc[0] + dv4[0] * bflo(uw.x)), gelu_tanh(acc[1] + dv4[1] * bfhi(uw.x)));
                  w2.y = cvt_pk_bf16(gelu_tanh(acc[2] + dv4[2] * bflo(uw.y)), gelu_tanh(acc[3] + dv4[3] * bfhi(uw.y)));
                  *(u32x2*)(ys5 + tok * 1024 + g * 16 + 4 * fq) = w2; }
                WAVE_LDS_SYNC();
            }
        }
        if (!FINAL) *(f32x2*)(S5F + ((size_t)((b * 64 + g) * 64 + seg) * 64 + lane) * 2) = (f32x2){xr, xi};
    }
#undef S5_FETCH
    __syncthreads();
}

__device__ __forceinline__ void s5_carry(float* __restrict__ S5F, const float* __restrict__ S5A) {
    int tid = threadIdx.x; asm volatile("" : "+v"(tid));
    for (int gid = blockIdx.x * 512 + tid; gid < 8192; gid += gridDim.x * 512) {
        const int p = gid & 63, bg = gid >> 6, g = bg & 63;
        float pr = S5A[(g * 64 + p) * 2], pi = S5A[(g * 64 + p) * 2 + 1];
#pragma unroll
        for (int q = 0; q < 6; ++q) { const float nr = pr * pr - pi * pi, ni = 2.0f * pr * pi; pr = nr; pi = ni; }
        float xr = 0.f, xi = 0.f;
        f32x2* F = (f32x2*)(S5F + ((size_t)bg * 64 * 64 + p) * 2);
#pragma unroll 1
        for (int s0 = 0; s0 < 64; s0 += 16) { f32x2 f[16];
#pragma unroll
            for (int u = 0; u < 16; ++u) f[u] = F[(size_t)(s0 + u) * 64];
#pragma unroll
            for (int u = 0; u < 16; ++u) { const f32x2 fin = f[u]; f[u] = (f32x2){xr, xi}; const float nr = pr * xr - pi * xi + fin[0], ni = pr * xi + pi * xr + fin[1]; xr = nr; xi = ni; }
#pragma unroll
            for (int u = 0; u < 16; ++u) F[(size_t)(s0 + u) * 64] = f[u];
        }
    }
}

__device__ __forceinline__ void attn_item(int item, const bf16_t* __restrict__ qkv, const float* __restrict__ qg, const float* __restrict__ kg, const float* __restrict__ sinks, bf16_t* __restrict__ ycat, unsigned char* smb) {
    int tid = threadIdx.x; asm volatile("" : "+v"(tid));
    const int wave = tid >> 6, lane = tid & 63, fr = lane & 15, fq = lane >> 4;
    const int qb = item & 63, kvh = (item >> 6) & 3, b = item >> 8;
    const int q0 = qb * 64; const size_t tokb = (size_t)b * SEQ;
    unsigned char* Ks = smb;
    unsigned char* Vt = smb + 192 * 144;
    const int hq = kvh * 8 + wave;
    u32x4 qraw[4][2];
#pragma unroll
    for (int i = 0; i < 4; ++i) { const bf16_t* qp = qkv + (tokb + q0 + 16 * i + fr) * 2560 + hq * 64 + fq * 8; qraw[i][0] = *(const u32x4*)qp; qraw[i][1] = *(const u32x4*)(qp + 32); }
#pragma unroll
    for (int i = 0; i < 3; ++i) { const int idx = tid + i * 512; const int kidx = idx >> 3, dg = idx & 7; const int s = q0 - 127 + kidx; const bool ok = (s >= 0) && (kidx < 191);
        u32x4 kw = (u32x4){0u, 0u, 0u, 0u}, vw = kw;
        if (ok) { const bf16_t* rp = qkv + (tokb + s) * 2560 + kvh * 64 + dg * 8; kw = *(const u32x4*)(rp + 2048); vw = *(const u32x4*)(rp + 2304); }
        float k[8]; unpack8(kw, k);
        float ss = 0.f;
#pragma unroll
        for (int jj = 0; jj < 8; ++jj) ss += k[jj] * k[jj];
        ss += __shfl_xor(ss, 1); ss += __shfl_xor(ss, 2); ss += __shfl_xor(ss, 4);
        const float r = rsqrtf(ss * (1.0f / 64.0f) + 1e-6f);
        const f32x4 g0 = *(const f32x4*)(kg + dg * 8), g1 = *(const f32x4*)(kg + dg * 8 + 4);
        u32x4 w; w.x = cvt_pk_bf16(k[0] * r * g0[0], k[1] * r * g0[1]); w.y = cvt_pk_bf16(k[2] * r * g0[2], k[3] * r * g0[3]); w.z = cvt_pk_bf16(k[4] * r * g1[0], k[5] * r * g1[1]); w.w = cvt_pk_bf16(k[6] * r * g1[2], k[7] * r * g1[3]);
        *(u32x4*)(Ks + kidx * 144 + dg * 16) = w;
        unsigned short* vcol = (unsigned short*)(Vt + (dg * 8) * 392 + kidx * 2);
        vcol[0 * 196] = (unsigned short)(vw.x & 0xffffu); vcol[1 * 196] = (unsigned short)(vw.x >> 16); vcol[2 * 196] = (unsigned short)(vw.y & 0xffffu); vcol[3 * 196] = (unsigned short)(vw.y >> 16);
        vcol[4 * 196] = (unsigned short)(vw.z & 0xffffu); vcol[5 * 196] = (unsigned short)(vw.z >> 16); vcol[6 * 196] = (unsigned short)(vw.w & 0xffffu); vcol[7 * 196] = (unsigned short)(vw.w >> 16); }
    const float slope2 = exp2f(-0.25f * (float)(hq + 1)) * LOG2E, sink2 = sinks[hq] * LOG2E;
    __syncthreads();
#pragma unroll
    for (int i = 0; i < 4; ++i) {
        bf16x8 qf[2];
        { const u32x4 w0 = qraw[i][0], w1 = qraw[i][1]; float f0[8], f1[8]; unpack8(w0, f0); unpack8(w1, f1);
          float ss = 0.f;
#pragma unroll
          for (int jj = 0; jj < 8; ++jj) ss += f0[jj] * f0[jj] + f1[jj] * f1[jj];
          ss += __shfl_xor(ss, 16); ss += __shfl_xor(ss, 32);
          const float r = rsqrtf(ss * (1.0f / 64.0f) + 1e-6f) * 0.125f * LOG2E;
          const f32x4 ga = *(const f32x4*)(qg + fq * 8), gb = *(const f32x4*)(qg + fq * 8 + 4), gc = *(const f32x4*)(qg + 32 + fq * 8), gd = *(const f32x4*)(qg + 32 + fq * 8 + 4);
          u32x4 a, c;
          a.x = cvt_pk_bf16(f0[0] * r * ga[0], f0[1] * r * ga[1]); a.y = cvt_pk_bf16(f0[2] * r * ga[2], f0[3] * r * ga[3]); a.z = cvt_pk_bf16(f0[4] * r * gb[0], f0[5] * r * gb[1]); a.w = cvt_pk_bf16(f0[6] * r * gb[2], f0[7] * r * gb[3]);
          c.x = cvt_pk_bf16(f1[0] * r * gc[0], f1[1] * r * gc[1]); c.y = cvt_pk_bf16(f1[2] * r * gc[2], f1[3] * r * gc[3]); c.z = cvt_pk_bf16(f1[4] * r * gd[0], f1[5] * r * gd[1]); c.w = cvt_pk_bf16(f1[6] * r * gd[2], f1[7] * r * gd[3]);
          qf[0] = __builtin_bit_cast(bf16x8, a); qf[1] = __builtin_bit_cast(bf16x8, c); }
        f32x4 sc[9];
#pragma unroll
        for (int jr = 0; jr < 9; ++jr) { const unsigned char* kp = Ks + (16 * (i + jr) + fr) * 144 + fq * 16;
            const bf16x8 k0 = *(const bf16x8*)kp, k1 = *(const bf16x8*)(kp + 64);
            f32x4 acc = (f32x4){0.f, 0.f, 0.f, 0.f};
            acc = __builtin_amdgcn_mfma_f32_16x16x32_bf16(k0, qf[0], acc, 0, 0, 0);
            acc = __builtin_amdgcn_mfma_f32_16x16x32_bf16(k1, qf[1], acc, 0, 0, 0);
            sc[jr] = acc; }
        float m = sink2;
        const float nb = -slope2 * (float)(fr + 127 - 4 * fq); const bool head = q0 < 128;
#pragma unroll
        for (int jr = 0; jr < 9; ++jr)
#pragma unroll
            for (int e = 0; e < 4; ++e) { const int dist = fr + 127 - 16 * jr - 4 * fq - e; const int kidx = 16 * (i + jr) + 4 * fq + e;
                bool valid = true;
                if (jr == 0) valid = dist < 128;
                if (jr == 8) valid = dist >= 0;
                if (head) valid = valid && (q0 - 127 + kidx >= 0);
                const float v = valid ? fmaf(slope2, (float)(16 * jr + e), sc[jr][e]) + nb : -1e30f; sc[jr][e] = v; m = fmaxf(m, v); }
        m = fmaxf(m, __shfl_xor(m, 16)); m = fmaxf(m, __shfl_xor(m, 32));
        float l = 0.f;
#pragma unroll
        for (int jr = 0; jr < 9; ++jr)
#pragma unroll
            for (int e = 0; e < 4; ++e) { const float pv = ex2(sc[jr][e] - m); sc[jr][e] = pv; l += pv; }
        l += __shfl_xor(l, 16); l += __shfl_xor(l, 32);
        l += ex2(sink2 - m);
        const float inv = 1.0f / l;
        bf16x8 pf[5];
#pragma unroll
        for (int pp = 0; pp < 5; ++pp) { u32x4 w; w.x = cvt_pk_bf16(sc[2 * pp][0], sc[2 * pp][1]); w.y = cvt_pk_bf16(sc[2 * pp][2], sc[2 * pp][3]);
            if (pp < 4) { w.z = cvt_pk_bf16(sc[2 * pp + 1][0], sc[2 * pp + 1][1]); w.w = cvt_pk_bf16(sc[2 * pp + 1][2], sc[2 * pp + 1][3]); } else { w.z = 0u; w.w = 0u; }
            pf[pp] = __builtin_bit_cast(bf16x8, w); }
#pragma unroll
        for (int nt = 0; nt < 4; ++nt) { f32x4 o = (f32x4){0.f, 0.f, 0.f, 0.f};
            const unsigned char* vp = Vt + (nt * 16 + fr) * 392 + (16 * i + 4 * fq) * 2;
#pragma unroll
            for (int pp = 0; pp < 5; ++pp) { u32x4 w; const u32x2 lo = *(const u32x2*)(vp + (2 * pp) * 32); w.x = lo.x; w.y = lo.y;
                if (pp < 4) { const u32x2 hi = *(const u32x2*)(vp + (2 * pp + 1) * 32); w.z = hi.x; w.w = hi.y; } else { w.z = 0u; w.w = 0u; }
                o = __builtin_amdgcn_mfma_f32_16x16x32_bf16(__builtin_bit_cast(bf16x8, w), pf[pp], o, 0, 0, 0); }
            u32x2 w2; w2.x = cvt_pk_bf16(o[0] * inv, o[1] * inv); w2.y = cvt_pk_bf16(o[2] * inv, o[3] * inv);
            *(u32x2*)(ycat + (tokb + q0 + 16 * i + fr) * 2048 + hq * 64 + nt * 16 + 4 * fq) = w2; }
    }
    __syncthreads();
}

#define XB_TMO      128
#define XB_XCNT(j)  (256  + 64 * (j))
#define XB_XSUB(j)  (1280 + 64 * (j))
#define XB_XGEN(j)  (2304 + 64 * (j))
#define XB_TOP      3328
#define XB_TOPGEN   3392
#define XCD_BAR_WORDS 3456
#define XB_SPIN_CAP (1u << 18)
__device__ __forceinline__ unsigned xb_ld(unsigned* p)              { return __hip_atomic_load(p, __ATOMIC_RELAXED, __HIP_MEMORY_SCOPE_AGENT); }
__device__ __forceinline__ unsigned xb_add(unsigned* p, unsigned v) { return __hip_atomic_fetch_add(p, v, __ATOMIC_RELAXED, __HIP_MEMORY_SCOPE_AGENT); }
__device__ __forceinline__ unsigned xb_xcc_id() { return (unsigned)__builtin_amdgcn_s_getreg((3 << 11) | 20) & 0xFu; }
#define XB_SPIN(cond, bar) do { unsigned _sp = 0; while (cond) { __builtin_amdgcn_s_sleep(1); \
    if ((++_sp & 255u) == 0u) { if (xb_ld(&(bar)[XB_TMO])) break; if (_sp > XB_SPIN_CAP) { atomicAdd(&(bar)[XB_TMO], 1u); break; } } } } while (0)
struct XcdBarrier { unsigned* bar; unsigned x; volatile LAS unsigned* st; };
__device__ __forceinline__ XcdBarrier xcd_barrier_post(unsigned* bar, volatile LAS unsigned* st) {
    XcdBarrier b; b.bar = bar; b.x = xb_xcc_id(); b.st = st;
    if (threadIdx.x == 0) (void)xb_add(&bar[XB_XCNT(b.x)], 1u);
    return b;
}
__device__ __forceinline__ void xcd_barrier_complete(unsigned* bar, unsigned x, unsigned& nloc, unsigned& nx) {
    const unsigned G = gridDim.x * gridDim.y * gridDim.z;
    unsigned sum, cnt, mine, sp = 0u;
    for (;;) {
        sum = 0u; cnt = 0u; mine = 0u;
#pragma unroll
        for (unsigned j = 0; j < 16; ++j) { const unsigned c = xb_ld(&bar[XB_XCNT(j)]); sum += c; cnt += (c > 0u) ? 1u : 0u; mine = (j == x) ? c : mine; }
        if (sum == G) break;
        __builtin_amdgcn_s_sleep(1);
        if ((++sp & 255u) == 0u) { if (xb_ld(&bar[XB_TMO])) break; if (sp > XB_SPIN_CAP) { atomicAdd(&bar[XB_TMO], 1u); break; } }
    }
    nloc = mine > 0u ? mine : 1u; nx = cnt > 0u ? cnt : 1u;
}
__device__ __forceinline__ void xcd_barrier(const XcdBarrier& b) {
    asm volatile("s_waitcnt vmcnt(0)" ::: "memory");
    __syncthreads();
    if (threadIdx.x == 0) {
        unsigned* bar = b.bar;
        __builtin_amdgcn_s_waitcnt(0);
        unsigned nloc = b.st[0], nx = b.st[1];
        if (nloc == 0u) { xcd_barrier_complete(bar, b.x, nloc, nx); b.st[0] = nloc; b.st[1] = nx; }
        const unsigned old = xb_add(&bar[XB_XSUB(b.x)], 1u);
        const unsigned gen = old / nloc;
        if (old + 1u == (gen + 1u) * nloc) {
            __builtin_amdgcn_fence(__ATOMIC_RELEASE, "agent");
            asm volatile("s_waitcnt vmcnt(0)" ::: "memory");
            const unsigned og = xb_add(&bar[XB_TOP], 1u);
            const unsigned tg = og / nx;
            if (og + 1u == (tg + 1u) * nx) xb_add(&bar[XB_TOPGEN], 1u);
            else XB_SPIN(xb_ld(&bar[XB_TOPGEN]) == tg, bar);
            __builtin_amdgcn_fence(__ATOMIC_ACQUIRE, "agent");
            xb_add(&bar[XB_XGEN(b.x)], 1u);
            asm volatile("s_waitcnt vmcnt(0)" ::: "memory");
        } else {
            XB_SPIN(xb_ld(&bar[XB_XGEN(b.x)]) == gen, bar);
            __builtin_amdgcn_fence(__ATOMIC_ACQUIRE, "agent");
            asm volatile("s_waitcnt vmcnt(0)" ::: "memory");
        }
    }
    __syncthreads();
}

struct Args { const float* in[25]; float* out; unsigned char* ws; int ph_lo, ph_hi; };

__global__ void __launch_bounds__(512, 2) mega(Args a) {
    extern __shared__ __attribute__((aligned(16))) unsigned char lds[];
    float* sm = (float*)lds;
    unsigned char* ws = a.ws;
    bf16_t* Win_t = (bf16_t*)(ws + WS_WIN); bf16_t* Wglu_t = (bf16_t*)(ws + WS_WGLU); bf16_t* WoE_t = (bf16_t*)(ws + WS_WOE); bf16_t* Wqkv_t = (bf16_t*)(ws + WS_WQKV);
    bf16_t* WoO_t = (bf16_t*)(ws + WS_WOO); bf16_t* Wup_t = (bf16_t*)(ws + WS_WUP); bf16_t* Wdn_t = (bf16_t*)(ws + WS_WDN);
    bf16_t* XN = (bf16_t*)(ws + WS_XN); bf16_t* PROJ = (bf16_t*)(ws + WS_PROJ); bf16_t* YCAT = (bf16_t*)(ws + WS_YCAT); bf16_t* YS5 = (bf16_t*)(ws + WS_YS5); bf16_t* HID = (bf16_t*)(ws + WS_HID);
    bf16_t* HST = (bf16_t*)(ws + WS_HST); float* HDEC = (float*)(ws + WS_HDEC); float* S5F = (float*)(ws + WS_S5F); float* S5A = (float*)(ws + WS_S5A); float* S5B = (float*)(ws + WS_S5B); float* RS = (float*)(ws + WS_RS);
    const int G = gridDim.x, bid = blockIdx.x;
    if (threadIdx.x < 4) ((volatile LAS unsigned*)((LAS unsigned char*)lds + LDS_STAGE))[threadIdx.x] = 0u;
    __syncthreads();
    XcdBarrier xbar; xbar.bar = (unsigned*)(ws + WS_BAR); xbar.x = 0; xbar.st = nullptr;
    if (a.ph_hi - a.ph_lo > 1) xbar = xcd_barrier_post((unsigned*)(ws + WS_BAR), (volatile LAS unsigned*)((LAS unsigned char*)lds + LDS_STAGE));
    if (a.ph_lo > 1000) cg::this_grid().sync();

    for (int ph = a.ph_lo; ph < a.ph_hi; ++ph) {
      int nrep = 1;
      for (int rep = 0; rep < nrep; ++rep) {
        if (ph == 0) {
            if (REP_MASK & (1 << 11)) nrep = 2;
            for (int j = 0; j < 2; ++j) {
                transpose_cvt(a.in[2] + (size_t)j * 2048 * 5120, Win_t + (size_t)j * 5120 * 2048, 2048, 5120, sm, a.in[1] + (size_t)j * 2048, bid, G);
                transpose_cvt(a.in[11] + (size_t)j * 1024 * 1024, Wglu_t + (size_t)j * 1024 * 1024, 1024, 1024, sm, nullptr, bid, G);
                transpose_cvt(a.in[15] + (size_t)j * 2048 * 2048, WoE_t + (size_t)j * 2048 * 2048, 2048, 2048, sm, nullptr, bid, G);
                transpose_cvt(a.in[17] + (size_t)j * 2048 * 2560, Wqkv_t + (size_t)j * 2560 * 2048, 2048, 2560, sm, a.in[16] + (size_t)j * 2048, bid, G);
                transpose_cvt(a.in[21] + (size_t)j * 2048 * 2048, WoO_t + (size_t)j * 2048 * 2048, 2048, 2048, sm, nullptr, bid, G);
            }
            s5_params(a.in[3], a.in[4], a.in[5], a.in[6], a.in[7], S5A, S5B);
            x_stats_phase(a.in[0], XN, RS);
        } else {
            const int q = ph - 1, pair = q / 13, r = q % 13;
            const bool odd = r >= 8; const int layer = pair * 2 + (odd ? 1 : 0), j = pair; const int rr = odd ? r - 8 : r;
            int kind;
            if (!odd) kind = rr == 0 ? 1 : rr == 1 ? 2 : rr == 2 ? 3 : rr == 3 ? 4 : rr == 4 ? 5 : rr == 5 ? 6 : rr == 6 ? 8 : 9;
            else kind = rr == 0 ? 1 : rr == 1 ? 10 : rr == 2 ? 6 : rr == 3 ? 8 : 9;
            if ((REP_MASK >> kind) & 1) nrep = 2;
            switch (kind) {
            case 1: case 8: {
                pg8::Gemm g; pg8::EpiBf16 E; const float* rs;
                float* RL = (float*)(lds + 131072);
                if (kind == 8) { g = pg8::Gemm{XN, Wup_t + (size_t)layer * 8192 * 2048, T, 8192, 2048}; E = pg8::EpiBf16{HID, 8192, 1, RL}; rs = RS + (size_t)(2 * layer + 1) * T * 32; }
                else if (!odd) { g = pg8::Gemm{XN, Win_t + (size_t)j * 5120 * 2048, T, 5120, 2048}; E = pg8::EpiBf16{PROJ, 5120, 0, RL}; rs = RS + (size_t)(2 * layer) * T * 32; }
                else { g = pg8::Gemm{XN, Wqkv_t + (size_t)j * 2560 * 2048, T, 2560, 2048}; E = pg8::EpiBf16{PROJ, 2560, 0, RL}; rs = RS + (size_t)(2 * layer) * T * 32; }
                pg8::StaticOrder S; S.init(g.M, g.N, G, bid);
                { int tid = threadIdx.x; asm volatile("" : "+v"(tid));
#pragma unroll
                  for (int i0 = 0; i0 < 4; i0 += 2) { const int i = i0 + (tid >> 8); pg8::Unit u;
                      if (S.next(i, u)) { const float* rp = rs + (size_t)(u.pm * 256 + (tid & 255)) * 32; f32x4 t4 = *(const f32x4*)rp;
#pragma unroll
                          for (int q4 = 1; q4 < 8; ++q4) t4 = t4 + *(const f32x4*)(rp + 4 * q4);
                          RL[i * 256 + (tid & 255)] = rsqrtf(((t4[0] + t4[1]) + (t4[2] + t4[3])) * (1.0f / 2048.0f) + 1e-6f); } }
                  __syncthreads(); }
                pg8::gemm_phase<pg8::EpiBf16, true, GEMM_SP2>((LAS unsigned char*)lds, g, S, E);
                if (kind == 1 && rep == 0) {
                    const int nfull = S.nwg % G;
                    if (nfull != 0 && bid >= nfull) {
                        __syncthreads();
                        transpose_cvt(a.in[23] + (size_t)layer * 2048 * 8192, Wup_t + (size_t)layer * 8192 * 2048, 2048, 8192, sm, a.in[22] + (size_t)layer * 2048, bid - nfull, G - nfull);
                        if (odd) transpose_cvt(a.in[24] + (size_t)layer * 8192 * 2048, Wdn_t + (size_t)layer * 2048 * 8192, 8192, 2048, sm, nullptr, bid - nfull, G - nfull);
                    } else if (nfull == 0 && !odd) { __syncthreads(); transpose_cvt(a.in[23] + (size_t)layer * 2048 * 8192, Wup_t + (size_t)layer * 8192 * 2048, 2048, 8192, sm, a.in[22] + (size_t)layer * 2048, bid, G); }
                    else if (nfull == 0) { __syncthreads(); transpose_cvt(a.in[23] + (size_t)layer * 2048 * 8192, Wup_t + (size_t)layer * 8192 * 2048, 2048, 8192, sm, a.in[22] + (size_t)layer * 2048, bid, G);
                        transpose_cvt(a.in[24] + (size_t)layer * 8192 * 2048, Wdn_t + (size_t)layer * 2048 * 8192, 8192, 2048, sm, nullptr, bid, G); }
                }
            } break;
            case 5: {
                pg8::Gemm g{YS5, Wglu_t + (size_t)j * 1024 * 1024, T, 1024, 1024}; pg8::EpiGlu E{YS5, a.in[12] + (size_t)j * 1024, YCAT, 2048};
                pg8::StaticOrder S; S.init(g.M, g.N, G, bid);
                pg8::gemm_phase<pg8::EpiGlu, false, GEMM_SP2>((LAS unsigned char*)lds, g, S, E);
                if (rep == 0) { const int nfull = S.nwg < G ? S.nwg : 0;
                    __syncthreads();
                    if (nfull != 0) { if (bid >= nfull) transpose_cvt(a.in[24] + (size_t)layer * 8192 * 2048, Wdn_t + (size_t)layer * 2048 * 8192, 8192, 2048, sm, nullptr, bid - nfull, G - nfull); }
                    else transpose_cvt(a.in[24] + (size_t)layer * 8192 * 2048, Wdn_t + (size_t)layer * 2048 * 8192, 8192, 2048, sm, nullptr, bid, G); }
            } break;
            case 6: case 9: {
                pg8::Gemm g;
                if (kind == 9) g = pg8::Gemm{HID, Wdn_t + (size_t)layer * 2048 * 8192, T, 2048, 8192};
                else g = pg8::Gemm{YCAT, (odd ? WoO_t : WoE_t) + (size_t)j * 2048 * 2048, T, 2048, 2048};
                const int slot = kind == 9 ? 2 * layer + 2 : 2 * layer + 1;
                pg8::EpiResid E{XN, RS + (size_t)slot * T * 32, (kind == 9 && layer == 3) ? a.out : (float*)nullptr};
                pg8::StaticOrder S; S.init(g.M, g.N, G, bid);
                pg8::gemm_phase<pg8::EpiResid, false, GEMM_SP2>((LAS unsigned char*)lds, g, S, E);
            } break;
            case 2:
                for (int r2 = 0; r2 < ((REP2 & 8) ? 2 : 1); ++r2) for (int it = bid; it < 1024; it += G) hgrn_p1(it, PROJ, a.in[13], j, HST, HDEC, lds);
                if (G == 256) s5_wg<false>(bid, PROJ, S5A + (size_t)j * 8192, S5B + (size_t)j * 131072, S5F, nullptr, nullptr, nullptr, nullptr, lds);
                else for (int r2 = 0; r2 < ((REP2 & 16) ? 2 : 1); ++r2) for (int it = bid; it < 1024; it += G) s5_pass<false>(it, PROJ, S5A + (size_t)j * 8192, S5B + (size_t)j * 131072, S5F, nullptr, nullptr, nullptr, nullptr, lds);
                break;
            case 3: hgrn_p2(HST, HDEC); s5_carry(S5F, S5A + (size_t)j * 8192); break;
            case 4:
                for (int r2 = 0; r2 < ((REP2 & 1) ? 2 : 1); ++r2) for (int it = bid; it < 1024; it += G) hgrn_p3(it, PROJ, a.in[13], j, HST, a.in[14] + (size_t)j * 128, YCAT, lds);
                if (G == 256) s5_wg<true>(bid, PROJ, S5A + (size_t)j * 8192, S5B + (size_t)j * 131072, S5F, a.in[8] + (size_t)j * 65536, a.in[9] + (size_t)j * 65536, a.in[10] + (size_t)j * 1024, YS5, lds);
                else for (int r2 = 0; r2 < ((REP2 & 2) ? 2 : 1); ++r2) for (int it = bid; it < 1024; it += G) s5_pass<true>(it, PROJ, S5A + (size_t)j * 8192, S5B + (size_t)j * 131072, S5F, a.in[8] + (size_t)j * 65536, a.in[9] + (size_t)j * 65536, a.in[10] + (size_t)j * 1024, YS5, lds);
                break;
            case 10:
                for (int it = bid; it < 512; it += G) attn_item(it, PROJ, a.in[18] + (size_t)j * 64, a.in[19] + (size_t)j * 64, a.in[20] + (size_t)j * 32, YCAT, lds);
                break;
            default: break;
            }
        }
      }
        if (ph + 1 < a.ph_hi) { xcd_barrier(xbar); if (REP2 & 4) xcd_barrier(xbar); }
    }
}

extern "C" void kernel_launch(void* const* d_in, const int* in_sizes, int n_in, void* d_out, int out_size, void* d_ws, size_t ws_size, hipStream_t stream) {
    static int grid = 0;
    if (grid == 0) {
        if (n_in != 25 || ws_size < WS_END) { fprintf(stderr, "kernel_launch: need 25 inputs and %zu bytes of workspace; got %d, %zu\n", (size_t)WS_END, n_in, ws_size); grid = -1; return; }
        int dev = 0, cus = 0, per_cu = 0;
        hipGetDevice(&dev); hipDeviceGetAttribute(&cus, hipDeviceAttributeMultiprocessorCount, dev);
        if (hipFuncSetAttribute((const void*)mega, hipFuncAttributeMaxDynamicSharedMemorySize, LDS_BYTES) != hipSuccess) { fprintf(stderr, "kernel_launch: hipFuncSetAttribute failed\n"); grid = -1; return; }
        if (hipOccupancyMaxActiveBlocksPerMultiprocessor(&per_cu, (const void*)mega, 512, LDS_BYTES) != hipSuccess || per_cu < 1) { fprintf(stderr, "kernel_launch: occupancy query says %d\n", per_cu); per_cu = 1; }
        (void)hipGetLastError();
        grid = cus > 0 ? cus : 256;
    }
    if (grid < 0) return;
    Args a{};
    for (int i = 0; i < 25; ++i) a.in[i] = (const float*)d_in[i];
    a.out = (float*)d_out; a.ws = (unsigned char*)d_ws;
#if MK_ONE_LAUNCH
    a.ph_lo = 0; a.ph_hi = NPH;
    if (hipMemsetAsync((unsigned char*)d_ws + WS_BAR, 0, (size_t)XCD_BAR_WORDS_C * 4, stream) != hipSuccess) { fprintf(stderr, "kernel_launch: memset failed\n"); return; }
    void* args[] = {&a};
    hipError_t e = hipLaunchCooperativeKernel((const void*)mega, dim3(grid), dim3(512), args, LDS_BYTES, stream);
    if (e != hipSuccess) fprintf(stderr, "kernel_launch: cooperative launch failed: %s (grid %d)\n", hipGetErrorString(e), grid);
#else
    for (int ph = 0; ph < NPH; ++ph) { a.ph_lo = ph; a.ph_hi = ph + 1; hipLaunchKernelGGL(mega, dim3(grid), dim3(512), LDS_BYTES, stream, a); }
#endif
}
```
